# Optimizing an MI355X kernel written in HIP

```python
import math
import jax, jax.numpy as jnp
from jax import lax
import numpy as np

D_MODEL = 1024
BATCH = 16
SEQ = 2048
DEPTH = 4

N_MIXERS = 2
N_CONV_LAYERS = (DEPTH + 1) // 2
N_SSM_LAYERS = DEPTH // 2
CONV_WIDTH = 3
SSM_GROUP = 16
SSM_GROUPS = D_MODEL // SSM_GROUP
SSM_STATE = 64
SSM_CHUNK = 128
DT_MIN = 1e-3
DT_MAX = 1e-1
EIG_CLIP = -1e-4
D_FF = 2816
MEM_LEN = 256
XA_HEADS = 4
XA_HEAD_DIM = D_MODEL // XA_HEADS
NORM_EPS = 1e-6
N_NORMS = 5

kernel_name = "hybrid_conv_s5_macaron_decoder"


def rmsnorm(x, g):
    xf = x.astype(jnp.float32)
    y = xf * lax.rsqrt(jnp.mean(xf * xf, axis=-1, keepdims=True) + NORM_EPS)
    return (y * g.astype(jnp.float32)).astype(x.dtype)


def swiglu_ffn(h, w_up, w_down):
    gate, up = jnp.split(h @ w_up, 2, axis=-1)
    return (jax.nn.silu(gate) * up) @ w_down


def short_conv_mixer(h, w_in, conv_w, w_out):
    c_gate, b_gate, v = jnp.split(h @ w_in, 3, axis=-1)
    u = c_gate * v
    conv = lax.conv_general_dilated(
        u, conv_w[:, None, :],
        window_strides=(1,),
        padding=[(CONV_WIDTH - 1, 0)],
        dimension_numbers=("NWC", "WIO", "NWC"),
        feature_group_count=D_MODEL)
    return (b_gate * conv) @ w_out


def _complex_scan_op(e1, e2):
    a1r, a1i, b1r, b1i = e1
    a2r, a2i, b2r, b2i = e2
    return (a2r * a1r - a2i * a1i,
            a2r * a1i + a2i * a1r,
            a2r * b1r - a2i * b1i + b2r,
            a2r * b1i + a2i * b1r + b2i)


def s5_mixer(h, a_re, a_im, log_dt, b_re, b_im, c_re, c_im, d_skip, w_glu):
    bsz, seq, _ = h.shape
    f32 = jnp.float32
    lam_re = jnp.minimum(a_re.astype(f32), EIG_CLIP)
    lam_im = a_im.astype(f32)
    dt = jnp.exp(log_dt.astype(f32))[:, None]
    mag = jnp.exp(lam_re * dt)
    abar_re = mag * jnp.cos(lam_im * dt)
    abar_im = mag * jnp.sin(lam_im * dt)
    den = lam_re * lam_re + lam_im * lam_im
    num_re = abar_re - 1.0
    num_im = abar_im
    coef_re = (num_re * lam_re + num_im * lam_im) / den
    coef_im = (num_im * lam_re - num_re * lam_im) / den
    br = b_re.astype(f32)
    bi = b_im.astype(f32)
    bbar_re = coef_re[..., None] * br - coef_im[..., None] * bi
    bbar_im = coef_re[..., None] * bi + coef_im[..., None] * br
    cr = c_re.astype(f32)
    ci = c_im.astype(f32)

    n_chunks = seq // SSM_CHUNK
    u = h.astype(f32).reshape(bsz, n_chunks, SSM_CHUNK, SSM_GROUPS, SSM_GROUP)
    u = jnp.moveaxis(u, 1, 0)
    el_shape = (bsz, SSM_CHUNK, SSM_GROUPS, SSM_STATE)
    a_el_re = jnp.broadcast_to(abar_re, el_shape)
    a_el_im = jnp.broadcast_to(abar_im, el_shape)

    def chunk_step(carry, u_c):
        h_re, h_im = carry
        bu_re = jnp.einsum("btgh,gph->btgp", u_c, bbar_re)
        bu_im = jnp.einsum("btgh,gph->btgp", u_c, bbar_im)
        acc_re, acc_im, loc_re, loc_im = lax.associative_scan(
            _complex_scan_op, (a_el_re, a_el_im, bu_re, bu_im), axis=1)
        s_re = loc_re + acc_re * h_re[:, None] - acc_im * h_im[:, None]
        s_im = loc_im + acc_re * h_im[:, None] + acc_im * h_re[:, None]
        y_c = (jnp.einsum("btgp,ghp->btgh", s_re, cr)
               - jnp.einsum("btgp,ghp->btgh", s_im, ci))
        return (s_re[:, -1], s_im[:, -1]), y_c

    h0 = (jnp.zeros((bsz, SSM_GROUPS, SSM_STATE), f32),
          jnp.zeros((bsz, SSM_GROUPS, SSM_STATE), f32))
    _, y = lax.scan(chunk_step, h0, u)
    y = jnp.moveaxis(y, 0, 1).reshape(bsz, seq, D_MODEL)
    y = y + d_skip.astype(f32) * h.astype(f32)
    z = jax.nn.gelu(y).astype(h.dtype)
    val, gate = jnp.split(z @ w_glu, 2, axis=-1)
    return val * jax.nn.sigmoid(gate)


def memory_cross_attention(h, mem_n, w_q, w_kv, w_o):
    bsz, seq, _ = h.shape
    mlen = mem_n.shape[1]
    q = (h @ w_q).reshape(bsz, seq, XA_HEADS, XA_HEAD_DIM)
    k, v = jnp.split(mem_n @ w_kv, 2, axis=-1)
    k = k.reshape(bsz, mlen, XA_HEADS, XA_HEAD_DIM)
    v = v.reshape(bsz, mlen, XA_HEADS, XA_HEAD_DIM)
    s = jnp.einsum("bqhd,bkhd->bhqk", q, k).astype(jnp.float32) * (XA_HEAD_DIM ** -0.5)
    p = jax.nn.softmax(s, axis=-1).astype(v.dtype)
    o = jnp.einsum("bhqk,bkhd->bqhd", p, v).reshape(bsz, seq, D_MODEL)
    return o @ w_o


def setup_inputs(seed: int = 0) -> dict:
    key = jax.random.key(seed)
    ks = jax.random.split(key, 24)
    D = D_MODEL
    nrm = jax.random.normal

    def w(k, shape, fan_in):
        return nrm(k, shape, jnp.float32) * (fan_in ** -0.5)

    x = nrm(ks[0], (BATCH, SEQ, D), jnp.float32)
    mem = nrm(ks[1], (BATCH, MEM_LEN, D), jnp.float32)
    norm_g = 1.0 + 0.02 * nrm(ks[2], (DEPTH, N_NORMS, D), jnp.float32)
    final_g = 1.0 + 0.02 * nrm(ks[3], (D,), jnp.float32)
    ffn1_up = w(ks[4], (DEPTH, D, 2 * D_FF), D)
    ffn1_down = w(ks[5], (DEPTH, D_FF, D), D_FF)
    ffn2_up = w(ks[6], (DEPTH, D, 2 * D_FF), D)
    ffn2_down = w(ks[7], (DEPTH, D_FF, D), D_FF)
    conv_w_in = w(ks[8], (N_CONV_LAYERS, D, 3 * D), D)
    conv_w = w(ks[9], (N_CONV_LAYERS, CONV_WIDTH, D), CONV_WIDTH)
    conv_w_out = w(ks[10], (N_CONV_LAYERS, D, D), D)
    ssm_shape = (N_SSM_LAYERS, SSM_GROUPS, SSM_STATE)
    ssm_a_re = -0.5 + 0.01 * nrm(ks[11], ssm_shape, jnp.float32)
    ssm_a_im = (math.pi * jnp.arange(SSM_STATE, dtype=jnp.float32)[None, None, :]
                + 0.01 * nrm(ks[12], ssm_shape, jnp.float32))
    ssm_log_dt = jax.random.uniform(ks[13], (N_SSM_LAYERS, SSM_GROUPS), jnp.float32,
                                    math.log(DT_MIN), math.log(DT_MAX))
    ssm_b_re = w(ks[14], (N_SSM_LAYERS, SSM_GROUPS, SSM_STATE, SSM_GROUP), 2 * SSM_GROUP)
    ssm_b_im = w(ks[15], (N_SSM_LAYERS, SSM_GROUPS, SSM_STATE, SSM_GROUP), 2 * SSM_GROUP)
    ssm_c_re = w(ks[16], (N_SSM_LAYERS, SSM_GROUPS, SSM_GROUP, SSM_STATE), SSM_STATE)
    ssm_c_im = w(ks[17], (N_SSM_LAYERS, SSM_GROUPS, SSM_GROUP, SSM_STATE), SSM_STATE)
    ssm_d = nrm(ks[18], (N_SSM_LAYERS, D), jnp.float32)
    ssm_w_glu = w(ks[19], (N_SSM_LAYERS, D, 2 * D), D)
    xa_w_q = w(ks[20], (DEPTH, D, D), D)
    xa_w_kv = w(ks[21], (DEPTH, D, 2 * D), D)
    xa_w_o = w(ks[22], (DEPTH, D, D), D)
    return {"x": x, "mem": mem, "norm_g": norm_g, "final_g": final_g,
            "ffn1_up": ffn1_up, "ffn1_down": ffn1_down,
            "ffn2_up": ffn2_up, "ffn2_down": ffn2_down,
            "conv_w_in": conv_w_in, "conv_w": conv_w, "conv_w_out": conv_w_out,
            "ssm_a_re": ssm_a_re, "ssm_a_im": ssm_a_im, "ssm_log_dt": ssm_log_dt,
            "ssm_b_re": ssm_b_re, "ssm_b_im": ssm_b_im,
            "ssm_c_re": ssm_c_re, "ssm_c_im": ssm_c_im,
            "ssm_d": ssm_d, "ssm_w_glu": ssm_w_glu,
            "xa_w_q": xa_w_q, "xa_w_kv": xa_w_kv, "xa_w_o": xa_w_o}


def reference(x, mem, norm_g, final_g, ffn1_up, ffn1_down, ffn2_up, ffn2_down,
              conv_w_in, conv_w, conv_w_out,
              ssm_a_re, ssm_a_im, ssm_log_dt, ssm_b_re, ssm_b_im,
              ssm_c_re, ssm_c_im, ssm_d, ssm_w_glu,
              xa_w_q, xa_w_kv, xa_w_o):
    for i in range(DEPTH):
        g = norm_g[i]
        x = x + 0.5 * swiglu_ffn(rmsnorm(x, g[0]), ffn1_up[i], ffn1_down[i])
        h = rmsnorm(x, g[1])
        j = i // N_MIXERS
        if i % N_MIXERS == 0:
            x = x + short_conv_mixer(h, conv_w_in[j], conv_w[j], conv_w_out[j])
        else:
            x = x + s5_mixer(h, ssm_a_re[j], ssm_a_im[j], ssm_log_dt[j],
                             ssm_b_re[j], ssm_b_im[j], ssm_c_re[j], ssm_c_im[j],
                             ssm_d[j], ssm_w_glu[j])
        x = x + memory_cross_attention(rmsnorm(x, g[2]), rmsnorm(mem, g[3]),
                                       xa_w_q[i], xa_w_kv[i], xa_w_o[i])
        x = x + 0.5 * swiglu_ffn(rmsnorm(x, g[4]), ffn2_up[i], ffn2_down[i])
    return rmsnorm(x, final_g)
```

```cpp
#include <hip/hip_runtime.h>
#include <hip/hip_cooperative_groups.h>
#include <cstdio>
namespace cg = cooperative_groups;

#define LAS __attribute__((address_space(3)))
typedef unsigned short bf16_t;
typedef short bf16x8 __attribute__((ext_vector_type(8)));
typedef float f32x4 __attribute__((ext_vector_type(4)));
typedef float f32x16 __attribute__((ext_vector_type(16)));
typedef unsigned u32x4 __attribute__((ext_vector_type(4)));
typedef unsigned u32x2 __attribute__((ext_vector_type(2)));

constexpr int T_TOK = 32768, DM = 1024, DFF = 2816, SEQ = 2048, NB = 16, MEML = 256, NLAYER = 4;
constexpr int NTHREADS = 512;
constexpr int LDS_BYTES = 131072 + 32768;
constexpr float NORM_EPS = 1e-6f;

constexpr size_t SZ_UP = (size_t)2 * DFF * DM * 2, SZ_DN = (size_t)DM * DFF * 2, SZ_SQ = (size_t)DM * DM * 2;
constexpr size_t WS_UP1 = 0;
constexpr size_t WS_DN1 = WS_UP1 + 4 * SZ_UP;
constexpr size_t WS_UP2 = WS_DN1 + 4 * SZ_DN;
constexpr size_t WS_DN2 = WS_UP2 + 4 * SZ_UP;
constexpr size_t WS_CIN = WS_DN2 + 4 * SZ_DN;
constexpr size_t WS_COUT = WS_CIN + 2 * 3 * SZ_SQ;
constexpr size_t WS_GLU = WS_COUT + 2 * SZ_SQ;
constexpr size_t WS_Q = WS_GLU + 2 * 2 * SZ_SQ;
constexpr size_t WS_K = WS_Q + 4 * SZ_SQ;
constexpr size_t WS_VT = WS_K + 4 * SZ_SQ;
constexpr size_t WS_O = WS_VT + 4 * SZ_SQ;
constexpr size_t WS_XB = WS_O + 4 * SZ_SQ;
constexpr size_t WS_HB = WS_XB + (size_t)T_TOK * DM * 2;
constexpr size_t WS_MEMB = WS_HB + (size_t)T_TOK * DFF * 2;
constexpr size_t WS_KALL = WS_MEMB + (size_t)4096 * DM * 2;
constexpr size_t WS_VTALL = WS_KALL + (size_t)4096 * 4096 * 2;
constexpr size_t WS_PART = WS_VTALL + (size_t)4096 * 4096 * 2;
constexpr size_t WS_DISC = WS_PART + (size_t)T_TOK * 32 * 4;
constexpr size_t WS_BAR = WS_DISC + (size_t)2 * 64 * 64 * 8 * 4;
constexpr size_t WS_END = WS_BAR + 256 * 33;

__device__ __forceinline__ unsigned cvt_pk_bf16(float lo, float hi) { unsigned r; asm volatile("v_cvt_pk_bf16_f32 %0, %1, %2" : "=v"(r) : "v"(lo), "v"(hi)); return r; }
__device__ __forceinline__ float bf_lo(unsigned w) { return __uint_as_float(w << 16); }
__device__ __forceinline__ float bf_hi(unsigned w) { return __uint_as_float(w & 0xffff0000u); }
__device__ __forceinline__ float fast_sigmoid(float x) { return __builtin_amdgcn_rcpf(1.0f + __builtin_amdgcn_exp2f(-1.44269504089f * x)); }
__device__ __forceinline__ float gelu_tanh(float x) { const float a = 1.5957691216f * (x + 0.044715f * x * x * x); return x * fast_sigmoid(a); }

__device__ __forceinline__ void grid_barrier(unsigned* bar, unsigned k, unsigned nsub, unsigned per_sub) {
    asm volatile("s_waitcnt vmcnt(0)" ::: "memory");
    __syncthreads();
    if (threadIdx.x == 0) {
        __builtin_amdgcn_fence(__ATOMIC_RELEASE, "agent");
        asm volatile("s_waitcnt vmcnt(0)" ::: "memory");
        const unsigned old = __hip_atomic_fetch_add(bar + 64 * (1 + (blockIdx.x % nsub)), 1u, __ATOMIC_RELAXED, __HIP_MEMORY_SCOPE_AGENT);
        if (old + 1u == k * per_sub) {
            const unsigned oldt = __hip_atomic_fetch_add(bar, 1u, __ATOMIC_RELAXED, __HIP_MEMORY_SCOPE_AGENT);
            if (oldt + 1u == k * nsub)
                for (unsigned i = 0; i < nsub; ++i) __hip_atomic_store(bar + 64 * (17 + i), k, __ATOMIC_RELAXED, __HIP_MEMORY_SCOPE_AGENT);
        }
        while (__hip_atomic_load(bar + 64 * (17 + (blockIdx.x % nsub)), __ATOMIC_RELAXED, __HIP_MEMORY_SCOPE_AGENT) < k) __builtin_amdgcn_s_sleep(1);
        __builtin_amdgcn_fence(__ATOMIC_ACQUIRE, "agent");
        asm volatile("s_waitcnt vmcnt(0)" ::: "memory");
    }
    __syncthreads();
}
__device__ __forceinline__ float shx(float v, int mask) {
    unsigned m = ~0u; asm volatile("" : "+s"(m));
    const int lane = __builtin_amdgcn_mbcnt_hi(m, __builtin_amdgcn_mbcnt_lo(m, 0));
    return __int_as_float(__builtin_amdgcn_ds_bpermute((lane ^ mask) << 2, __float_as_int(v)));
}
template <class T> __device__ __forceinline__ T* launder(T* p) { asm volatile("" : "+s"(p)); return p; }
__device__ __forceinline__ int opaque_tid() { int t = threadIdx.x; asm volatile("" : "+v"(t)); return t; }

namespace pg8 {
constexpr int BM = 256, BK = 64, HALF = 128, HTB = HALF * BK * 2, STAGE_BYTES = 8 * HTB, NXCD = 8, WGM = 4;
__host__ __device__ __forceinline__ int lds_byte(int r, int c) { const int st = (r >> 4) * 2 + (c >> 5), rr = r & 15, cc = c & 31, ob = rr * 64 + cc * 2; return st * 1024 + (ob ^ (((ob >> 9) & 1) << 5)); }
__host__ __device__ __forceinline__ void stage_rc(int b, int& R, int& C) { const int st = b / 1024, sb = b % 1024, swz = sb ^ (((sb >> 9) & 1) << 5); R = (st >> 1) * 16 + swz / 64; C = (st & 1) * 32 + (swz % 64) / 2; }
__host__ __device__ __forceinline__ int perm32(int rho) { const int n = rho >> 4, i = rho & 15; return 8 * (i >> 2) + 4 * n + (i & 3); }

struct Unit { int pm, pn; };
struct Gemm { const bf16_t* A; const bf16_t* Bt; int K, lda; size_t tstepB; };
__device__ __forceinline__ Gemm mk_gemm(const bf16_t* A, const bf16_t* Bt, int K) { return Gemm{A, Bt, K, K, (size_t)512 * K}; }

struct StaticOrder {
    int nM, nN, nwg, G, c;
    __device__ void init(int M, int N, int G_, int c_) { nM = M / BM; nN = N / BM; nwg = nM * nN; G = G_; c = c_; }
    __device__ bool next(int i, Unit& u) const {
        const long L = (long)i * G + c; if (L >= nwg) return false;
        int wgid = (int)L; { const int q = nwg / NXCD, r = nwg % NXCD, xcd = wgid % NXCD, off = wgid / NXCD; wgid = (xcd < r ? xcd * (q + 1) : r * (q + 1) + (xcd - r) * q) + off; }
        const int nig = WGM * nN, gid = wgid / nig, fm = gid * WGM, gsz = (nM - fm) < WGM ? (nM - fm) : WGM;
        u.pm = fm + ((wgid % nig) % gsz); u.pn = (wgid % nig) / gsz; return true;
    }
};

struct GroupOrder {
    int G, c;
    __device__ bool next(int i, Unit& u) const { const int L = i * G + c; if (L >= 512) return false; u.pm = L; u.pn = L >> 3; return true; }
};

template <class Epi, class Sched>
__device__ __forceinline__ void gemm_phase(LAS unsigned char* lds, const Gemm g, const Sched& S, const Epi& E) {
    const int tid = opaque_tid(), wid = __builtin_amdgcn_readfirstlane(tid >> 6), lane = tid & 63, wr = wid >> 2, wc = wid & 3, fr = lane & 15, fq = lane >> 4;
    const int K = g.K, nt = K / BK;
    unsigned voffA[2], voffB[2];
#pragma unroll
    for (int i = 0; i < 2; ++i) { int R, C; stage_rc(tid * 16 + i * 8192, R, C); const int Rb = Epi::PERM ? ((R & ~31) + perm32(R & 31)) : R;
        voffA[i] = (unsigned)(R * g.lda + C) * 2u; voffB[i] = (unsigned)(Rb * K + C) * 2u; }
    const size_t kstep = (size_t)(BK * 2);
    const size_t hstepA = (size_t)HALF * g.lda * 2, hstepB = (size_t)HALF * K * 2;
    const size_t tstepA = 2 * hstepA, tstepB = g.tstepB;
    const unsigned ldsw = (unsigned)wid * 1024u;
    const int aoff = lds_byte(wr * 64 + fr, fq * 8), boff = lds_byte(wc * 32 + fr, fq * 8);
#define PG8_SA(b, h) (((b) * 2 + (h)) * HTB)
#define PG8_SB(b, h) ((4 + (b) * 2 + (h)) * HTB)
#define PG8_STAGE(bufoff, gbase, voff) do { _Pragma("unroll") for (int _i = 0; _i < 2; ++_i) \
        __builtin_amdgcn_global_load_lds((const unsigned*)((const char*)(gbase) + (voff)[_i]), (LAS unsigned*)(lds + (bufoff) + ldsw + _i * 8192), 16, 0, 0); } while (0)
#define PG8_LDA(dst, b, h) do { _Pragma("unroll") for (int m = 0; m < 4; ++m) _Pragma("unroll") for (int k = 0; k < 2; ++k) dst[m][k] = *(const LAS bf16x8*)(lds + PG8_SA(b, h) + aoff + m * 2048 + k * 1024); } while (0)
#define PG8_LDB(dst, b, h) do { _Pragma("unroll") for (int n = 0; n < 2; ++n) _Pragma("unroll") for (int k = 0; k < 2; ++k) dst[n][k] = *(const LAS bf16x8*)(lds + PG8_SB(b, h) + boff + n * 2048 + k * 1024); } while (0)
#define PG8_MMA(ai, bj, At, Bt) do { __builtin_amdgcn_s_setprio(1); _Pragma("unroll") for (int m = 0; m < 4; ++m) _Pragma("unroll") for (int n = 0; n < 2; ++n) _Pragma("unroll") for (int k = 0; k < 2; ++k) \
        acc[ai][bj][m][n] = __builtin_amdgcn_mfma_f32_16x16x32_bf16(Bt[n][k], At[m][k], acc[ai][bj][m][n], 0, 0, 0); __builtin_amdgcn_s_setprio(0); } while (0)
#define PG8_WAIT_V(n) asm volatile("s_waitcnt vmcnt(" #n ")" ::: "memory")
#define PG8_WAIT_L(n) asm volatile("s_waitcnt lgkmcnt(" #n ")" ::: "memory")
#define PG8_BAR __builtin_amdgcn_s_barrier()
#define PG8_SCHED __builtin_amdgcn_sched_barrier(0)
    const bool lp = Epi::LDSPART && E.lds_part();
#define PG8_PART_DMA(unit, buf) do { if constexpr (Epi::LDSPART) { if (lp) { const char* ps_ = (const char*)E.part + ((size_t)(unit).pm * 256 + 32 * wid) * 128; const unsigned pv_ = (unsigned)((lane >> 2) * 128 + (lane & 3) * 16); \
        __builtin_amdgcn_global_load_lds((const unsigned*)(ps_ + pv_), (LAS unsigned*)(lds + STAGE_BYTES + (buf) * 16384 + (32 * wid) * 64), 16, 0, 0); \
        __builtin_amdgcn_global_load_lds((const unsigned*)(ps_ + 2048 + pv_), (LAS unsigned*)(lds + STAGE_BYTES + (buf) * 16384 + (32 * wid + 16) * 64), 16, 0, 0); } } } while (0)
    Unit cur, nxt; int ui = 0;
    if (!S.next(0, cur)) return;
    f32x4 acc[2][2][4][2];
#pragma unroll
    for (int a = 0; a < 2; ++a)
#pragma unroll
        for (int b = 0; b < 2; ++b)
#pragma unroll
            for (int m = 0; m < 4; ++m)
#pragma unroll
                for (int n = 0; n < 2; ++n) acc[a][b][m][n] = (f32x4){0.f, 0.f, 0.f, 0.f};
    bf16x8 At[4][2], B0[2][2], B1[2][2];
    const char* cA = (const char*)g.A + (size_t)cur.pm * tstepA; const char* cB = (const char*)g.Bt + (size_t)cur.pn * tstepB;
    PG8_PART_DMA(cur, 0);
    PG8_STAGE(PG8_SB(0, 0), cB, voffB); PG8_STAGE(PG8_SA(0, 0), cA, voffA); PG8_STAGE(PG8_SB(0, 1), cB + hstepB, voffB); PG8_STAGE(PG8_SA(0, 1), cA + hstepA, voffA);
    if (wr == 1) PG8_BAR;
    PG8_WAIT_V(4); PG8_BAR;
    PG8_STAGE(PG8_SB(1, 0), cB + kstep, voffB); PG8_STAGE(PG8_SA(1, 0), cA + kstep, voffA); PG8_STAGE(PG8_SB(1, 1), cB + hstepB + kstep, voffB);
    PG8_WAIT_V(6); PG8_BAR;
    for (;;) {
        const bool has_next = S.next(ui + 1, nxt);
        const char* nA = has_next ? (const char*)g.A + (size_t)nxt.pm * tstepA : cA; const char* nB = has_next ? (const char*)g.Bt + (size_t)nxt.pn * tstepB : cB;
        for (int t = 0; t < nt; t += 2) {
            const bool last = (t == nt - 2);
            const char* a1 = cA + (size_t)(t + 1) * kstep;
            const char* a2 = last ? nA : cA + (size_t)(t + 2) * kstep; const char* b2 = last ? nB : cB + (size_t)(t + 2) * kstep;
            const char* a3 = a2 + kstep; const char* b3 = b2 + kstep;
            PG8_LDB(B0, 0, 0); PG8_SCHED; PG8_LDA(At, 0, 0); PG8_STAGE(PG8_SA(1, 1), a1 + hstepA, voffA);
            PG8_WAIT_L(8); PG8_BAR; PG8_WAIT_L(0); PG8_MMA(0, 0, At, B0); PG8_BAR; PG8_SCHED;
            PG8_LDB(B1, 0, 1); PG8_STAGE(PG8_SB(0, 0), b2, voffB);
            PG8_BAR; PG8_WAIT_L(0); PG8_MMA(0, 1, At, B1); PG8_BAR;
            PG8_LDA(At, 0, 1); PG8_STAGE(PG8_SA(0, 0), a2, voffA);
            PG8_BAR; PG8_WAIT_L(0); PG8_MMA(1, 0, At, B0); PG8_BAR; PG8_SCHED;
            PG8_STAGE(PG8_SB(0, 1), b2 + hstepB, voffB);
            PG8_WAIT_V(6); PG8_BAR;
            if (last && has_next) PG8_PART_DMA(nxt, (ui + 1) & 1);
            PG8_MMA(1, 1, At, B1); PG8_BAR;
            PG8_LDB(B0, 1, 0); PG8_SCHED; PG8_LDA(At, 1, 0); PG8_STAGE(PG8_SA(0, 1), a2 + hstepA, voffA);
            PG8_WAIT_L(8); PG8_BAR; PG8_WAIT_L(0); PG8_MMA(0, 0, At, B0); PG8_BAR; PG8_SCHED;
            PG8_LDB(B1, 1, 1); PG8_STAGE(PG8_SB(1, 0), b3, voffB);
            PG8_BAR; PG8_WAIT_L(0); PG8_MMA(0, 1, At, B1); PG8_BAR;
            PG8_LDA(At, 1, 1); PG8_STAGE(PG8_SA(1, 0), a3, voffA);
            PG8_BAR; PG8_WAIT_L(0); PG8_MMA(1, 0, At, B0); PG8_BAR; PG8_SCHED;
            PG8_STAGE(PG8_SB(1, 1), b3 + hstepB, voffB);
            PG8_WAIT_V(6); PG8_BAR; PG8_MMA(1, 1, At, B1); PG8_BAR;
        }
        E(acc, cur, wr, wc, fr, fq, lp ? (const LAS unsigned char*)(lds + STAGE_BYTES + (ui & 1) * 16384) : (const LAS unsigned char*)nullptr);
        if (!has_next) break;
#pragma unroll
        for (int a = 0; a < 2; ++a)
#pragma unroll
            for (int b = 0; b < 2; ++b)
#pragma unroll
                for (int m = 0; m < 4; ++m)
#pragma unroll
                    for (int n = 0; n < 2; ++n) acc[a][b][m][n] = (f32x4){0.f, 0.f, 0.f, 0.f};
        cur = nxt; cA = nA; cB = nB; ++ui;
    }
    PG8_WAIT_V(0);
    if (wr == 0) PG8_BAR;
    PG8_BAR;
#undef PG8_PART_DMA
#undef PG8_SA
#undef PG8_SB
#undef PG8_STAGE
#undef PG8_LDA
#undef PG8_LDB
#undef PG8_MMA
#undef PG8_WAIT_V
#undef PG8_WAIT_L
#undef PG8_BAR
#undef PG8_SCHED
}
}
using pg8::Unit;

__device__ __forceinline__ void rows_rstd(const float* part, int row0, int np, int fq, float (&rs)[8]) {
#pragma unroll
    for (int hf = 0; hf < 2; ++hf) {
        f32x4 pa[4], pb[4];
#pragma unroll
        for (int g4 = 0; g4 < 4; ++g4) {
            const float* p = part + (size_t)(row0 + hf * 128 + g4 * 16) * 32;
            if (np == 16) { pa[g4] = *(const f32x4*)(p + 4 * fq); pb[g4] = (f32x4){0.f, 0.f, 0.f, 0.f}; }
            else { pa[g4] = *(const f32x4*)(p + 8 * fq); pb[g4] = *(const f32x4*)(p + 8 * fq + 4); }
        }
#pragma unroll
        for (int g4 = 0; g4 < 4; ++g4) {
            float sm = ((pa[g4][0] + pa[g4][1]) + (pa[g4][2] + pa[g4][3])) + ((pb[g4][0] + pb[g4][1]) + (pb[g4][2] + pb[g4][3]));
            sm += shx(sm, 16); sm += shx(sm, 32);
            rs[hf * 4 + g4] = __builtin_amdgcn_rsqf(sm * (1.0f / 1024.0f) + NORM_EPS);
        }
        if (np != 16) asm volatile("" ::: "memory");
    }
}

__device__ __forceinline__ void rows_rstd_lds(const LAS unsigned char* lp, int rl0, int fq, float (&rs)[8]) {
    f32x4 pa[8];
#pragma unroll
    for (int g = 0; g < 8; ++g) pa[g] = *(const LAS f32x4*)(lp + (rl0 + (g >> 2) * 128 + (g & 3) * 16) * 64 + fq * 16);
#pragma unroll
    for (int g = 0; g < 8; ++g) {
        float sm = (pa[g][0] + pa[g][1]) + (pa[g][2] + pa[g][3]);
        sm += shx(sm, 16); sm += shx(sm, 32);
        rs[g] = __builtin_amdgcn_rsqf(sm * (1.0f / 1024.0f) + NORM_EPS);
    }
}

struct EpiBf16S {
    static constexpr bool PERM = true, LDSPART = true;
    bf16_t* O; int ldc; const float* part; int np; float cscale;
    __device__ __forceinline__ bool lds_part() const { return part != nullptr && np == 16; }
    __device__ __forceinline__ void operator()(const f32x4 (&acc)[2][2][4][2], const Unit& u, int wr, int wc, int fr, int fq, const LAS unsigned char* lp) const {
        { const int ln_ = opaque_tid() & 63; fr = ln_ & 15; fq = ln_ >> 4; }
        const int row0 = u.pm * 256 + wr * 64 + fr, col0 = u.pn * 256 + wc * 32 + 8 * fq;
        float rs[8];
        if (lp) rows_rstd_lds(lp, wr * 64 + fr, fq, rs);
        else if (part) rows_rstd(part, row0, np, fq, rs);
        else {
#pragma unroll
            for (int g = 0; g < 8; ++g) rs[g] = 1.0f; }
#pragma unroll
        for (int ai = 0; ai < 2; ++ai)
#pragma unroll
            for (int m = 0; m < 4; ++m) {
                const int row = row0 + ai * 128 + m * 16;
                const float sc = cscale * rs[ai * 4 + m];
                bf16_t* rowp = O + (size_t)row * ldc + col0;
#pragma unroll
                for (int bj = 0; bj < 2; ++bj) { const f32x4 v0 = acc[ai][bj][m][0] * sc, v1 = acc[ai][bj][m][1] * sc;
                    u32x4 w; w.x = cvt_pk_bf16(v0[0], v0[1]); w.y = cvt_pk_bf16(v0[2], v0[3]); w.z = cvt_pk_bf16(v1[0], v1[1]); w.w = cvt_pk_bf16(v1[2], v1[3]);
                    *(u32x4*)(rowp + bj * 128) = w; }
            }
    }
};
struct EpiSwiglu {
    static constexpr bool PERM = true, LDSPART = true;
    bf16_t* H; const float* part; int np;
    __device__ __forceinline__ bool lds_part() const { return np == 16; }
    __device__ __forceinline__ void operator()(const f32x4 (&acc)[2][2][4][2], const Unit& u, int wr, int wc, int fr, int fq, const LAS unsigned char* lp) const {
        { const int ln_ = opaque_tid() & 63; fr = ln_ & 15; fq = ln_ >> 4; }
        const int row0 = u.pm * 256 + wr * 64 + fr, col0 = u.pn * 128 + wc * 32 + 8 * fq;
        float rsv[8]; if (lp) rows_rstd_lds(lp, wr * 64 + fr, fq, rsv); else rows_rstd(part, row0, np, fq, rsv);
#pragma unroll
        for (int ai = 0; ai < 2; ++ai)
#pragma unroll
            for (int m = 0; m < 4; ++m) {
                const int row = row0 + ai * 128 + m * 16;
                const float rs = rsv[ai * 4 + m], c1 = -1.44269504089f * rs, r2 = rs * rs;
                float o[8];
#pragma unroll
                for (int n = 0; n < 2; ++n) {
                    const f32x4 gv = acc[ai][0][m][n], uv = acc[ai][1][m][n];
                    const f32x4 ev = gv * c1, tv = (gv * uv) * r2;
#pragma unroll
                    for (int j = 0; j < 4; ++j) o[n * 4 + j] = tv[j] * __builtin_amdgcn_rcpf(1.0f + __builtin_amdgcn_exp2f(ev[j]));
                }
                u32x4 w; w.x = cvt_pk_bf16(o[0], o[1]); w.y = cvt_pk_bf16(o[2], o[3]); w.z = cvt_pk_bf16(o[4], o[5]); w.w = cvt_pk_bf16(o[6], o[7]);
                *(u32x4*)(H + (size_t)row * DFF + col0) = w;
            }
    }
};
struct EpiConvIn {
    static constexpr bool PERM = true, LDSPART = true;
    bf16_t* U; bf16_t* Bg; const float* part; int np;
    __device__ __forceinline__ bool lds_part() const { return np == 16; }
    __device__ __forceinline__ void operator()(const f32x4 (&acc)[2][2][4][2], const Unit& u, int wr, int wc, int fr, int fq, const LAS unsigned char* lp) const {
        { const int ln_ = opaque_tid() & 63; fr = ln_ & 15; fq = ln_ >> 4; }
        const int row0 = u.pm * 256 + wr * 64 + fr;
        float rsv[8]; if (lp) rows_rstd_lds(lp, wr * 64 + fr, fq, rsv); else rows_rstd(part, row0, np, fq, rsv);
#pragma unroll
        for (int ai = 0; ai < 2; ++ai)
#pragma unroll
            for (int m = 0; m < 4; ++m) {
                const int row = row0 + ai * 128 + m * 16;
                const float rs = rsv[ai * 4 + m];
                if (u.pn < 8) {
                    const float r2 = rs * rs; float o[8];
#pragma unroll
                    for (int n = 0; n < 2; ++n)
#pragma unroll
                        for (int j = 0; j < 4; ++j) o[n * 4 + j] = acc[ai][0][m][n][j] * acc[ai][1][m][n][j] * r2;
                    u32x4 w; w.x = cvt_pk_bf16(o[0], o[1]); w.y = cvt_pk_bf16(o[2], o[3]); w.z = cvt_pk_bf16(o[4], o[5]); w.w = cvt_pk_bf16(o[6], o[7]);
                    *(u32x4*)(U + (size_t)row * DM + u.pn * 128 + wc * 32 + 8 * fq) = w;
                } else {
#pragma unroll
                    for (int bj = 0; bj < 2; ++bj) { const f32x4 v0 = acc[ai][bj][m][0] * rs, v1 = acc[ai][bj][m][1] * rs;
                        u32x4 w; w.x = cvt_pk_bf16(v0[0], v0[1]); w.y = cvt_pk_bf16(v0[2], v0[3]); w.z = cvt_pk_bf16(v1[0], v1[1]); w.w = cvt_pk_bf16(v1[2], v1[3]);
                        *(u32x4*)(Bg + (size_t)row * DM + (u.pn - 8) * 256 + bj * 128 + wc * 32 + 8 * fq) = w; }
                }
            }
    }
};
struct EpiResid {
    static constexpr bool PERM = true, LDSPART = false;
    __device__ __forceinline__ bool lds_part() const { return false; }
    const float* xin; bf16_t* xb; float* part; float scale;
    __device__ __forceinline__ void operator()(const f32x4 (&acc)[2][2][4][2], const Unit& u, int wr, int wc, int fr, int fq, const LAS unsigned char* lp) const {
        { const int ln_ = opaque_tid() & 63; fr = ln_ & 15; fq = ln_ >> 4; }
        const int row0 = u.pm * 256 + wr * 64 + fr, col0 = u.pn * 256 + wc * 32 + 8 * fq;
        if (xin == nullptr) {
#pragma unroll
            for (int ai = 0; ai < 2; ++ai) {
                u32x4 rb[4][2];
#pragma unroll
                for (int m = 0; m < 4; ++m)
#pragma unroll
                    for (int bj = 0; bj < 2; ++bj) rb[m][bj] = *(const u32x4*)((const char*)xb + (unsigned)((row0 + ai * 128 + m * 16) * DM + col0 + bj * 128) * 2u);
#pragma unroll
                for (int m = 0; m < 4; ++m) {
                    const int row = row0 + ai * 128 + m * 16; float ss = 0.f;
#pragma unroll
                    for (int bj = 0; bj < 2; ++bj) {
                        const u32x4 b4 = rb[m][bj];
                        f32x4 v0, v1; v0[0] = bf_lo(b4.x); v0[1] = bf_hi(b4.x); v0[2] = bf_lo(b4.y); v0[3] = bf_hi(b4.y); v1[0] = bf_lo(b4.z); v1[1] = bf_hi(b4.z); v1[2] = bf_lo(b4.w); v1[3] = bf_hi(b4.w);
                        v0 = v0 + acc[ai][bj][m][0] * scale; v1 = v1 + acc[ai][bj][m][1] * scale;
                        u32x4 w; w.x = cvt_pk_bf16(v0[0], v0[1]); w.y = cvt_pk_bf16(v0[2], v0[3]); w.z = cvt_pk_bf16(v1[0], v1[1]); w.w = cvt_pk_bf16(v1[2], v1[3]);
                        *(u32x4*)((char*)xb + (unsigned)(row * DM + col0 + bj * 128) * 2u) = w;
                        ss += ((v0[0] * v0[0] + v0[1] * v0[1]) + (v0[2] * v0[2] + v0[3] * v0[3])) + ((v1[0] * v1[0] + v1[1] * v1[1]) + (v1[2] * v1[2] + v1[3] * v1[3]));
                    }
                    ss += shx(ss, 16); ss += shx(ss, 32);
                    if (fq == 0) part[(size_t)row * 32 + u.pn * 4 + wc] = ss;
                }
                asm volatile("" ::: "memory");
            }
        } else {
#pragma unroll
            for (int gp = 0; gp < 4; ++gp) {
                const int ai = gp >> 1;
                f32x4 rb[2][4];
#pragma unroll
                for (int mm = 0; mm < 2; ++mm)
#pragma unroll
                    for (int q = 0; q < 4; ++q) rb[mm][q] = *(const f32x4*)(xin + (size_t)(row0 + ai * 128 + ((gp & 1) * 2 + mm) * 16) * DM + col0 + (q >> 1) * 128 + (q & 1) * 4);
#pragma unroll
                for (int mm = 0; mm < 2; ++mm) {
                    const int m = (gp & 1) * 2 + mm, row = row0 + ai * 128 + m * 16; float ss = 0.f;
#pragma unroll
                    for (int bj = 0; bj < 2; ++bj) {
                        const f32x4 v0 = rb[mm][bj * 2 + 0] + acc[ai][bj][m][0] * scale, v1 = rb[mm][bj * 2 + 1] + acc[ai][bj][m][1] * scale;
                        u32x4 w; w.x = cvt_pk_bf16(v0[0], v0[1]); w.y = cvt_pk_bf16(v0[2], v0[3]); w.z = cvt_pk_bf16(v1[0], v1[1]); w.w = cvt_pk_bf16(v1[2], v1[3]);
                        *(u32x4*)((char*)xb + (unsigned)(row * DM + col0 + bj * 128) * 2u) = w;
                        ss += ((v0[0] * v0[0] + v0[1] * v0[1]) + (v0[2] * v0[2] + v0[3] * v0[3])) + ((v1[0] * v1[0] + v1[1] * v1[1]) + (v1[2] * v1[2] + v1[3] * v1[3]));
                    }
                    ss += shx(ss, 16); ss += shx(ss, 32);
                    if (fq == 0) part[(size_t)row * 32 + u.pn * 4 + wc] = ss;
                }
                asm volatile("" ::: "memory");
            }
        }
    }
};
struct EpiGlu {
    static constexpr bool PERM = true, LDSPART = false;
    __device__ __forceinline__ bool lds_part() const { return false; }
    bf16_t* xb; float* part;
    __device__ __forceinline__ void operator()(const f32x4 (&acc)[2][2][4][2], const Unit& u, int wr, int wc, int fr, int fq, const LAS unsigned char* lp) const {
        { const int ln_ = opaque_tid() & 63; fr = ln_ & 15; fq = ln_ >> 4; }
        const int row0 = u.pm * 256 + wr * 64 + fr, col0 = u.pn * 128 + wc * 32 + 8 * fq;
#pragma unroll
        for (int ai = 0; ai < 2; ++ai) {
            u32x4 rb[4];
#pragma unroll
            for (int m = 0; m < 4; ++m) rb[m] = *(const u32x4*)((const char*)xb + (unsigned)((row0 + ai * 128 + m * 16) * DM + col0) * 2u);
#pragma unroll
            for (int m = 0; m < 4; ++m) {
                const int row = row0 + ai * 128 + m * 16;
                const u32x4 b4 = rb[m];
                f32x4 v0, v1; v0[0] = bf_lo(b4.x); v0[1] = bf_hi(b4.x); v0[2] = bf_lo(b4.y); v0[3] = bf_hi(b4.y); v1[0] = bf_lo(b4.z); v1[1] = bf_hi(b4.z); v1[2] = bf_lo(b4.w); v1[3] = bf_hi(b4.w);
#pragma unroll
                for (int j = 0; j < 4; ++j) { v0[j] += acc[ai][0][m][0][j] * fast_sigmoid(acc[ai][1][m][0][j]); v1[j] += acc[ai][0][m][1][j] * fast_sigmoid(acc[ai][1][m][1][j]); }
                u32x4 w; w.x = cvt_pk_bf16(v0[0], v0[1]); w.y = cvt_pk_bf16(v0[2], v0[3]); w.z = cvt_pk_bf16(v1[0], v1[1]); w.w = cvt_pk_bf16(v1[2], v1[3]);
                *(u32x4*)((char*)xb + (unsigned)(row * DM + col0) * 2u) = w;
                float ss = ((v0[0] * v0[0] + v0[1] * v0[1]) + (v0[2] * v0[2] + v0[3] * v0[3])) + ((v1[0] * v1[0] + v1[1] * v1[1]) + (v1[2] * v1[2] + v1[3] * v1[3]));
                ss += shx(ss, 16); ss += shx(ss, 32);
                if (fq == 0) part[(size_t)row * 32 + u.pn * 4 + wc] = ss;
            }
            asm volatile("" ::: "memory");
        }
    }
};

__device__ __forceinline__ int srccol(int kind, int n0) {
    if (kind == 0) return n0;
    const int pn = n0 >> 8, r = n0 & 255, bj = r >> 7, rr = r & 127;
    if (kind == 1) return bj * DFF + 128 * pn + rr;
    if (kind == 2) return n0 < 2048 ? (bj ? 2048 : 0) + 128 * pn + rr : 1024 + (n0 - 2048);
    return bj * 1024 + 128 * pn + rr;
}
__device__ void transpose_job(LAS float* tile, const float* W, int Nsrc, int K, bf16_t* dst, int Ndst, int kind, const float* gain) {
    const int tid = opaque_tid();
    const int tilesK = K >> 7, ntile = tilesK * (Ndst >> 7);
    for (int t = blockIdx.x; t < ntile; t += gridDim.x) {
        const int tn = t / tilesK, tk = t - tn * tilesK, n0 = tn * 128, k0 = tk * 128;
        const int sc = srccol(kind, n0);
        const int c4 = (tid & 31) * 4, kr = tid >> 5;
        f32x4 v[8];
#pragma unroll
        for (int i = 0; i < 8; ++i) v[i] = *(const f32x4*)(W + (size_t)(k0 + kr + 16 * i) * Nsrc + sc + c4);
#pragma unroll
        for (int i = 0; i < 8; ++i) {
            const int k = kr + 16 * i; const float gk = gain ? gain[k0 + k] : 1.0f;
            tile[k * 129 + c4 + 0] = v[i][0] * gk; tile[k * 129 + c4 + 1] = v[i][1] * gk; tile[k * 129 + c4 + 2] = v[i][2] * gk; tile[k * 129 + c4 + 3] = v[i][3] * gk;
        }
        __syncthreads();
#pragma unroll
        for (int i = 0; i < 4; ++i) {
            const int q = tid + NTHREADS * i, n = q >> 4, kc = (q & 15) * 8;
            float f[8];
#pragma unroll
            for (int e = 0; e < 8; ++e) f[e] = tile[(kc + e) * 129 + n];
            u32x4 w; w.x = cvt_pk_bf16(f[0], f[1]); w.y = cvt_pk_bf16(f[2], f[3]); w.z = cvt_pk_bf16(f[4], f[5]); w.w = cvt_pk_bf16(f[6], f[7]);
            *(u32x4*)(dst + (size_t)(n0 + n) * K + k0 + kc) = w;
        }
        __syncthreads();
    }
}

struct Args { const float* in[23]; float* out; unsigned char* ws; };
typedef const __attribute__((address_space(4))) Args* CArgs;
__device__ __forceinline__ CArgs get_args() { CArgs p = (CArgs)__builtin_amdgcn_kernarg_segment_ptr(); asm volatile("" : "+s"(p)); return p; }

__device__ __forceinline__ void sincos_d(double th, double& s, double& c) {
    const double twopi = 6.283185307179586476925;
    const double k = rint(th / twopi); const double r = th - k * twopi;
    const double q = r * 0.125, q2 = q * q;
    double sq = q * (1.0 + q2 * (-1.0 / 6.0 + q2 * (1.0 / 120.0 + q2 * (-1.0 / 5040.0 + q2 * (1.0 / 362880.0 + q2 * (-1.0 / 39916800.0 + q2 * (1.0 / 6227020800.0)))))));
    double cq = 1.0 + q2 * (-0.5 + q2 * (1.0 / 24.0 + q2 * (-1.0 / 720.0 + q2 * (1.0 / 40320.0 + q2 * (-1.0 / 3628800.0 + q2 * (1.0 / 479001600.0 + q2 * (-1.0 / 87178291200.0)))))));
#pragma unroll
    for (int i = 0; i < 3; ++i) { const double s2 = 2.0 * sq * cq, c2 = cq * cq - sq * sq; sq = s2; cq = c2; }
    s = sq; c = cq;
}
__device__ __forceinline__ double exp_d(double x) {
    const double ln2 = 0.693147180559945309417;
    const double k = rint(x / ln2); const double r = x - k * ln2;
    double p = 1.0 + r * (1.0 + r * (0.5 + r * (1.0 / 6.0 + r * (1.0 / 24.0 + r * (1.0 / 120.0 + r * (1.0 / 720.0 + r * (1.0 / 5040.0 + r * (1.0 / 40320.0 + r * (1.0 / 362880.0 + r * (1.0 / 3628800.0 + r * (1.0 / 39916800.0 + r * (1.0 / 479001600.0))))))))))));
    return ldexp(p, (int)k);
}

__device__ __forceinline__ void ssm_disc(CArgs a, int j, int g, int p, double& abr, double& abi, double& cfr, double& cfi) {
    const size_t gp = ((size_t)j * 64 + g) * 64 + p;
    const double lre = fmin((double)a->in[11][gp], -1e-4), lim = (double)a->in[12][gp];
    const double dt = exp_d((double)a->in[13][j * 64 + g]);
    const double mag = exp_d(lre * dt); double sn, cs; sincos_d(lim * dt, sn, cs);
    abr = mag * cs; abi = mag * sn;
    const double den = lre * lre + lim * lim, nre = abr - 1.0, nim = abi;
    cfr = (nre * lre + nim * lim) / den; cfi = (nim * lre - nre * lim) / den;
}
__device__ void prep_phase(LAS unsigned char* lds) {
    LAS float* tile = (LAS float*)lds;
    CArgs ap = get_args();
    unsigned char* ws = ap->ws;
    const float* norm_g = ap->in[2];
    for (int l = 0; l < NLAYER; ++l) {
        const float* g = norm_g + (size_t)l * 5 * DM;
        transpose_job(tile, ap->in[4] + (size_t)l * DM * 2 * DFF, 2 * DFF, DM, (bf16_t*)(ws + WS_UP1 + l * SZ_UP), 2 * DFF, 1, g + 0 * DM);
        transpose_job(tile, ap->in[5] + (size_t)l * DFF * DM, DM, DFF, (bf16_t*)(ws + WS_DN1 + l * SZ_DN), DM, 0, nullptr);
        transpose_job(tile, ap->in[6] + (size_t)l * DM * 2 * DFF, 2 * DFF, DM, (bf16_t*)(ws + WS_UP2 + l * SZ_UP), 2 * DFF, 1, g + 4 * DM);
        transpose_job(tile, ap->in[7] + (size_t)l * DFF * DM, DM, DFF, (bf16_t*)(ws + WS_DN2 + l * SZ_DN), DM, 0, nullptr);
        transpose_job(tile, ap->in[20] + (size_t)l * DM * DM, DM, DM, (bf16_t*)(ws + WS_Q + l * SZ_SQ), DM, 0, g + 2 * DM);
        transpose_job(tile, ap->in[21] + (size_t)l * DM * 2 * DM, 2 * DM, DM, (bf16_t*)(ws + WS_K + l * SZ_SQ), DM, 0, g + 3 * DM);
        transpose_job(tile, ap->in[21] + (size_t)l * DM * 2 * DM + DM, 2 * DM, DM, (bf16_t*)(ws + WS_VT + l * SZ_SQ), DM, 0, g + 3 * DM);
        transpose_job(tile, ap->in[22] + (size_t)l * DM * DM, DM, DM, (bf16_t*)(ws + WS_O + l * SZ_SQ), DM, 0, nullptr);
        if ((l & 1) == 0) {
            const int j = l >> 1;
            transpose_job(tile, ap->in[8] + (size_t)j * DM * 3 * DM, 3 * DM, DM, (bf16_t*)(ws + WS_CIN + j * 3 * SZ_SQ), 3 * DM, 2, g + 1 * DM);
            transpose_job(tile, ap->in[10] + (size_t)j * DM * DM, DM, DM, (bf16_t*)(ws + WS_COUT + j * SZ_SQ), DM, 0, nullptr);
        } else {
            const int j = l >> 1;
            transpose_job(tile, ap->in[19] + (size_t)j * DM * 2 * DM, 2 * DM, DM, (bf16_t*)(ws + WS_GLU + j * 2 * SZ_SQ), 2 * DM, 3, nullptr);
        }
    }
    const int tid0 = opaque_tid(), lane = tid0 & 63, gw = blockIdx.x * 8 + (tid0 >> 6), nw = gridDim.x * 8;
    const float* x = ap->in[0]; bf16_t* xb = (bf16_t*)(ws + WS_XB); float* part = (float*)(ws + WS_PART);
    for (int row = gw; row < T_TOK; row += 2 * nw) {
        f32x4 v[2][4];
#pragma unroll
        for (int rr = 0; rr < 2; ++rr)
#pragma unroll
            for (int i = 0; i < 4; ++i) v[rr][i] = *(const f32x4*)(x + (size_t)(row + rr * nw) * DM + i * 256 + lane * 4);
#pragma unroll
        for (int rr = 0; rr < 2; ++rr) {
            float ss = 0.f;
#pragma unroll
            for (int i = 0; i < 4; ++i) {
                const f32x4 t = v[rr][i];
                u32x2 w; w.x = cvt_pk_bf16(t[0], t[1]); w.y = cvt_pk_bf16(t[2], t[3]);
                *(u32x2*)(xb + (size_t)(row + rr * nw) * DM + i * 256 + lane * 4) = w;
                ss += (t[0] * t[0] + t[1] * t[1]) + (t[2] * t[2] + t[3] * t[3]);
            }
#pragma unroll
            for (int o = 32; o >= 1; o >>= 1) ss += shx(ss, o);
            if (lane < 16) part[(size_t)(row + rr * nw) * 32 + lane] = lane == 0 ? ss : 0.f;
        }
    }
    const float* mem = ap->in[1]; bf16_t* memb = (bf16_t*)(ws + WS_MEMB);
    for (int row = gw; row < NB * MEML; row += nw) {
        f32x4 v[4]; float ss = 0.f;
#pragma unroll
        for (int i = 0; i < 4; ++i) { v[i] = *(const f32x4*)(mem + (size_t)row * DM + i * 256 + lane * 4); ss += (v[i][0] * v[i][0] + v[i][1] * v[i][1]) + (v[i][2] * v[i][2] + v[i][3] * v[i][3]); }
#pragma unroll
        for (int o = 32; o >= 1; o >>= 1) ss += shx(ss, o);
        const float rs = __builtin_amdgcn_rsqf(ss * (1.0f / 1024.0f) + NORM_EPS);
#pragma unroll
        for (int i = 0; i < 4; ++i) { u32x2 w; w.x = cvt_pk_bf16(v[i][0] * rs, v[i][1] * rs); w.y = cvt_pk_bf16(v[i][2] * rs, v[i][3] * rs);
            *(u32x2*)(memb + (size_t)row * DM + i * 256 + lane * 4) = w; }
    }
    float* disc = (float*)(ws + WS_DISC);
    for (int idx = blockIdx.x * NTHREADS + tid0; idx < 2 * 64 * 64; idx += gridDim.x * NTHREADS) {
        double abr, abi, cfr, cfi; ssm_disc(ap, idx >> 12, (idx >> 6) & 63, idx & 63, abr, abi, cfr, cfi);
        double pr = abr, pi = abi;
#pragma unroll
        for (int q = 0; q < 4; ++q) { const double nr = pr * pr - pi * pi, ni = 2.0 * pr * pi; pr = nr; pi = ni; }
        f32x4 v0, v1; v0[0] = (float)abr; v0[1] = (float)abi; v0[2] = (float)cfr; v0[3] = (float)cfi; v1[0] = (float)pr; v1[1] = (float)pi; v1[2] = 0.f; v1[3] = 0.f;
        *(f32x4*)(disc + (size_t)idx * 8) = v0; *(f32x4*)(disc + (size_t)idx * 8 + 4) = v1;
    }
}

__device__ void conv_phase(const bf16_t* U, bf16_t* Bg, const float* cw) {
    const size_t total = (size_t)T_TOK * 128;
    for (size_t idx = (size_t)blockIdx.x * NTHREADS + opaque_tid(); idx < total; idx += (size_t)gridDim.x * NTHREADS) {
        const int t = (int)(idx >> 7), c8 = (int)(idx & 127) * 8, pos = t & (SEQ - 1);
        const size_t off = (size_t)t * DM + c8;
        const u32x4 u0 = *(const u32x4*)(U + off);
        u32x4 u1 = (u32x4){0u, 0u, 0u, 0u}, u2 = (u32x4){0u, 0u, 0u, 0u};
        if (pos >= 1) u1 = *(const u32x4*)(U + off - DM);
        if (pos >= 2) u2 = *(const u32x4*)(U + off - 2 * DM);
        const u32x4 bb = *(const u32x4*)(Bg + off);
        float o[8];
#pragma unroll
        for (int i = 0; i < 4; ++i) {
            const int c = c8 + 2 * i;
            const float w0a = cw[c], w0b = cw[c + 1], w1a = cw[DM + c], w1b = cw[DM + c + 1], w2a = cw[2 * DM + c], w2b = cw[2 * DM + c + 1];
            o[2 * i] = bf_lo(bb[i]) * (w0a * bf_lo(u2[i]) + w1a * bf_lo(u1[i]) + w2a * bf_lo(u0[i]));
            o[2 * i + 1] = bf_hi(bb[i]) * (w0b * bf_hi(u2[i]) + w1b * bf_hi(u1[i]) + w2b * bf_hi(u0[i]));
        }
        u32x4 w; w.x = cvt_pk_bf16(o[0], o[1]); w.y = cvt_pk_bf16(o[2], o[3]); w.z = cvt_pk_bf16(o[4], o[5]); w.w = cvt_pk_bf16(o[6], o[7]);
        *(u32x4*)(Bg + off) = w;
    }
}

constexpr size_t SSM_PU_OFF = (size_t)64 * 2048 * 384 * 2;
constexpr size_t SSM_MQ_OFF = SSM_PU_OFF + (size_t)64 * 2048 * 128 * 4;
constexpr size_t SSM_P_OFF = SSM_MQ_OFF + (size_t)64 * 256 * 384 * 2;
static_assert(SSM_P_OFF + (size_t)64 * 128 * 256 * 2 <= (size_t)T_TOK * DFF * 2, "ssm scratch must fit the hidden buffer");

__device__ void ssm_uprep_phase(const bf16_t* xb, const float* part, const float* gain, bf16_t* U2) {
    const int tid = opaque_tid(), lane = tid & 63, gw = blockIdx.x * 8 + (tid >> 6), nw = gridDim.x * 8;
    const int s = lane & 15, gq = lane >> 4;
    for (int item0 = gw; item0 < 32768; item0 += 2 * nw) {
        f32x4 pp[2][4]; u32x4 xa[2][2];
#pragma unroll
        for (int rr = 0; rr < 2; ++rr) {
            const int item = item0 + rr * nw, g = (item & 15) * 4 + gq, c = (item >> 4) & 127, b = item >> 11, row = b * SEQ + c * 16 + s;
#pragma unroll
            for (int q = 0; q < 4; ++q) pp[rr][q] = *(const f32x4*)(part + (size_t)row * 32 + 4 * q);
            xa[rr][0] = *(const u32x4*)(xb + (size_t)row * DM + g * 16); xa[rr][1] = *(const u32x4*)(xb + (size_t)row * DM + g * 16 + 8);
        }
#pragma unroll
        for (int rr = 0; rr < 2; ++rr) {
            const int item = item0 + rr * nw, g = (item & 15) * 4 + gq, c = (item >> 4) & 127, b = item >> 11;
            float ssq = 0.f;
#pragma unroll
            for (int q = 0; q < 4; ++q) ssq += (pp[rr][q][0] + pp[rr][q][1]) + (pp[rr][q][2] + pp[rr][q][3]);
            const float rs = __builtin_amdgcn_rsqf(ssq * (1.0f / 1024.0f) + NORM_EPS);
            const unsigned xw[8] = {xa[rr][0].x, xa[rr][0].y, xa[rr][0].z, xa[rr][0].w, xa[rr][1].x, xa[rr][1].y, xa[rr][1].z, xa[rr][1].w};
            unsigned w[8];
#pragma unroll
            for (int q4 = 0; q4 < 4; ++q4) {
                const f32x4 gv = *(const f32x4*)(gain + g * 16 + q4 * 4);
                w[q4 * 2] = cvt_pk_bf16(bf_lo(xw[q4 * 2]) * rs * gv[0], bf_hi(xw[q4 * 2]) * rs * gv[1]); w[q4 * 2 + 1] = cvt_pk_bf16(bf_lo(xw[q4 * 2 + 1]) * rs * gv[2], bf_hi(xw[q4 * 2 + 1]) * rs * gv[3]);
            }
            bf16_t* dst = U2 + ((size_t)g * 2048 + b * 128 + c) * 384 + 16 * s;
            *(u32x4*)dst = (u32x4){w[0], w[1], w[2], w[3]}; *(u32x4*)(dst + 8) = (u32x4){w[4], w[5], w[6], w[7]};
        }
    }
}

__device__ void ssm_build_phase(int j, bf16_t* MQ, bf16_t* P, LAS unsigned char* lds) {
    CArgs a = get_args();
    LAS float* ApR = (LAS float*)lds; LAS float* ApI = ApR + 17 * 64;
    LAS float* BbR = ApI + 17 * 64; LAS float* BbI = BbR + 1024;
    LAS float* CR = BbI + 1024; LAS float* CI = CR + 1024; LAS float* Kt = CI + 1024;
    const int tid = opaque_tid();
    for (int item = blockIdx.x; item < 256; item += gridDim.x) {
        const int g = item >> 2, q4 = item & 3;
        if (tid < 64) {
            const int p = tid; const f32x4 dv = *(const f32x4*)((const float*)(a->ws + WS_DISC) + (((size_t)j * 64 + g) * 64 + p) * 8);
            const float abr = dv[0], abi = dv[1], cfr = dv[2], cfi = dv[3];
            float pr = 1.0f, pi = 0.0f;
            for (int n = 0; n <= 16; ++n) { ApR[n * 64 + p] = pr; ApI[n * 64 + p] = pi; const float nr = pr * abr - pi * abi, ni = pr * abi + pi * abr; pr = nr; pi = ni; }
            const size_t gp = ((size_t)j * 64 + g) * 64 + p;
            for (int h = 0; h < 16; ++h) { const float br = a->in[14][gp * 16 + h], bi = a->in[15][gp * 16 + h]; BbR[p * 16 + h] = cfr * br - cfi * bi; BbI[p * 16 + h] = cfr * bi + cfi * br; }
        }
        for (int i = tid; i < 1024; i += NTHREADS) { const size_t ci = ((size_t)j * 64 + g) * 1024 + i; CR[i] = a->in[16][ci]; CI[i] = a->in[17][ci]; }
        __syncthreads();
        for (int e = tid; e < 1024; e += NTHREADS) {
            const int tau = e >> 6, h = 4 * q4 + ((e >> 4) & 3), hp = e & 15; float acc = 0.f;
            for (int p = 0; p < 64; ++p) { const float cr = CR[h * 64 + p], ci = CI[h * 64 + p], ar = ApR[tau * 64 + p], ai = ApI[tau * 64 + p], br = BbR[p * 16 + hp], bi = BbI[p * 16 + hp];
                acc += (cr * ar - ci * ai) * br - (cr * ai + ci * ar) * bi; }
            Kt[e] = acc;
        }
        __syncthreads();
        bf16_t* mq = MQ + (size_t)g * 256 * 384;
        for (int e = tid; e < 64 * 192; e += NTHREADS) {
            const int rl = e / 192, k = (e - rl * 192) * 2, t = rl >> 2, hl = rl & 3, h = 4 * q4 + hl, n = t * 16 + h; float v[2];
#pragma unroll
            for (int q = 0; q < 2; ++q) { const int kk = k + q;
                if (kk < 256) { const int sidx = kk >> 4, hp = kk & 15; v[q] = (sidx <= t) ? Kt[(t - sidx) * 64 + hl * 16 + hp] : 0.f; }
                else if (kk < 320) { const int p = kk - 256; v[q] = CR[h * 64 + p] * ApR[(t + 1) * 64 + p] - CI[h * 64 + p] * ApI[(t + 1) * 64 + p]; }
                else { const int p = kk - 320; v[q] = -(CR[h * 64 + p] * ApI[(t + 1) * 64 + p] + CI[h * 64 + p] * ApR[(t + 1) * 64 + p]); } }
            *(unsigned*)(mq + (size_t)n * 384 + k) = cvt_pk_bf16(v[0], v[1]);
        }
        bf16_t* pp = P + (size_t)g * 128 * 256;
        for (int e = tid; e < 32 * 128; e += NTHREADS) {
            const int rl = e >> 7, k = (e & 127) * 2, im = rl >> 4, p = 16 * q4 + (rl & 15), r = im * 64 + p, sidx = k >> 4; float v[2];
            const float ar = ApR[(15 - sidx) * 64 + p], ai = ApI[(15 - sidx) * 64 + p];
#pragma unroll
            for (int q = 0; q < 2; ++q) { const int hp = (k + q) & 15; const float br = BbR[p * 16 + hp], bi = BbI[p * 16 + hp]; v[q] = im ? (ar * bi + ai * br) : (ar * br - ai * bi); }
            *(unsigned*)(pp + (size_t)r * 256 + k) = cvt_pk_bf16(v[0], v[1]);
        }
        __syncthreads();
    }
}

__device__ void ssm_cscan_phase(int j, const float* PU, bf16_t* U2) {
    CArgs a = get_args();
    const int tid = opaque_tid(), wave = tid >> 6, lane = tid & 63;
    if (wave >= 4) return;
    for (int item = blockIdx.x * 4 + wave; item < NB * 64; item += gridDim.x * 4) {
        const int b = item >> 6, g = item & 63, p = lane;
        const f32x4 dv = *(const f32x4*)((const float*)(a->ws + WS_DISC) + (((size_t)j * 64 + g) * 64 + p) * 8 + 4);
        const float a16r = dv[0], a16i = dv[1];
        float sr = 0.f, si = 0.f;
        const float* pu = PU + ((size_t)g * 2048 + b * 128) * 128 + p;
        bf16_t* uo = U2 + ((size_t)g * 2048 + b * 128) * 384 + 256 + p;
        for (int c0 = 0; c0 < 128; c0 += 32) {
            float lr[32], li[32];
#pragma unroll
            for (int q = 0; q < 32; ++q) { lr[q] = pu[(size_t)(c0 + q) * 128]; li[q] = pu[(size_t)(c0 + q) * 128 + 64]; }
#pragma unroll
            for (int q = 0; q < 32; ++q) {
                uo[(size_t)(c0 + q) * 384] = (bf16_t)(cvt_pk_bf16(sr, 0.f) & 0xffffu); uo[(size_t)(c0 + q) * 384 + 64] = (bf16_t)(cvt_pk_bf16(si, 0.f) & 0xffffu);
                const float nr = a16r * sr - a16i * si + lr[q], ni = a16r * si + a16i * sr + li[q]; sr = nr; si = ni;
            }
        }
    }
}

struct EpiPU {
    static constexpr bool PERM = false, LDSPART = false;
    __device__ __forceinline__ bool lds_part() const { return false; }
    float* PU;
    __device__ __forceinline__ void operator()(const f32x4 (&acc)[2][2][4][2], const Unit& u, int wr, int wc, int fr, int fq, const LAS unsigned char* lp) const {
        { const int ln_ = opaque_tid() & 63; fr = ln_ & 15; fq = ln_ >> 4; }
        const int row0 = u.pm * 256 + wr * 64 + fr, col0 = wc * 32 + 4 * fq;
#pragma unroll
        for (int ai = 0; ai < 2; ++ai)
#pragma unroll
            for (int m = 0; m < 4; ++m)
#pragma unroll
                for (int n = 0; n < 2; ++n) *(f32x4*)(PU + (size_t)(row0 + ai * 128 + m * 16) * 128 + col0 + n * 16) = acc[ai][0][m][n];
    }
};
struct EpiY {
    static constexpr bool PERM = true, LDSPART = false;
    __device__ __forceinline__ bool lds_part() const { return false; }
    const bf16_t* U2; bf16_t* Z; const float* dsk;
    __device__ __forceinline__ void operator()(const f32x4 (&acc)[2][2][4][2], const Unit& u, int wr, int wc, int fr, int fq, const LAS unsigned char* lp) const {
        { const int ln_ = opaque_tid() & 63; fr = ln_ & 15; fq = ln_ >> 4; }
        const int g = u.pm >> 3, rg0 = (u.pm & 7) * 256 + wr * 64 + fr, h0 = 8 * (fq & 1), tq = 2 * wc + (fq >> 1);
        const f32x4 d0 = *(const f32x4*)(dsk + g * 16 + h0), d1 = *(const f32x4*)(dsk + g * 16 + h0 + 4);
#pragma unroll
        for (int gp = 0; gp < 4; ++gp) {
            const int ai = gp >> 1;
            u32x4 uw[2][2];
#pragma unroll
            for (int mm = 0; mm < 2; ++mm)
#pragma unroll
                for (int bj = 0; bj < 2; ++bj) uw[mm][bj] = *(const u32x4*)(U2 + ((size_t)g * 2048 + rg0 + ai * 128 + ((gp & 1) * 2 + mm) * 16) * 384 + 16 * (8 * bj + tq) + h0);
#pragma unroll
            for (int mm = 0; mm < 2; ++mm) {
                const int m = (gp & 1) * 2 + mm;
                const int rg = rg0 + ai * 128 + m * 16, b = rg >> 7, cc = rg & 127;
                bf16_t* zrow = Z + (size_t)(b * SEQ + 16 * cc) * DM + g * 16 + h0;
#pragma unroll
                for (int bj = 0; bj < 2; ++bj) {
                    const u32x4 uv = uw[mm][bj];
                    const f32x4 y0 = acc[ai][bj][m][0], y1 = acc[ai][bj][m][1];
                    u32x4 w;
                    w.x = cvt_pk_bf16(gelu_tanh(y0[0] + d0[0] * bf_lo(uv.x)), gelu_tanh(y0[1] + d0[1] * bf_hi(uv.x)));
                    w.y = cvt_pk_bf16(gelu_tanh(y0[2] + d0[2] * bf_lo(uv.y)), gelu_tanh(y0[3] + d0[3] * bf_hi(uv.y)));
                    w.z = cvt_pk_bf16(gelu_tanh(y1[0] + d1[0] * bf_lo(uv.z)), gelu_tanh(y1[1] + d1[1] * bf_hi(uv.z)));
                    w.w = cvt_pk_bf16(gelu_tanh(y1[2] + d1[2] * bf_lo(uv.w)), gelu_tanh(y1[3] + d1[3] * bf_hi(uv.w)));
                    *(u32x4*)(zrow + (size_t)(8 * bj + tq) * DM) = w;
                }
            }
            asm volatile("" ::: "memory");
        }
    }
};

__device__ void attn_phase(const bf16_t* Q, const bf16_t* Kall, const bf16_t* VT, bf16_t* O, int layer, LAS unsigned char* lds) {
    const int tid0 = opaque_tid(), wave = __builtin_amdgcn_readfirstlane(tid0 >> 6);
    for (int unit = blockIdx.x; unit < NB * 4 * 8; unit += gridDim.x) {
        int lane = tid0 & 63; asm volatile("" : "+v"(lane));
        const int r = lane & 31, h = lane >> 5;
#define ATT_VOFF() int ln_ = tid0 & 63; asm volatile("" : "+v"(ln_)); const int rb = 2 * wave + (ln_ >> 5), cc0 = (ln_ & 31) ^ rb; \
        const unsigned voff_e = (unsigned)(rb * 4096 + cc0 * 8) * 2u, voff_o = (unsigned)(rb * 4096 + (cc0 ^ 16) * 8) * 2u
        const int b = unit >> 5, hd = (unit >> 3) & 3, qt = unit & 7;
        const int t0 = b * SEQ + qt * 256 + wave * 32;
        const bf16_t* qp = Q + (size_t)(t0 + r) * DM + hd * 256 + 8 * h;
        bf16x8 qf[16];
#pragma unroll
        for (int kk = 0; kk < 16; ++kk) qf[kk] = *(const bf16x8*)(qp + 16 * kk);
        __syncthreads();
        {
            ATT_VOFF();
            const char* kb = (const char*)(Kall + (size_t)(b * MEML) * 4096 + layer * 1024 + hd * 256);
#pragma unroll
            for (int it = 0; it < 16; ++it)
                __builtin_amdgcn_global_load_lds((const unsigned*)(kb + (size_t)it * 16 * 4096 * 2 + ((it & 1) ? voff_o : voff_e)), (LAS unsigned*)(lds + (it * 8 + wave) * 1024), 16, 0, 0);
        }
        asm volatile("s_waitcnt vmcnt(0)" ::: "memory");
        __syncthreads();
        bf16x8 pf[8][2]; float mh[4], mrun = -3.0e38f, drun = 0.f;
#pragma unroll
        for (int hf = 0; hf < 4; ++hf) {
            int r = lane & 31, h = lane >> 5; asm volatile("" : "+v"(r), "+v"(h));
            f32x16 s[2];
#pragma unroll
            for (int k4 = 0; k4 < 2; ++k4) {
                const int kt = hf * 2 + k4;
                f32x16 acc;
#pragma unroll
                for (int e = 0; e < 16; ++e) acc[e] = 0.f;
#pragma unroll
                for (int k8 = 0; k8 < 4; ++k8) {
                    bf16x8 af[4];
#pragma unroll
                    for (int i = 0; i < 4; ++i) af[i] = *(const LAS bf16x8*)(lds + (32 * kt + r) * 512 + (((2 * (4 * k8 + i) + h) ^ r) << 4));
                    __builtin_amdgcn_sched_group_barrier(0x100, 4, 0);
                    __builtin_amdgcn_sched_group_barrier(0x008, 4, 0);
                    __builtin_amdgcn_s_setprio(1);
#pragma unroll
                    for (int i = 0; i < 4; ++i) acc = __builtin_amdgcn_mfma_f32_32x32x16_bf16(af[i], qf[4 * k8 + i], acc, 0, 0, 0);
                    __builtin_amdgcn_s_setprio(0);
                }
                s[k4] = acc;
            }
            float mx = -3.0e38f;
#pragma unroll
            for (int k4 = 0; k4 < 2; ++k4)
#pragma unroll
                for (int e = 0; e < 16; ++e) mx = fmaxf(mx, s[k4][e]);
            mx = fmaxf(mx, shx(mx, 32));
            float sum = 0.f;
#pragma unroll
            for (int k4 = 0; k4 < 2; ++k4)
#pragma unroll
                for (int e = 0; e < 16; ++e) { const float pv = __builtin_amdgcn_exp2f(s[k4][e] - mx); s[k4][e] = pv; sum += pv; }
            sum += shx(sum, 32);
            { const float mnew = fmaxf(mrun, mx); drun = drun * __builtin_amdgcn_exp2f(mrun - mnew) + sum * __builtin_amdgcn_exp2f(mx - mnew); mrun = mnew; mh[hf] = mx; }
#pragma unroll
            for (int k4 = 0; k4 < 2; ++k4)
#pragma unroll
                for (int s2 = 0; s2 < 2; ++s2) {
                    u32x4 w;
                    w.x = cvt_pk_bf16(s[k4][8 * s2 + 0], s[k4][8 * s2 + 1]); w.y = cvt_pk_bf16(s[k4][8 * s2 + 2], s[k4][8 * s2 + 3]);
                    w.z = cvt_pk_bf16(s[k4][8 * s2 + 4], s[k4][8 * s2 + 5]); w.w = cvt_pk_bf16(s[k4][8 * s2 + 6], s[k4][8 * s2 + 7]);
                    pf[hf * 2 + k4][s2] = __builtin_bit_cast(bf16x8, w);
                }
        }
        asm volatile("s_waitcnt lgkmcnt(0)" ::: "memory");
        __syncthreads();
        {
            ATT_VOFF();
            const char* vb = (const char*)(VT + (size_t)(layer * 1024 + hd * 256) * 4096 + b * MEML);
#pragma unroll
            for (int it = 0; it < 16; ++it)
                __builtin_amdgcn_global_load_lds((const unsigned*)(vb + (size_t)it * 16 * 4096 * 2 + ((it & 1) ? voff_o : voff_e)), (LAS unsigned*)(lds + (it * 8 + wave) * 1024), 16, 0, 0);
        }
        float fq[4];
        const float inv = 1.0f / drun;
#pragma unroll
        for (int q = 0; q < 4; ++q) fq[q] = __builtin_amdgcn_exp2f(mh[q] - mrun) * inv;
        asm volatile("s_waitcnt vmcnt(0)" ::: "memory");
        __syncthreads();
        bf16_t* op = O + (size_t)(t0 + r) * DM + hd * 256 + 4 * h;
        int rv = lane & 31, hv = lane >> 5; asm volatile("" : "+v"(rv), "+v"(hv));
#pragma unroll
        for (int dt = 0; dt < 8; ++dt) {
            f32x16 ac[4];
#pragma unroll
            for (int q = 0; q < 4; ++q)
#pragma unroll
                for (int e = 0; e < 16; ++e) ac[q][e] = 0.f;
            const LAS unsigned char* rowp = lds + (32 * dt + rv) * 512 + 8 * hv;
#pragma unroll
            for (int kt = 0; kt < 8; ++kt) {
                u32x4 vf[2];
#pragma unroll
                for (int s2 = 0; s2 < 2; ++s2) {
                    const u32x2 lo = *(const LAS u32x2*)(rowp + (((4 * kt + 2 * s2) ^ rv) << 4)), hi = *(const LAS u32x2*)(rowp + (((4 * kt + 2 * s2 + 1) ^ rv) << 4));
                    vf[s2].x = lo.x; vf[s2].y = lo.y; vf[s2].z = hi.x; vf[s2].w = hi.y;
                }
                __builtin_amdgcn_sched_group_barrier(0x100, 4, 0);
                __builtin_amdgcn_sched_group_barrier(0x008, 2, 0);
                __builtin_amdgcn_s_setprio(1);
#pragma unroll
                for (int s2 = 0; s2 < 2; ++s2) ac[kt >> 1] = __builtin_amdgcn_mfma_f32_32x32x16_bf16(__builtin_bit_cast(bf16x8, vf[s2]), pf[kt][s2], ac[kt >> 1], 0, 0, 0);
                __builtin_amdgcn_s_setprio(0);
            }
#pragma unroll
            for (int g4 = 0; g4 < 4; ++g4) {
                float o[4];
#pragma unroll
                for (int e = 0; e < 4; ++e) o[e] = (ac[0][4 * g4 + e] * fq[0] + ac[1][4 * g4 + e] * fq[1]) + (ac[2][4 * g4 + e] * fq[2] + ac[3][4 * g4 + e] * fq[3]);
                u32x2 w; w.x = cvt_pk_bf16(o[0], o[1]); w.y = cvt_pk_bf16(o[2], o[3]);
                *(u32x2*)(op + dt * 32 + 8 * g4) = w;
            }
        }
        asm volatile("s_waitcnt lgkmcnt(0)" ::: "memory");
    }
    __syncthreads();
}

__device__ void final_norm_phase(const bf16_t* xb, float* out, const float* g) {
    const int tid0 = opaque_tid(), lane = tid0 & 63, gw = blockIdx.x * 8 + (tid0 >> 6), nw = gridDim.x * 8;
    f32x4 gg[4];
#pragma unroll
    for (int i = 0; i < 4; ++i) gg[i] = *(const f32x4*)(g + i * 256 + lane * 4);
    for (int row = gw; row < T_TOK; row += 2 * nw) {
        u32x2 b2[2][4];
#pragma unroll
        for (int rr = 0; rr < 2; ++rr)
#pragma unroll
            for (int i = 0; i < 4; ++i) b2[rr][i] = *(const u32x2*)(xb + (size_t)(row + rr * nw) * DM + i * 256 + lane * 4);
#pragma unroll
        for (int rr = 0; rr < 2; ++rr) {
            f32x4 v[4]; float ss = 0.f;
#pragma unroll
            for (int i = 0; i < 4; ++i) {
                v[i][0] = bf_lo(b2[rr][i].x); v[i][1] = bf_hi(b2[rr][i].x); v[i][2] = bf_lo(b2[rr][i].y); v[i][3] = bf_hi(b2[rr][i].y);
                ss += (v[i][0] * v[i][0] + v[i][1] * v[i][1]) + (v[i][2] * v[i][2] + v[i][3] * v[i][3]);
            }
#pragma unroll
            for (int o = 32; o >= 1; o >>= 1) ss += shx(ss, o);
            const float rs = 1.0f / sqrtf(ss * (1.0f / 1024.0f) + NORM_EPS);
#pragma unroll
            for (int i = 0; i < 4; ++i) *(f32x4*)(out + (size_t)(row + rr * nw) * DM + i * 256 + lane * 4) = v[i] * rs * gg[i];
        }
    }
}

__global__ void __launch_bounds__(NTHREADS, 2) mega_fwd(Args a_unused) {
    extern __shared__ __attribute__((aligned(16))) unsigned char lds_raw[];
    LAS unsigned char* lds = (LAS unsigned char*)lds_raw;
    cg::grid_group grid = cg::this_grid();
    const int G = gridDim.x, c = blockIdx.x;
#define WSP(off) (get_args()->ws + (off))
#define XB_ ((bf16_t*)WSP(WS_XB))
#define HB_ ((bf16_t*)WSP(WS_HB))
#define HB2_ ((bf16_t*)WSP(WS_HB + (size_t)T_TOK * DM * 2))
#define PART_ ((float*)WSP(WS_PART))
#define OUT_ (get_args()->out)

    { unsigned* bar0 = (unsigned*)WSP(WS_BAR); if (blockIdx.x == 0 && threadIdx.x < 33) __hip_atomic_store(bar0 + 64 * threadIdx.x, 0u, __ATOMIC_RELAXED, __HIP_MEMORY_SCOPE_AGENT); }
    unsigned bar_k = 0;
#define GRID_BAR() do { bar_k += 1u; grid_barrier((unsigned*)WSP(WS_BAR), bar_k, 16u, (unsigned)G / 16u); } while (0)
    prep_phase(lds);
    grid.sync();
    {
        pg8::StaticOrder S; S.init(4096, 4096, G, c);
        { pg8::Gemm g = pg8::mk_gemm((const bf16_t*)WSP(WS_MEMB), (const bf16_t*)WSP(WS_K), DM); EpiBf16S E{(bf16_t*)WSP(WS_KALL), 4096, nullptr, 0, 1.0f}; pg8::gemm_phase(lds, g, S, E); }
        { pg8::Gemm g = pg8::mk_gemm((const bf16_t*)WSP(WS_VT), (const bf16_t*)WSP(WS_MEMB), DM); EpiBf16S E{(bf16_t*)WSP(WS_VTALL), 4096, nullptr, 0, 1.0f}; pg8::gemm_phase(lds, g, S, E); }
    }
#pragma unroll 1
    for (int l = 0; l < NLAYER; ++l) {
#pragma unroll 1
        for (int pass = 0; pass < 2; ++pass) {
            {
                pg8::StaticOrder S; S.init(T_TOK, 2 * DFF, G, c);
                pg8::Gemm g = pg8::mk_gemm(XB_, (const bf16_t*)WSP((pass ? WS_UP2 : WS_UP1) + l * SZ_UP), DM);
                EpiSwiglu E{HB_, PART_, 16}; pg8::gemm_phase(lds, g, S, E);
            }
            GRID_BAR();
            {
                pg8::StaticOrder S; S.init(T_TOK, DM, G, c);
                pg8::Gemm g = pg8::mk_gemm(HB_, (const bf16_t*)WSP((pass ? WS_DN2 : WS_DN1) + l * SZ_DN), DFF);
                EpiResid E{(l == 0 && pass == 0) ? get_args()->in[0] : (const float*)nullptr, XB_, PART_, 0.5f}; pg8::gemm_phase(lds, g, S, E);
            }
            GRID_BAR();
            if (pass == 0) {
                const int j = l >> 1; int np_q;
                if ((l & 1) == 0) {
                    {
                        pg8::StaticOrder S; S.init(T_TOK, 3 * DM, G, c);
                        pg8::Gemm g = pg8::mk_gemm(XB_, (const bf16_t*)WSP(WS_CIN + j * 3 * SZ_SQ), DM);
                        EpiConvIn E{HB_, HB2_, PART_, 16}; pg8::gemm_phase(lds, g, S, E);
                    }
                    GRID_BAR();
                    conv_phase(HB_, HB2_, get_args()->in[9] + (size_t)j * 3 * DM);
                    GRID_BAR();
                    {
                        pg8::StaticOrder S; S.init(T_TOK, DM, G, c);
                        pg8::Gemm g = pg8::mk_gemm(HB2_, (const bf16_t*)WSP(WS_COUT + j * SZ_SQ), DM);
                        EpiResid E{nullptr, XB_, PART_, 1.0f}; pg8::gemm_phase(lds, g, S, E);
                    }
                    GRID_BAR();
                    np_q = 16;
                } else {
#define U2_ HB_
#define PU_ ((float*)WSP(WS_HB + SSM_PU_OFF))
#define Z_ ((bf16_t*)WSP(WS_HB + SSM_PU_OFF))
#define MQ_ ((bf16_t*)WSP(WS_HB + SSM_MQ_OFF))
#define PM_ ((bf16_t*)WSP(WS_HB + SSM_P_OFF))
                    ssm_uprep_phase(XB_, PART_, get_args()->in[2] + (size_t)(l * 5 + 1) * DM, U2_);
                    ssm_build_phase(j, MQ_, PM_, lds);
                    GRID_BAR();
                    {
                        pg8::GroupOrder S{G, c};
                        pg8::Gemm g{U2_, PM_, 256, 384, (size_t)128 * 256 * 2};
                        EpiPU E{PU_}; pg8::gemm_phase(lds, g, S, E);
                    }
                    GRID_BAR();
                    ssm_cscan_phase(j, PU_, U2_);
                    GRID_BAR();
                    {
                        pg8::GroupOrder S{G, c};
                        pg8::Gemm g{U2_, MQ_, 384, 384, (size_t)256 * 384 * 2};
                        EpiY E{U2_, Z_, get_args()->in[18] + (size_t)j * DM}; pg8::gemm_phase(lds, g, S, E);
                    }
                    GRID_BAR();
                    {
                        pg8::StaticOrder S; S.init(T_TOK, 2 * DM, G, c);
                        pg8::Gemm g = pg8::mk_gemm(Z_, (const bf16_t*)WSP(WS_GLU + j * 2 * SZ_SQ), DM);
                        EpiGlu E{XB_, PART_}; pg8::gemm_phase(lds, g, S, E);
                    }
                    GRID_BAR();
                    np_q = 32;
                }
                {
                    pg8::StaticOrder S; S.init(T_TOK, DM, G, c);
                    pg8::Gemm g = pg8::mk_gemm(XB_, (const bf16_t*)WSP(WS_Q + l * SZ_SQ), DM);
                    EpiBf16S E{HB_, DM, PART_, np_q, 0.0625f * 1.44269504089f}; pg8::gemm_phase(lds, g, S, E);
                }
                GRID_BAR();
                attn_phase(HB_, (const bf16_t*)WSP(WS_KALL), (const bf16_t*)WSP(WS_VTALL), HB2_, l, lds);
                GRID_BAR();
                {
                    pg8::StaticOrder S; S.init(T_TOK, DM, G, c);
                    pg8::Gemm g = pg8::mk_gemm(HB2_, (const bf16_t*)WSP(WS_O + l * SZ_SQ), DM);
                    EpiResid E{nullptr, XB_, PART_, 1.0f}; pg8::gemm_phase(lds, g, S, E);
                }
                GRID_BAR();
            }
        }
    }
    final_norm_phase(XB_, OUT_, get_args()->in[3]);
}

extern "C" void kernel_launch(void* const* d_in, const int* in_sizes, int n_in, void* d_out, int out_size, void* d_ws, size_t ws_size, hipStream_t stream) {
    static int grid_blocks = 0;
    if (grid_blocks == 0) {
        if (n_in != 23 || out_size != T_TOK * DM || ws_size < WS_END) { fprintf(stderr, "kernel_launch: unexpected shapes (n_in %d out %d ws %zu need %zu)\n", n_in, out_size, ws_size, (size_t)WS_END); grid_blocks = -1; return; }
        int dev = 0, cus = 0, per_cu = 0;
        hipGetDevice(&dev);
        hipDeviceGetAttribute(&cus, hipDeviceAttributeMultiprocessorCount, dev);
        if (hipFuncSetAttribute((const void*)mega_fwd, hipFuncAttributeMaxDynamicSharedMemorySize, LDS_BYTES) != hipSuccess) { fprintf(stderr, "kernel_launch: hipFuncSetAttribute failed\n"); grid_blocks = -1; return; }
        if (hipOccupancyMaxActiveBlocksPerMultiprocessor(&per_cu, (const void*)mega_fwd, NTHREADS, LDS_BYTES) != hipSuccess || per_cu < 1) { fprintf(stderr, "kernel_launch: occupancy query gave %d\n", per_cu); per_cu = 1; }
        (void)hipGetLastError();
        grid_blocks = cus * 1;
    }
    if (grid_blocks < 0) return;
    Args a{};
    for (int i = 0; i < 23; ++i) a.in[i] = (const float*)d_in[i];
    a.out = (float*)d_out; a.ws = (unsigned char*)d_ws;
    void* args[] = {&a};
    hipError_t e = hipLaunchCooperativeKernel((const void*)mega_fwd, dim3(grid_blocks), dim3(NTHREADS), args, LDS_BYTES, stream);
    if (e != hipSuccess) fprintf(stderr, "cooperative launch failed: %s (grid %d)\n", hipGetErrorString(e), grid_blocks);
}
```

```cpp
#include <hip/hip_runtime.h>
#include <hip/hip_cooperative_groups.h>
#include <cstdio>
namespace cg = cooperative_groups;

#define LAS __attribute__((address_space(3)))
typedef unsigned short bf16_t;
typedef short bf16x8 __attribute__((ext_vector_type(8)));
typedef float f32x4 __attribute__((ext_vector_type(4)));
typedef float f32x16 __attribute__((ext_vector_type(16)));
typedef unsigned u32x4 __attribute__((ext_vector_type(4)));
typedef unsigned u32x2 __attribute__((ext_vector_type(2)));

constexpr int T_TOK = 32768, DM = 1024, DFF = 2816, SEQ = 2048, NB = 16, MEML = 256, NLAYER = 4;
constexpr int NTHREADS = 512;
constexpr int LDS_BYTES = 131072 + 32768;
constexpr float NORM_EPS = 1e-6f;

constexpr size_t SZ_UP = (size_t)2 * DFF * DM * 2, SZ_DN = (size_t)DM * DFF * 2, SZ_SQ = (size_t)DM * DM * 2;
constexpr size_t WS_UP1 = 0;
constexpr size_t WS_DN1 = WS_UP1 + 4 * SZ_UP;
constexpr size_t WS_UP2 = WS_DN1 + 4 * SZ_DN;
constexpr size_t WS_DN2 = WS_UP2 + 4 * SZ_UP;
constexpr size_t WS_CIN = WS_DN2 + 4 * SZ_DN;
constexpr size_t WS_COUT = WS_CIN + 2 * 3 * SZ_SQ;
constexpr size_t WS_GLU = WS_COUT + 2 * SZ_SQ;
constexpr size_t WS_Q = WS_GLU + 2 * 2 * SZ_SQ;
constexpr size_t WS_K = WS_Q + 4 * SZ_SQ;
constexpr size_t WS_VT = WS_K + 4 * SZ_SQ;
constexpr size_t WS_O = WS_VT + 4 * SZ_SQ;
constexpr size_t WS_XB = WS_O + 4 * SZ_SQ;
constexpr size_t WS_HB = WS_XB + (size_t)T_TOK * DM * 2;
constexpr size_t WS_MEMB = WS_HB + (size_t)T_TOK * DFF * 2;
constexpr size_t WS_KALL = WS_MEMB + (size_t)4096 * DM * 2;
constexpr size_t WS_VTALL = WS_KALL + (size_t)4096 * 4096 * 2;
constexpr size_t WS_PART = WS_VTALL + (size_t)4096 * 4096 * 2;
constexpr size_t WS_DISC = WS_PART + (size_t)T_TOK * 32 * 4;
constexpr size_t WS_BAR = WS_DISC + (size_t)2 * 64 * 64 * 8 * 4;
constexpr size_t WS_END = WS_BAR + 256 * 33;

__device__ __forceinline__ unsigned cvt_pk_bf16(float lo, float hi) { unsigned r; asm volatile("v_cvt_pk_bf16_f32 %0, %1, %2" : "=v"(r) : "v"(lo), "v"(hi)); return r; }
__device__ __forceinline__ float bf_lo(unsigned w) { return __uint_as_float(w << 16); }
__device__ __forceinline__ float bf_hi(unsigned w) { return __uint_as_float(w & 0xffff0000u); }
__device__ __forceinline__ float fast_sigmoid(float x) { return __builtin_amdgcn_rcpf(1.0f + __builtin_amdgcn_exp2f(-1.44269504089f * x)); }
__device__ __forceinline__ float gelu_tanh(float x) { const float a = 1.5957691216f * (x + 0.044715f * x * x * x); return x * fast_sigmoid(a); }

__device__ __forceinline__ void grid_barrier(unsigned* bar, unsigned k, unsigned nsub, unsigned per_sub) {
    asm volatile("s_waitcnt vmcnt(0)" ::: "memory");
    __syncthreads();
    if (threadIdx.x == 0) {
        __builtin_amdgcn_fence(__ATOMIC_RELEASE, "agent");
        asm volatile("s_waitcnt vmcnt(0)" ::: "memory");
        const unsigned old = __hip_atomic_fetch_add(bar + 64 * (1 + (blockIdx.x % nsub)), 1u, __ATOMIC_RELAXED, __HIP_MEMORY_SCOPE_AGENT);
        if (old + 1u == k * per_sub) {
            const unsigned oldt = __hip_atomic_fetch_add(bar, 1u, __ATOMIC_RELAXED, __HIP_MEMORY_SCOPE_AGENT);
            if (oldt + 1u == k * nsub)
                for (unsigned i = 0; i < nsub; ++i) __hip_atomic_store(bar + 64 * (17 + i), k, __ATOMIC_RELAXED, __HIP_MEMORY_SCOPE_AGENT);
        }
        while (__hip_atomic_load(bar + 64 * (17 + (blockIdx.x % nsub)), __ATOMIC_RELAXED, __HIP_MEMORY_SCOPE_AGENT) < k) __builtin_amdgcn_s_sleep(1);
        __builtin_amdgcn_fence(__ATOMIC_ACQUIRE, "agent");
        asm volatile("s_waitcnt vmcnt(0)" ::: "memory");
    }
    __syncthreads();
}
__device__ __forceinline__ float shx(float v, int mask) {
    unsigned m = ~0u; asm volatile("" : "+s"(m));
    const int lane = __builtin_amdgcn_mbcnt_hi(m, __builtin_amdgcn_mbcnt_lo(m, 0));
    return __int_as_float(__builtin_amdgcn_ds_bpermute((lane ^ mask) << 2, __float_as_int(v)));
}
template <class T> __device__ __forceinline__ T* launder(T* p) { asm volatile("" : "+s"(p)); return p; }
__device__ __forceinline__ int opaque_tid() { int t = threadIdx.x; asm volatile("" : "+v"(t)); return t; }

namespace pg8 {
constexpr int BM = 256, BK = 64, HALF = 128, HTB = HALF * BK * 2, STAGE_BYTES = 8 * HTB, NXCD = 8, WGM = 4;
__host__ __device__ __forceinline__ int lds_byte(int r, int c) { const int st = (r >> 4) * 2 + (c >> 5), rr = r & 15, cc = c & 31, ob = rr * 64 + cc * 2; return st * 1024 + (ob ^ (((ob >> 9) & 1) << 5)); }
__host__ __device__ __forceinline__ void stage_rc(int b, int& R, int& C) { const int st = b / 1024, sb = b % 1024, swz = sb ^ (((sb >> 9) & 1) << 5); R = (st >> 1) * 16 + swz / 64; C = (st & 1) * 32 + (swz % 64) / 2; }
__host__ __device__ __forceinline__ int perm32(int rho) { const int n = rho >> 4, i = rho & 15; return 8 * (i >> 2) + 4 * n + (i & 3); }

struct Unit { int pm, pn; };
struct Gemm { const bf16_t* A; const bf16_t* Bt; int K, lda; size_t tstepB; };
__device__ __forceinline__ Gemm mk_gemm(const bf16_t* A, const bf16_t* Bt, int K) { return Gemm{A, Bt, K, K, (size_t)512 * K}; }

struct StaticOrder {
    int nM, nN, nwg, G, c;
    __device__ void init(int M, int N, int G_, int c_) { nM = M / BM; nN = N / BM; nwg = nM * nN; G = G_; c = c_; }
    __device__ bool next(int i, Unit& u) const {
        const long L = (long)i * G + c; if (L >= nwg) return false;
        int wgid = (int)L; { const int q = nwg / NXCD, r = nwg % NXCD, xcd = wgid % NXCD, off = wgid / NXCD; wgid = (xcd < r ? xcd * (q + 1) : r * (q + 1) + (xcd - r) * q) + off; }
        const int nig = WGM * nN, gid = wgid / nig, fm = gid * WGM, gsz = (nM - fm) < WGM ? (nM - fm) : WGM;
        u.pm = fm + ((wgid % nig) % gsz); u.pn = (wgid % nig) / gsz; return true;
    }
};

struct GroupOrder {
    int G, c;
    __device__ bool next(int i, Unit& u) const { const int L = i * G + c; if (L >= 512) return false; u.pm = L; u.pn = L >> 3; return true; }
};

template <class Epi, class Sched>
__device__ __forceinline__ void gemm_phase(LAS unsigned char* lds, const Gemm g, const Sched& S, const Epi& E) {
    const int tid = opaque_tid(), wid = __builtin_amdgcn_readfirstlane(tid >> 6), lane = tid & 63, wr = wid >> 2, wc = wid & 3, fr = lane & 15, fq = lane >> 4;
    const int K = g.K, nt = K / BK;
    unsigned voffA[2], voffB[2];
#pragma unroll
    for (int i = 0; i < 2; ++i) { int R, C; stage_rc(tid * 16 + i * 8192, R, C); const int Rb = Epi::PERM ? ((R & ~31) + perm32(R & 31)) : R;
        voffA[i] = (unsigned)(R * g.lda + C) * 2u; voffB[i] = (unsigned)(Rb * K + C) * 2u; }
    const size_t kstep = (size_t)(BK * 2);
    const size_t hstepA = (size_t)HALF * g.lda * 2, hstepB = (size_t)HALF * K * 2;
    const size_t tstepA = 2 * hstepA, tstepB = g.tstepB;
    const unsigned ldsw = (unsigned)wid * 1024u;
    const int aoff = lds_byte(wr * 64 + fr, fq * 8), boff = lds_byte(wc * 32 + fr, fq * 8);
#define PG8_SA(b, h) (((b) * 2 + (h)) * HTB)
#define PG8_SB(b, h) ((4 + (b) * 2 + (h)) * HTB)
#define PG8_STAGE(bufoff, gbase, voff) do { _Pragma("unroll") for (int _i = 0; _i < 2; ++_i) \
        __builtin_amdgcn_global_load_lds((const unsigned*)((const char*)(gbase) + (voff)[_i]), (LAS unsigned*)(lds + (bufoff) + ldsw + _i * 8192), 16, 0, 0); } while (0)
#define PG8_LDA(dst, b, h) do { _Pragma("unroll") for (int m = 0; m < 4; ++m) _Pragma("unroll") for (int k = 0; k < 2; ++k) dst[m][k] = *(const LAS bf16x8*)(lds + PG8_SA(b, h) + aoff + m * 2048 + k * 1024); } while (0)
#define PG8_LDB(dst, b, h) do { _Pragma("unroll") for (int n = 0; n < 2; ++n) _Pragma("unroll") for (int k = 0; k < 2; ++k) dst[n][k] = *(const LAS bf16x8*)(lds + PG8_SB(b, h) + boff + n * 2048 + k * 1024); } while (0)
#define PG8_MMA(ai, bj, At, Bt) do { __builtin_amdgcn_s_setprio(1); _Pragma("unroll") for (int m = 0; m < 4; ++m) _Pragma("unroll") for (int n = 0; n < 2; ++n) _Pragma("unroll") for (int k = 0; k < 2; ++k) \
        acc[ai][bj][m][n] = __builtin_amdgcn_mfma_f32_16x16x32_bf16(Bt[n][k], At[m][k], acc[ai][bj][m][n], 0, 0, 0); __builtin_amdgcn_s_setprio(0); } while (0)
#define PG8_WAIT_V(n) asm volatile("s_waitcnt vmcnt(" #n ")" ::: "memory")
#define PG8_WAIT_L(n) asm volatile("s_waitcnt lgkmcnt(" #n ")" ::: "memory")
#define PG8_BAR __builtin_amdgcn_s_barrier()
#define PG8_SCHED __builtin_amdgcn_sched_barrier(0)
    const bool lp = Epi::LDSPART && E.lds_part();
#define PG8_PART_DMA(unit, buf) do { if constexpr (Epi::LDSPART) { if (lp) { const char* ps_ = (const char*)E.part + ((size_t)(unit).pm * 256 + 32 * wid) * 128; const unsigned pv_ = (unsigned)((lane >> 2) * 128 + (lane & 3) * 16); \
        __builtin_amdgcn_global_load_lds((const unsigned*)(ps_ + pv_), (LAS unsigned*)(lds + STAGE_BYTES + (buf) * 16384 + (32 * wid) * 64), 16, 0, 0); \
        __builtin_amdgcn_global_load_lds((const unsigned*)(ps_ + 2048 + pv_), (LAS unsigned*)(lds + STAGE_BYTES + (buf) * 16384 + (32 * wid + 16) * 64), 16, 0, 0); } } } while (0)
    Unit cur, nxt; int ui = 0;
    if (!S.next(0, cur)) return;
    f32x4 acc[2][2][4][2];
#pragma unroll
    for (int a = 0; a < 2; ++a)
#pragma unroll
        for (int b = 0; b < 2; ++b)
#pragma unroll
            for (int m = 0; m < 4; ++m)
#pragma unroll
                for (int n = 0; n < 2; ++n) acc[a][b][m][n] = (f32x4){0.f, 0.f, 0.f, 0.f};
    bf16x8 At[4][2], B0[2][2], B1[2][2];
    const char* cA = (const char*)g.A + (size_t)cur.pm * tstepA; const char* cB = (const char*)g.Bt + (size_t)cur.pn * tstepB;
    PG8_PART_DMA(cur, 0);
    PG8_STAGE(PG8_SB(0, 0), cB, voffB); PG8_STAGE(PG8_SA(0, 0), cA, voffA); PG8_STAGE(PG8_SB(0, 1), cB + hstepB, voffB); PG8_STAGE(PG8_SA(0, 1), cA + hstepA, voffA);
    if (wr == 1) PG8_BAR;
    PG8_WAIT_V(4); PG8_BAR;
    PG8_STAGE(PG8_SB(1, 0), cB + kstep, voffB); PG8_STAGE(PG8_SA(1, 0), cA + kstep, voffA); PG8_STAGE(PG8_SB(1, 1), cB + hstepB + kstep, voffB);
    PG8_WAIT_V(6); PG8_BAR;
    for (;;) {
        const bool has_next = S.next(ui + 1, nxt);
        const char* nA = has_next ? (const char*)g.A + (size_t)nxt.pm * tstepA : cA; const char* nB = has_next ? (const char*)g.Bt + (size_t)nxt.pn * tstepB : cB;
        for (int t = 0; t < nt; t += 2) {
            const bool last = (t == nt - 2);
            const char* a1 = cA + (size_t)(t + 1) * kstep;
            const char* a2 = last ? nA : cA + (size_t)(t + 2) * kstep; const char* b2 = last ? nB : cB + (size_t)(t + 2) * kstep;
            const char* a3 = a2 + kstep; const char* b3 = b2 + kstep;
            PG8_LDB(B0, 0, 0); PG8_SCHED; PG8_LDA(At, 0, 0); PG8_STAGE(PG8_SA(1, 1), a1 + hstepA, voffA);
            PG8_WAIT_L(8); PG8_BAR; PG8_WAIT_L(0); PG8_MMA(0, 0, At, B0); PG8_BAR; PG8_SCHED;
            PG8_LDB(B1, 0, 1); PG8_STAGE(PG8_SB(0, 0), b2, voffB);
            PG8_BAR; PG8_WAIT_L(0); PG8_MMA(0, 1, At, B1); PG8_BAR;
            PG8_LDA(At, 0, 1); PG8_STAGE(PG8_SA(0, 0), a2, voffA);
            PG8_BAR; PG8_WAIT_L(0); PG8_MMA(1, 0, At, B0); PG8_BAR; PG8_SCHED;
            PG8_STAGE(PG8_SB(0, 1), b2 + hstepB, voffB);
            PG8_WAIT_V(6); PG8_BAR;
            if (last && has_next) PG8_PART_DMA(nxt, (ui + 1) & 1);
            PG8_MMA(1, 1, At, B1); PG8_BAR;
            PG8_LDB(B0, 1, 0); PG8_SCHED; PG8_LDA(At, 1, 0); PG8_STAGE(PG8_SA(0, 1), a2 + hstepA, voffA);
            PG8_WAIT_L(8); PG8_BAR; PG8_WAIT_L(0); PG8_MMA(0, 0, At, B0); PG8_BAR; PG8_SCHED;
            PG8_LDB(B1, 1, 1); PG8_STAGE(PG8_SB(1, 0), b3, voffB);
            PG8_BAR; PG8_WAIT_L(0); PG8_MMA(0, 1, At, B1); PG8_BAR;
            PG8_LDA(At, 1, 1); PG8_STAGE(PG8_SA(1, 0), a3, voffA);
            PG8_BAR; PG8_WAIT_L(0); PG8_MMA(1, 0, At, B0); PG8_BAR; PG8_SCHED;
            PG8_STAGE(PG8_SB(1, 1), b3 + hstepB, voffB);
            PG8_WAIT_V(6); PG8_BAR; PG8_MMA(1, 1, At, B1); PG8_BAR;
        }
        E(acc, cur, wr, wc, fr, fq, lp ? (const LAS unsigned char*)(lds + STAGE_BYTES + (ui & 1) * 16384) : (const LAS unsigned char*)nullptr);
        if (!has_next) break;
#pragma unroll
        for (int a = 0; a < 2; ++a)
#pragma unroll
            for (int b = 0; b < 2; ++b)
#pragma unroll
                for (int m = 0; m < 4; ++m)
#pragma unroll
                    for (int n = 0; n < 2; ++n) acc[a][b][m][n] = (f32x4){0.f, 0.f, 0.f, 0.f};
        cur = nxt; cA = nA; cB = nB; ++ui;
    }
    PG8_WAIT_V(0);
    if (wr == 0) PG8_BAR;
    PG8_BAR;
#undef PG8_PART_DMA
#undef PG8_SA
#undef PG8_SB
#undef PG8_STAGE
#undef PG8_LDA
#undef PG8_LDB
#undef PG8_MMA
#undef PG8_WAIT_V
#undef PG8_WAIT_L
#undef PG8_BAR
#undef PG8_SCHED
}
}
using pg8::Unit;

__device__ __forceinline__ void rows_rstd(const float* part, int row0, int np, int fq, float (&rs)[8]) {
#pragma unroll
    for (int hf = 0; hf < 2; ++hf) {
        f32x4 pa[4], pb[4];
#pragma unroll
        for (int g4 = 0; g4 < 4; ++g4) {
            const float* p = part + (size_t)(row0 + hf * 128 + g4 * 16) * 32;
            if (np == 16) { pa[g4] = *(const f32x4*)(p + 4 * fq); pb[g4] = (f32x4){0.f, 0.f, 0.f, 0.f}; }
            else { pa[g4] = *(const f32x4*)(p + 8 * fq); pb[g4] = *(const f32x4*)(p + 8 * fq + 4); }
        }
#pragma unroll
        for (int g4 = 0; g4 < 4; ++g4) {
            float sm = ((pa[g4][0] + pa[g4][1]) + (pa[g4][2] + pa[g4][3])) + ((pb[g4][0] + pb[g4][1]) + (pb[g4][2] + pb[g4][3]));
            sm += shx(sm, 16); sm += shx(sm, 32);
            rs[hf * 4 + g4] = __builtin_amdgcn_rsqf(sm * (1.0f / 1024.0f) + NORM_EPS);
        }
        if (np != 16) asm volatile("" ::: "memory");
    }
}

__device__ __forceinline__ void rows_rstd_lds(const LAS unsigned char* lp, int rl0, int fq, float (&rs)[8]) {
    f32x4 pa[8];
#pragma unroll
    for (int g = 0; g < 8; ++g) pa[g] = *(const LAS f32x4*)(lp + (rl0 + (g >> 2) * 128 + (g & 3) * 16) * 64 + fq * 16);
#pragma unroll
    for (int g = 0; g < 8; ++g) {
        float sm = (pa[g][0] + pa[g][1]) + (pa[g][2] + pa[g][3]);
        sm += shx(sm, 16); sm += shx(sm, 32);
        rs[g] = __builtin_amdgcn_rsqf(sm * (1.0f / 1024.0f) + NORM_EPS);
    }
}

struct EpiBf16S {
    static constexpr bool PERM = true, LDSPART = true;
    bf16_t* O; int ldc; const float* part; int np; float cscale;
    __device__ __forceinline__ bool lds_part() const { return part != nullptr && np == 16; }
    __device__ __forceinline__ void operator()(const f32x4 (&acc)[2][2][4][2], const Unit& u, int wr, int wc, int fr, int fq, const LAS unsigned char* lp) const {
        { const int ln_ = opaque_tid() & 63; fr = ln_ & 15; fq = ln_ >> 4; }
        const int row0 = u.pm * 256 + wr * 64 + fr, col0 = u.pn * 256 + wc * 32 + 8 * fq;
        float rs[8];
        if (lp) rows_rstd_lds(lp, wr * 64 + fr, fq, rs);
        else if (part) rows_rstd(part, row0, np, fq, rs);
        else {
#pragma unroll
            for (int g = 0; g < 8; ++g) rs[g] = 1.0f; }
#pragma unroll
        for (int ai = 0; ai < 2; ++ai)
#pragma unroll
            for (int m = 0; m < 4; ++m) {
                const int row = row0 + ai * 128 + m * 16;
                const float sc = cscale * rs[ai * 4 + m];
                bf16_t* rowp = O + (size_t)row * ldc + col0;
#pragma unroll
                for (int bj = 0; bj < 2; ++bj) { const f32x4 v0 = acc[ai][bj][m][0] * sc, v1 = acc[ai][bj][m][1] * sc;
                    u32x4 w; w.x = cvt_pk_bf16(v0[0], v0[1]); w.y = cvt_pk_bf16(v0[2], v0[3]); w.z = cvt_pk_bf16(v1[0], v1[1]); w.w = cvt_pk_bf16(v1[2], v1[3]);
                    *(u32x4*)(rowp + bj * 128) = w; }
            }
    }
};
struct EpiSwiglu {
    static constexpr bool PERM = true, LDSPART = true;
    bf16_t* H; const float* part; int np;
    __device__ __forceinline__ bool lds_part() const { return np == 16; }
    __device__ __forceinline__ void operator()(const f32x4 (&acc)[2][2][4][2], const Unit& u, int wr, int wc, int fr, int fq, const LAS unsigned char* lp) const {
        { const int ln_ = opaque_tid() & 63; fr = ln_ & 15; fq = ln_ >> 4; }
        const int row0 = u.pm * 256 + wr * 64 + fr, col0 = u.pn * 128 + wc * 32 + 8 * fq;
        float rsv[8]; if (lp) rows_rstd_lds(lp, wr * 64 + fr, fq, rsv); else rows_rstd(part, row0, np, fq, rsv);
#pragma unroll
        for (int ai = 0; ai < 2; ++ai)
#pragma unroll
            for (int m = 0; m < 4; ++m) {
                const int row = row0 + ai * 128 + m * 16;
                const float rs = rsv[ai * 4 + m], c1 = -1.44269504089f * rs, r2 = rs * rs;
                float o[8];
#pragma unroll
                for (int n = 0; n < 2; ++n) {
                    const f32x4 gv = acc[ai][0][m][n], uv = acc[ai][1][m][n];
                    const f32x4 ev = gv * c1, tv = (gv * uv) * r2;
#pragma unroll
                    for (int j = 0; j < 4; ++j) o[n * 4 + j] = tv[j] * __builtin_amdgcn_rcpf(1.0f + __builtin_amdgcn_exp2f(ev[j]));
                }
                u32x4 w; w.x = cvt_pk_bf16(o[0], o[1]); w.y = cvt_pk_bf16(o[2], o[3]); w.z = cvt_pk_bf16(o[4], o[5]); w.w = cvt_pk_bf16(o[6], o[7]);
                *(u32x4*)(H + (size_t)row * DFF + col0) = w;
            }
    }
};
struct EpiConvIn {
    static constexpr bool PERM = true, LDSPART = true;
    bf16_t* U; bf16_t* Bg; const float* part; int np;
    __device__ __forceinline__ bool lds_part() const { return np == 16; }
    __device__ __forceinline__ void operator()(const f32x4 (&acc)[2][2][4][2], const Unit& u, int wr, int wc, int fr, int fq, const LAS unsigned char* lp) const {
        { const int ln_ = opaque_tid() & 63; fr = ln_ & 15; fq = ln_ >> 4; }
        const int row0 = u.pm * 256 + wr * 64 + fr;
        float rsv[8]; if (lp) rows_rstd_lds(lp, wr * 64 + fr, fq, rsv); else rows_rstd(part, row0, np, fq, rsv);
#pragma unroll
        for (int ai = 0; ai < 2; ++ai)
#pragma unroll
            for (int m = 0; m < 4; ++m) {
                const int row = row0 + ai * 128 + m * 16;
                const float rs = rsv[ai * 4 + m];
                if (u.pn < 8) {
                    const float r2 = rs * rs; float o[8];
#pragma unroll
                    for (int n = 0; n < 2; ++n)
#pragma unroll
                        for (int j = 0; j < 4; ++j) o[n * 4 + j] = acc[ai][0][m][n][j] * acc[ai][1][m][n][j] * r2;
                    u32x4 w; w.x = cvt_pk_bf16(o[0], o[1]); w.y = cvt_pk_bf16(o[2], o[3]); w.z = cvt_pk_bf16(o[4], o[5]); w.w = cvt_pk_bf16(o[6], o[7]);
                    *(u32x4*)(U + (size_t)row * DM + u.pn * 128 + wc * 32 + 8 * fq) = w;
                } else {
#pragma unroll
                    for (int bj = 0; bj < 2; ++bj) { const f32x4 v0 = acc[ai][bj][m][0] * rs, v1 = acc[ai][bj][m][1] * rs;
                        u32x4 w; w.x = cvt_pk_bf16(v0[0], v0[1]); w.y = cvt_pk_bf16(v0[2], v0[3]); w.z = cvt_pk_bf16(v1[0], v1[1]); w.w = cvt_pk_bf16(v1[2], v1[3]);
                        *(u32x4*)(Bg + (size_t)row * DM + (u.pn - 8) * 256 + bj * 128 + wc * 32 + 8 * fq) = w; }
                }
            }
    }
};
struct EpiResid {
    static constexpr bool PERM = true, LDSPART = false;
    __device__ __forceinline__ bool lds_part() const { return false; }
    const float* xin; bf16_t* xb; float* part; float scale;
    __device__ __forceinline__ void operator()(const f32x4 (&acc)[2][2][4][2], const Unit& u, int wr, int wc, int fr, int fq, const LAS unsigned char* lp) const {
        { const int ln_ = opaque_tid() & 63; fr = ln_ & 15; fq = ln_ >> 4; }
        const int row0 = u.pm * 256 + wr * 64 + fr, col0 = u.pn * 256 + wc * 32 + 8 * fq;
        if (xin == nullptr) {
#pragma unroll
            for (int ai = 0; ai < 2; ++ai) {
                u32x4 rb[4][2];
#pragma unroll
                for (int m = 0; m < 4; ++m)
#pragma unroll
                    for (int bj = 0; bj < 2; ++bj) rb[m][bj] = *(const u32x4*)((const char*)xb + (unsigned)((row0 + ai * 128 + m * 16) * DM + col0 + bj * 128) * 2u);
#pragma unroll
                for (int m = 0; m < 4; ++m) {
                    const int row = row0 + ai * 128 + m * 16; float ss = 0.f;
#pragma unroll
                    for (int bj = 0; bj < 2; ++bj) {
                        const u32x4 b4 = rb[m][bj];
                        f32x4 v0, v1; v0[0] = bf_lo(b4.x); v0[1] = bf_hi(b4.x); v0[2] = bf_lo(b4.y); v0[3] = bf_hi(b4.y); v1[0] = bf_lo(b4.z); v1[1] = bf_hi(b4.z); v1[2] = bf_lo(b4.w); v1[3] = bf_hi(b4.w);
                        v0 = v0 + acc[ai][bj][m][0] * scale; v1 = v1 + acc[ai][bj][m][1] * scale;
                        u32x4 w; w.x = cvt_pk_bf16(v0[0], v0[1]); w.y = cvt_pk_bf16(v0[2], v0[3]); w.z = cvt_pk_bf16(v1[0], v1[1]); w.w = cvt_pk_bf16(v1[2], v1[3]);
                        *(u32x4*)((char*)xb + (unsigned)(row * DM + col0 + bj * 128) * 2u) = w;
                        ss += ((v0[0] * v0[0] + v0[1] * v0[1]) + (v0[2] * v0[2] + v0[3] * v0[3])) + ((v1[0] * v1[0] + v1[1] * v1[1]) + (v1[2] * v1[2] + v1[3] * v1[3]));
                    }
                    ss += shx(ss, 16); ss += shx(ss, 32);
                    if (fq == 0) part[(size_t)row * 32 + u.pn * 4 + wc] = ss;
                }
                asm volatile("" ::: "memory");
            }
        } else {
#pragma unroll
            for (int gp = 0; gp < 4; ++gp) {
                const int ai = gp >> 1;
                f32x4 rb[2][4];
#pragma unroll
                for (int mm = 0; mm < 2; ++mm)
#pragma unroll
                    for (int q = 0; q < 4; ++q) rb[mm][q] = *(const f32x4*)(xin + (size_t)(row0 + ai * 128 + ((gp & 1) * 2 + mm) * 16) * DM + col0 + (q >> 1) * 128 + (q & 1) * 4);
#pragma unroll
                for (int mm = 0; mm < 2; ++mm) {
                    const int m = (gp & 1) * 2 + mm, row = row0 + ai * 128 + m * 16; float ss = 0.f;
#pragma unroll
                    for (int bj = 0; bj < 2; ++bj) {
                        const f32x4 v0 = rb[mm][bj * 2 + 0] + acc[ai][bj][m][0] * scale, v1 = rb[mm][bj * 2 + 1] + acc[ai][bj][m][1] * scale;
                        u32x4 w; w.x = cvt_pk_bf16(v0[0], v0[1]); w.y = cvt_pk_bf16(v0[2], v0[3]); w.z = cvt_pk_bf16(v1[0], v1[1]); w.w = cvt_pk_bf16(v1[2], v1[3]);
                        *(u32x4*)((char*)xb + (unsigned)(row * DM + col0 + bj * 128) * 2u) = w;
                        ss += ((v0[0] * v0[0] + v0[1] * v0[1]) + (v0[2] * v0[2] + v0[3] * v0[3])) + ((v1[0] * v1[0] + v1[1] * v1[1]) + (v1[2] * v1[2] + v1[3] * v1[3]));
                    }
                    ss += shx(ss, 16); ss += shx(ss, 32);
                    if (fq == 0) part[(size_t)row * 32 + u.pn * 4 + wc] = ss;
                }
                asm volatile("" ::: "memory");
            }
        }
    }
};
struct EpiGlu {
    static constexpr bool PERM = true, LDSPART = false;
    __device__ __forceinline__ bool lds_part() const { return false; }
    bf16_t* xb; float* part;
    __device__ __forceinline__ void operator()(const f32x4 (&acc)[2][2][4][2], const Unit& u, int wr, int wc, int fr, int fq, const LAS unsigned char* lp) const {
        { const int ln_ = opaque_tid() & 63; fr = ln_ & 15; fq = ln_ >> 4; }
        const int row0 = u.pm * 256 + wr * 64 + fr, col0 = u.pn * 128 + wc * 32 + 8 * fq;
#pragma unroll
        for (int ai = 0; ai < 2; ++ai) {
            u32x4 rb[4];
#pragma unroll
            for (int m = 0; m < 4; ++m) rb[m] = *(const u32x4*)((const char*)xb + (unsigned)((row0 + ai * 128 + m * 16) * DM + col0) * 2u);
#pragma unroll
            for (int m = 0; m < 4; ++m) {
                const int row = row0 + ai * 128 + m * 16;
                const u32x4 b4 = rb[m];
                f32x4 v0, v1; v0[0] = bf_lo(b4.x); v0[1] = bf_hi(b4.x); v0[2] = bf_lo(b4.y); v0[3] = bf_hi(b4.y); v1[0] = bf_lo(b4.z); v1[1] = bf_hi(b4.z); v1[2] = bf_lo(b4.w); v1[3] = bf_hi(b4.w);
#pragma unroll
                for (int j = 0; j < 4; ++j) { v0[j] += acc[ai][0][m][0][j] * fast_sigmoid(acc[ai][1][m][0][j]); v1[j] += acc[ai][0][m][1][j] * fast_sigmoid(acc[ai][1][m][1][j]); }
                u32x4 w; w.x = cvt_pk_bf16(v0[0], v0[1]); w.y = cvt_pk_bf16(v0[2], v0[3]); w.z = cvt_pk_bf16(v1[0], v1[1]); w.w = cvt_pk_bf16(v1[2], v1[3]);
                *(u32x4*)((char*)xb + (unsigned)(row * DM + col0) * 2u) = w;
                float ss = ((v0[0] * v0[0] + v0[1] * v0[1]) + (v0[2] * v0[2] + v0[3] * v0[3])) + ((v1[0] * v1[0] + v1[1] * v1[1]) + (v1[2] * v1[2] + v1[3] * v1[3]));
                ss += shx(ss, 16); ss += shx(ss, 32);
                if (fq == 0) part[(size_t)row * 32 + u.pn * 4 + wc] = ss;
            }
            asm volatile("" ::: "memory");
        }
    }
};

__device__ __forceinline__ int srccol(int kind, int n0) {
    if (kind == 0) return n0;
    const int pn = n0 >> 8, r = n0 & 255, bj = r >> 7, rr = r & 127;
    if (kind == 1) return bj * DFF + 128 * pn + rr;
    if (kind == 2) return n0 < 2048 ? (bj ? 2048 : 0) + 128 * pn + rr : 1024 + (n0 - 2048);
    return bj * 1024 + 128 * pn + rr;
}
__device__ void transpose_job(LAS float* tile, const float* W, int Nsrc, int K, bf16_t* dst, int Ndst, int kind, const float* gain) {
    const int tid = opaque_tid();
    const int tilesK = K >> 7, ntile = tilesK * (Ndst >> 7);
    for (int t = blockIdx.x; t < ntile; t += gridDim.x) {
        const int tn = t / tilesK, tk = t - tn * tilesK, n0 = tn * 128, k0 = tk * 128;
        const int sc = srccol(kind, n0);
        const int c4 = (tid & 31) * 4, kr = tid >> 5;
        f32x4 v[8];
#pragma unroll
        for (int i = 0; i < 8; ++i) v[i] = *(const f32x4*)(W + (size_t)(k0 + kr + 16 * i) * Nsrc + sc + c4);
#pragma unroll
        for (int i = 0; i < 8; ++i) {
            const int k = kr + 16 * i; const float gk = gain ? gain[k0 + k] : 1.0f;
            tile[k * 129 + c4 + 0] = v[i][0] * gk; tile[k * 129 + c4 + 1] = v[i][1] * gk; tile[k * 129 + c4 + 2] = v[i][2] * gk; tile[k * 129 + c4 + 3] = v[i][3] * gk;
        }
        __syncthreads();
#pragma unroll
        for (int i = 0; i < 4; ++i) {
            const int q = tid + NTHREADS * i, n = q >> 4, kc = (q & 15) * 8;
            float f[8];
#pragma unroll
            for (int e = 0; e < 8; ++e) f[e] = tile[(kc + e) * 129 + n];
            u32x4 w; w.x = cvt_pk_bf16(f[0], f[1]); w.y = cvt_pk_bf16(f[2], f[3]); w.z = cvt_pk_bf16(f[4], f[5]); w.w = cvt_pk_bf16(f[6], f[7]);
            *(u32x4*)(dst + (size_t)(n0 + n) * K + k0 + kc) = w;
        }
        __syncthreads();
    }
}

struct Args { const float* in[23]; float* out; unsigned char* ws; };
typedef const __attribute__((address_space(4))) Args* CArgs;
__device__ __forceinline__ CArgs get_args() { CArgs p = (CArgs)__builtin_amdgcn_kernarg_segment_ptr(); asm volatile("" : "+s"(p)); return p; }

__device__ __forceinline__ void sincos_d(double th, double& s, double& c) {
    const double twopi = 6.283185307179586476925;
    const double k = rint(th / twopi); const double r = th - k * twopi;
    const double q = r * 0.125, q2 = q * q;
    double sq = q * (1.0 + q2 * (-1.0 / 6.0 + q2 * (1.0 / 120.0 + q2 * (-1.0 / 5040.0 + q2 * (1.0 / 362880.0 + q2 * (-1.0 / 39916800.0 + q2 * (1.0 / 6227020800.0)))))));
    double cq = 1.0 + q2 * (-0.5 + q2 * (1.0 / 24.0 + q2 * (-1.0 / 720.0 + q2 * (1.0 / 40320.0 + q2 * (-1.0 / 3628800.0 + q2 * (1.0 / 479001600.0 + q2 * (-1.0 / 87178291200.0)))))));
#pragma unroll
    for (int i = 0; i < 3; ++i) { const double s2 = 2.0 * sq * cq, c2 = cq * cq - sq * sq; sq = s2; cq = c2; }
    s = sq; c = cq;
}
__device__ __forceinline__ double exp_d(double x) {
    const double ln2 = 0.693147180559945309417;
    const double k = rint(x / ln2); const double r = x - k * ln2;
    double p = 1.0 + r * (1.0 + r * (0.5 + r * (1.0 / 6.0 + r * (1.0 / 24.0 + r * (1.0 / 120.0 + r * (1.0 / 720.0 + r * (1.0 / 5040.0 + r * (1.0 / 40320.0 + r * (1.0 / 362880.0 + r * (1.0 / 3628800.0 + r * (1.0 / 39916800.0 + r * (1.0 / 479001600.0))))))))))));
    return ldexp(p, (int)k);
}

__device__ __forceinline__ void ssm_disc(CArgs a, int j, int g, int p, double& abr, double& abi, double& cfr, double& cfi) {
    const size_t gp = ((size_t)j * 64 + g) * 64 + p;
    const double lre = fmin((double)a->in[11][gp], -1e-4), lim = (double)a->in[12][gp];
    const double dt = exp_d((double)a->in[13][j * 64 + g]);
    const double mag = exp_d(lre * dt); double sn, cs; sincos_d(lim * dt, sn, cs);
    abr = mag * cs; abi = mag * sn;
    const double den = lre * lre + lim * lim, nre = abr - 1.0, nim = abi;
    cfr = (nre * lre + nim * lim) / den; cfi = (nim * lre - nre * lim) / den;
}
__device__ void prep_phase(LAS unsigned char* lds) {
    LAS float* tile = (LAS float*)lds;
    CArgs ap = get_args();
    unsigned char* ws = ap->ws;
    const float* norm_g = ap->in[2];
    for (int l = 0; l < NLAYER; ++l) {
        const float* g = norm_g + (size_t)l * 5 * DM;
        transpose_job(tile, ap->in[4] + (size_t)l * DM * 2 * DFF, 2 * DFF, DM, (bf16_t*)(ws + WS_UP1 + l * SZ_UP), 2 * DFF, 1, g + 0 * DM);
        transpose_job(tile, ap->in[5] + (size_t)l * DFF * DM, DM, DFF, (bf16_t*)(ws + WS_DN1 + l * SZ_DN), DM, 0, nullptr);
        transpose_job(tile, ap->in[6] + (size_t)l * DM * 2 * DFF, 2 * DFF, DM, (bf16_t*)(ws + WS_UP2 + l * SZ_UP), 2 * DFF, 1, g + 4 * DM);
        transpose_job(tile, ap->in[7] + (size_t)l * DFF * DM, DM, DFF, (bf16_t*)(ws + WS_DN2 + l * SZ_DN), DM, 0, nullptr);
        transpose_job(tile, ap->in[20] + (size_t)l * DM * DM, DM, DM, (bf16_t*)(ws + WS_Q + l * SZ_SQ), DM, 0, g + 2 * DM);
        transpose_job(tile, ap->in[21] + (size_t)l * DM * 2 * DM, 2 * DM, DM, (bf16_t*)(ws + WS_K + l * SZ_SQ), DM, 0, g + 3 * DM);
        transpose_job(tile, ap->in[21] + (size_t)l * DM * 2 * DM + DM, 2 * DM, DM, (bf16_t*)(ws + WS_VT + l * SZ_SQ), DM, 0, g + 3 * DM);
        transpose_job(tile, ap->in[22] + (size_t)l * DM * DM, DM, DM, (bf16_t*)(ws + WS_O + l * SZ_SQ), DM, 0, nullptr);
        if ((l & 1) == 0) {
            const int j = l >> 1;
            transpose_job(tile, ap->in[8] + (size_t)j * DM * 3 * DM, 3 * DM, DM, (bf16_t*)(ws + WS_CIN + j * 3 * SZ_SQ), 3 * DM, 2, g + 1 * DM);
            transpose_job(tile, ap->in[10] + (size_t)j * DM * DM, DM, DM, (bf16_t*)(ws + WS_COUT + j * SZ_SQ), DM, 0, nullptr);
        } else {
            const int j = l >> 1;
            transpose_job(tile, ap->in[19] + (size_t)j * DM * 2 * DM, 2 * DM, DM, (bf16_t*)(ws + WS_GLU + j * 2 * SZ_SQ), 2 * DM, 3, nullptr);
        }
    }
    const int tid0 = opaque_tid(), lane = tid0 & 63, gw = blockIdx.x * 8 + (tid0 >> 6), nw = gridDim.x * 8;
    const float* x = ap->in[0]; bf16_t* xb = (bf16_t*)(ws + WS_XB); float* part = (float*)(ws + WS_PART);
    for (int row = gw; row < T_TOK; row += 2 * nw) {
        f32x4 v[2][4];
#pragma unroll
        for (int rr = 0; rr < 2; ++rr)
#pragma unroll
            for (int i = 0; i < 4; ++i) v[rr][i] = *(const f32x4*)(x + (size_t)(row + rr * nw) * DM + i * 256 + lane * 4);
#pragma unroll
        for (int rr = 0; rr < 2; ++rr) {
            float ss = 0.f;
#pragma unroll
            for (int i = 0; i < 4; ++i) {
                const f32x4 t = v[rr][i];
                u32x2 w; w.x = cvt_pk_bf16(t[0], t[1]); w.y = cvt_pk_bf16(t[2], t[3]);
                *(u32x2*)(xb + (size_t)(row + rr * nw) * DM + i * 256 + lane * 4) = w;
                ss += (t[0] * t[0] + t[1] * t[1]) + (t[2] * t[2] + t[3] * t[3]);
            }
#pragma unroll
            for (int o = 32; o >= 1; o >>= 1) ss += shx(ss, o);
            if (lane < 16) part[(size_t)(row + rr * nw) * 32 + lane] = lane == 0 ? ss : 0.f;
        }
    }
    const float* mem = ap->in[1]; bf16_t* memb = (bf16_t*)(ws + WS_MEMB);
    for (int row = gw; row < NB * MEML; row += nw) {
        f32x4 v[4]; float ss = 0.f;
#pragma unroll
        for (int i = 0; i < 4; ++i) { v[i] = *(const f32x4*)(mem + (size_t)row * DM + i * 256 + lane * 4); ss += (v[i][0] * v[i][0] + v[i][1] * v[i][1]) + (v[i][2] * v[i][2] + v[i][3] * v[i][3]); }
#pragma unroll
        for (int o = 32; o >= 1; o >>= 1) ss += shx(ss, o);
        const float rs = __builtin_amdgcn_rsqf(ss * (1.0f / 1024.0f) + NORM_EPS);
#pragma unroll
        for (int i = 0; i < 4; ++i) { u32x2 w; w.x = cvt_pk_bf16(v[i][0] * rs, v[i][1] * rs); w.y = cvt_pk_bf16(v[i][2] * rs, v[i][3] * rs);
            *(u32x2*)(memb + (size_t)row * DM + i * 256 + lane * 4) = w; }
    }
    float* disc = (float*)(ws + WS_DISC);
    for (int idx = blockIdx.x * NTHREADS + tid0; idx < 2 * 64 * 64; idx += gridDim.x * NTHREADS) {
        double abr, abi, cfr, cfi; ssm_disc(ap, idx >> 12, (idx >> 6) & 63, idx & 63, abr, abi, cfr, cfi);
        double pr = abr, pi = abi;
#pragma unroll
        for (int q = 0; q < 4; ++q) { const double nr = pr * pr - pi * pi, ni = 2.0 * pr * pi; pr = nr; pi = ni; }
        f32x4 v0, v1; v0[0] = (float)abr; v0[1] = (float)abi; v0[2] = (float)cfr; v0[3] = (float)cfi; v1[0] = (float)pr; v1[1] = (float)pi; v1[2] = 0.f; v1[3] = 0.f;
        *(f32x4*)(disc + (size_t)idx * 8) = v0; *(f32x4*)(disc + (size_t)idx * 8 + 4) = v1;
    }
}

__device__ void conv_phase(const bf16_t* U, bf16_t* Bg, const float* cw) {
    const size_t total = (size_t)T_TOK * 128, stride = (size_t)gridDim.x * NTHREADS;
    for (size_t idx0 = (size_t)blockIdx.x * NTHREADS + opaque_tid(); idx0 < total; idx0 += 2 * stride) {
        u32x4 u0[2], u1[2], u2[2], bb[2];
#pragma unroll
        for (int rr = 0; rr < 2; ++rr) {
            const size_t idx = idx0 + rr * stride;
            const int t = (int)(idx >> 7), c8 = (int)(idx & 127) * 8, pos = t & (SEQ - 1);
            const size_t off = (size_t)t * DM + c8;
            u0[rr] = *(const u32x4*)(U + off);
            u1[rr] = (u32x4){0u, 0u, 0u, 0u}; u2[rr] = (u32x4){0u, 0u, 0u, 0u};
            if (pos >= 1) u1[rr] = *(const u32x4*)(U + off - DM);
            if (pos >= 2) u2[rr] = *(const u32x4*)(U + off - 2 * DM);
            bb[rr] = *(const u32x4*)(Bg + off);
        }
#pragma unroll
        for (int rr = 0; rr < 2; ++rr) {
            const size_t idx = idx0 + rr * stride;
            const int t = (int)(idx >> 7), c8 = (int)(idx & 127) * 8;
            const size_t off = (size_t)t * DM + c8;
            float o[8];
#pragma unroll
            for (int i = 0; i < 4; ++i) {
                const int c = c8 + 2 * i;
                const float w0a = cw[c], w0b = cw[c + 1], w1a = cw[DM + c], w1b = cw[DM + c + 1], w2a = cw[2 * DM + c], w2b = cw[2 * DM + c + 1];
                o[2 * i] = bf_lo(bb[rr][i]) * (w0a * bf_lo(u2[rr][i]) + w1a * bf_lo(u1[rr][i]) + w2a * bf_lo(u0[rr][i]));
                o[2 * i + 1] = bf_hi(bb[rr][i]) * (w0b * bf_hi(u2[rr][i]) + w1b * bf_hi(u1[rr][i]) + w2b * bf_hi(u0[rr][i]));
            }
            u32x4 w; w.x = cvt_pk_bf16(o[0], o[1]); w.y = cvt_pk_bf16(o[2], o[3]); w.z = cvt_pk_bf16(o[4], o[5]); w.w = cvt_pk_bf16(o[6], o[7]);
            *(u32x4*)(Bg + off) = w;
        }
    }
}

constexpr size_t SSM_PU_OFF = (size_t)64 * 2048 * 384 * 2;
constexpr size_t SSM_MQ_OFF = SSM_PU_OFF + (size_t)64 * 2048 * 128 * 4;
constexpr size_t SSM_P_OFF = SSM_MQ_OFF + (size_t)64 * 256 * 384 * 2;
static_assert(SSM_P_OFF + (size_t)64 * 128 * 256 * 2 <= (size_t)T_TOK * DFF * 2, "ssm scratch must fit the hidden buffer");

__device__ void ssm_uprep_phase(const bf16_t* xb, const float* part, const float* gain, bf16_t* U2) {
    const int tid = opaque_tid(), lane = tid & 63, gw = blockIdx.x * 8 + (tid >> 6), nw = gridDim.x * 8;
    const int s = lane & 15, gq = lane >> 4;
    for (int item0 = gw; item0 < 32768; item0 += 2 * nw) {
        f32x4 pp[2][4]; u32x4 xa[2][2];
#pragma unroll
        for (int rr = 0; rr < 2; ++rr) {
            const int item = item0 + rr * nw, g = (item & 15) * 4 + gq, c = (item >> 4) & 127, b = item >> 11, row = b * SEQ + c * 16 + s;
#pragma unroll
            for (int q = 0; q < 4; ++q) pp[rr][q] = *(const f32x4*)(part + (size_t)row * 32 + 4 * q);
            xa[rr][0] = *(const u32x4*)(xb + (size_t)row * DM + g * 16); xa[rr][1] = *(const u32x4*)(xb + (size_t)row * DM + g * 16 + 8);
        }
#pragma unroll
        for (int rr = 0; rr < 2; ++rr) {
            const int item = item0 + rr * nw, g = (item & 15) * 4 + gq, c = (item >> 4) & 127, b = item >> 11;
            float ssq = 0.f;
#pragma unroll
            for (int q = 0; q < 4; ++q) ssq += (pp[rr][q][0] + pp[rr][q][1]) + (pp[rr][q][2] + pp[rr][q][3]);
            const float rs = __builtin_amdgcn_rsqf(ssq * (1.0f / 1024.0f) + NORM_EPS);
            const unsigned xw[8] = {xa[rr][0].x, xa[rr][0].y, xa[rr][0].z, xa[rr][0].w, xa[rr][1].x, xa[rr][1].y, xa[rr][1].z, xa[rr][1].w};
            unsigned w[8];
#pragma unroll
            for (int q4 = 0; q4 < 4; ++q4) {
                const f32x4 gv = *(const f32x4*)(gain + g * 16 + q4 * 4);
                w[q4 * 2] = cvt_pk_bf16(bf_lo(xw[q4 * 2]) * rs * gv[0], bf_hi(xw[q4 * 2]) * rs * gv[1]); w[q4 * 2 + 1] = cvt_pk_bf16(bf_lo(xw[q4 * 2 + 1]) * rs * gv[2], bf_hi(xw[q4 * 2 + 1]) * rs * gv[3]);
            }
            bf16_t* dst = U2 + ((size_t)g * 2048 + b * 128 + c) * 384 + 16 * s;
            *(u32x4*)dst = (u32x4){w[0], w[1], w[2], w[3]}; *(u32x4*)(dst + 8) = (u32x4){w[4], w[5], w[6], w[7]};
        }
    }
}

__device__ void ssm_build_phase(int j, bf16_t* MQ, bf16_t* P, LAS unsigned char* lds) {
    CArgs a = get_args();
    LAS float* ApR = (LAS float*)lds; LAS float* ApI = ApR + 17 * 64;
    LAS float* BbR = ApI + 17 * 64; LAS float* BbI = BbR + 1024;
    LAS float* CR = BbI + 1024; LAS float* CI = CR + 1024; LAS float* Kt = CI + 1024;
    const int tid = opaque_tid();
    for (int item = blockIdx.x; item < 256; item += gridDim.x) {
        const int g = item >> 2, q4 = item & 3;
        if (tid < 64) {
            const int p = tid; const f32x4 dv = *(const f32x4*)((const float*)(a->ws + WS_DISC) + (((size_t)j * 64 + g) * 64 + p) * 8);
            const float abr = dv[0], abi = dv[1], cfr = dv[2], cfi = dv[3];
            float pr = 1.0f, pi = 0.0f;
            for (int n = 0; n <= 16; ++n) { ApR[n * 64 + p] = pr; ApI[n * 64 + p] = pi; const float nr = pr * abr - pi * abi, ni = pr * abi + pi * abr; pr = nr; pi = ni; }
            const size_t gp = ((size_t)j * 64 + g) * 64 + p;
            for (int h = 0; h < 16; ++h) { const float br = a->in[14][gp * 16 + h], bi = a->in[15][gp * 16 + h]; BbR[p * 16 + h] = cfr * br - cfi * bi; BbI[p * 16 + h] = cfr * bi + cfi * br; }
        }
        for (int i = tid; i < 1024; i += NTHREADS) { const size_t ci = ((size_t)j * 64 + g) * 1024 + i; CR[i] = a->in[16][ci]; CI[i] = a->in[17][ci]; }
        __syncthreads();
        for (int e = tid; e < 1024; e += NTHREADS) {
            const int tau = e >> 6, h = 4 * q4 + ((e >> 4) & 3), hp = e & 15; float acc = 0.f;
            for (int p = 0; p < 64; ++p) { const float cr = CR[h * 64 + p], ci = CI[h * 64 + p], ar = ApR[tau * 64 + p], ai = ApI[tau * 64 + p], br = BbR[p * 16 + hp], bi = BbI[p * 16 + hp];
                acc += (cr * ar - ci * ai) * br - (cr * ai + ci * ar) * bi; }
            Kt[e] = acc;
        }
        __syncthreads();
        bf16_t* mq = MQ + (size_t)g * 256 * 384;
        for (int e = tid; e < 64 * 192; e += NTHREADS) {
            const int rl = e / 192, k = (e - rl * 192) * 2, t = rl >> 2, hl = rl & 3, h = 4 * q4 + hl, n = t * 16 + h; float v[2];
#pragma unroll
            for (int q = 0; q < 2; ++q) { const int kk = k + q;
                if (kk < 256) { const int sidx = kk >> 4, hp = kk & 15; v[q] = (sidx <= t) ? Kt[(t - sidx) * 64 + hl * 16 + hp] : 0.f; }
                else if (kk < 320) { const int p = kk - 256; v[q] = CR[h * 64 + p] * ApR[(t + 1) * 64 + p] - CI[h * 64 + p] * ApI[(t + 1) * 64 + p]; }
                else { const int p = kk - 320; v[q] = -(CR[h * 64 + p] * ApI[(t + 1) * 64 + p] + CI[h * 64 + p] * ApR[(t + 1) * 64 + p]); } }
            *(unsigned*)(mq + (size_t)n * 384 + k) = cvt_pk_bf16(v[0], v[1]);
        }
        bf16_t* pp = P + (size_t)g * 128 * 256;
        for (int e = tid; e < 32 * 128; e += NTHREADS) {
            const int rl = e >> 7, k = (e & 127) * 2, im = rl >> 4, p = 16 * q4 + (rl & 15), r = im * 64 + p, sidx = k >> 4; float v[2];
            const float ar = ApR[(15 - sidx) * 64 + p], ai = ApI[(15 - sidx) * 64 + p];
#pragma unroll
            for (int q = 0; q < 2; ++q) { const int hp = (k + q) & 15; const float br = BbR[p * 16 + hp], bi = BbI[p * 16 + hp]; v[q] = im ? (ar * bi + ai * br) : (ar * br - ai * bi); }
            *(unsigned*)(pp + (size_t)r * 256 + k) = cvt_pk_bf16(v[0], v[1]);
        }
        __syncthreads();
    }
}

__device__ void ssm_cscan_phase(int j, const float* PU, bf16_t* U2) {
    CArgs a = get_args();
    const int tid = opaque_tid(), wave = tid >> 6, lane = tid & 63;
    if (wave >= 4) return;
    for (int item = blockIdx.x * 4 + wave; item < NB * 64; item += gridDim.x * 4) {
        const int b = item >> 6, g = item & 63, p = lane;
        const f32x4 dv = *(const f32x4*)((const float*)(a->ws + WS_DISC) + (((size_t)j * 64 + g) * 64 + p) * 8 + 4);
        const float a16r = dv[0], a16i = dv[1];
        float sr = 0.f, si = 0.f;
        const float* pu = PU + ((size_t)g * 2048 + b * 128) * 128 + p;
        bf16_t* uo = U2 + ((size_t)g * 2048 + b * 128) * 384 + 256 + p;
        for (int c0 = 0; c0 < 128; c0 += 32) {
            float lr[32], li[32];
#pragma unroll
            for (int q = 0; q < 32; ++q) { lr[q] = pu[(size_t)(c0 + q) * 128]; li[q] = pu[(size_t)(c0 + q) * 128 + 64]; }
#pragma unroll
            for (int q = 0; q < 32; ++q) {
                uo[(size_t)(c0 + q) * 384] = (bf16_t)(cvt_pk_bf16(sr, 0.f) & 0xffffu); uo[(size_t)(c0 + q) * 384 + 64] = (bf16_t)(cvt_pk_bf16(si, 0.f) & 0xffffu);
                const float nr = a16r * sr - a16i * si + lr[q], ni = a16r * si + a16i * sr + li[q]; sr = nr; si = ni;
            }
        }
    }
}

struct EpiPU {
    static constexpr bool PERM = false, LDSPART = false;
    __device__ __forceinline__ bool lds_part() const { return false; }
    float* PU;
    __device__ __forceinline__ void operator()(const f32x4 (&acc)[2][2][4][2], const Unit& u, int wr, int wc, int fr, int fq, const LAS unsigned char* lp) const {
        { const int ln_ = opaque_tid() & 63; fr = ln_ & 15; fq = ln_ >> 4; }
        const int row0 = u.pm * 256 + wr * 64 + fr, col0 = wc * 32 + 4 * fq;
#pragma unroll
        for (int ai = 0; ai < 2; ++ai)
#pragma unroll
            for (int m = 0; m < 4; ++m)
#pragma unroll
                for (int n = 0; n < 2; ++n) *(f32x4*)(PU + (size_t)(row0 + ai * 128 + m * 16) * 128 + col0 + n * 16) = acc[ai][0][m][n];
    }
};
struct EpiY {
    static constexpr bool PERM = true, LDSPART = false;
    __device__ __forceinline__ bool lds_part() const { return false; }
    const bf16_t* U2; bf16_t* Z; const float* dsk;
    __device__ __forceinline__ void operator()(const f32x4 (&acc)[2][2][4][2], const Unit& u, int wr, int wc, int fr, int fq, const LAS unsigned char* lp) const {
        { const int ln_ = opaque_tid() & 63; fr = ln_ & 15; fq = ln_ >> 4; }
        const int g = u.pm >> 3, rg0 = (u.pm & 7) * 256 + wr * 64 + fr, h0 = 8 * (fq & 1), tq = 2 * wc + (fq >> 1);
        const f32x4 d0 = *(const f32x4*)(dsk + g * 16 + h0), d1 = *(const f32x4*)(dsk + g * 16 + h0 + 4);
#pragma unroll
        for (int gp = 0; gp < 4; ++gp) {
            const int ai = gp >> 1;
            u32x4 uw[2][2];
#pragma unroll
            for (int mm = 0; mm < 2; ++mm)
#pragma unroll
                for (int bj = 0; bj < 2; ++bj) uw[mm][bj] = *(const u32x4*)(U2 + ((size_t)g * 2048 + rg0 + ai * 128 + ((gp & 1) * 2 + mm) * 16) * 384 + 16 * (8 * bj + tq) + h0);
#pragma unroll
            for (int mm = 0; mm < 2; ++mm) {
                const int m = (gp & 1) * 2 + mm;
                const int rg = rg0 + ai * 128 + m * 16, b = rg >> 7, cc = rg & 127;
                bf16_t* zrow = Z + (size_t)(b * SEQ + 16 * cc) * DM + g * 16 + h0;
#pragma unroll
                for (int bj = 0; bj < 2; ++bj) {
                    const u32x4 uv = uw[mm][bj];
                    const f32x4 y0 = acc[ai][bj][m][0], y1 = acc[ai][bj][m][1];
                    u32x4 w;
                    w.x = cvt_pk_bf16(gelu_tanh(y0[0] + d0[0] * bf_lo(uv.x)), gelu_tanh(y0[1] + d0[1] * bf_hi(uv.x)));
                    w.y = cvt_pk_bf16(gelu_tanh(y0[2] + d0[2] * bf_lo(uv.y)), gelu_tanh(y0[3] + d0[3] * bf_hi(uv.y)));
                    w.z = cvt_pk_bf16(gelu_tanh(y1[0] + d1[0] * bf_lo(uv.z)), gelu_tanh(y1[1] + d1[1] * bf_hi(uv.z)));
                    w.w = cvt_pk_bf16(gelu_tanh(y1[2] + d1[2] * bf_lo(uv.w)), gelu_tanh(y1[3] + d1[3] * bf_hi(uv.w)));
                    *(u32x4*)(zrow + (size_t)(8 * bj + tq) * DM) = w;
                }
            }
            asm volatile("" ::: "memory");
        }
    }
};

__device__ void attn_phase(const bf16_t* Q, const bf16_t* Kall, const bf16_t* VT, bf16_t* O, int layer, LAS unsigned char* lds) {
    const int tid0 = opaque_tid(), wave = __builtin_amdgcn_readfirstlane(tid0 >> 6);
    for (int unit = blockIdx.x; unit < NB * 4 * 8; unit += gridDim.x) {
        int lane = tid0 & 63; asm volatile("" : "+v"(lane));
        const int r = lane & 31, h = lane >> 5;
#define ATT_VOFF() int ln_ = tid0 & 63; asm volatile("" : "+v"(ln_)); const int rb = 2 * wave + (ln_ >> 5), cc0 = (ln_ & 31) ^ rb; \
        const unsigned voff_e = (unsigned)(rb * 4096 + cc0 * 8) * 2u, voff_o = (unsigned)(rb * 4096 + (cc0 ^ 16) * 8) * 2u
        const int b = unit >> 5, hd = (unit >> 3) & 3, qt = unit & 7;
        const int t0 = b * SEQ + qt * 256 + wave * 32;
        const bf16_t* qp = Q + (size_t)(t0 + r) * DM + hd * 256 + 8 * h;
        bf16x8 qf[16];
#pragma unroll
        for (int kk = 0; kk < 16; ++kk) qf[kk] = *(const bf16x8*)(qp + 16 * kk);
        __syncthreads();
        {
            ATT_VOFF();
            const char* kb = (const char*)(Kall + (size_t)(b * MEML) * 4096 + layer * 1024 + hd * 256);
#pragma unroll
            for (int it = 0; it < 16; ++it)
                __builtin_amdgcn_global_load_lds((const unsigned*)(kb + (size_t)it * 16 * 4096 * 2 + ((it & 1) ? voff_o : voff_e)), (LAS unsigned*)(lds + (it * 8 + wave) * 1024), 16, 0, 0);
        }
        asm volatile("s_waitcnt vmcnt(0)" ::: "memory");
        __syncthreads();
        bf16x8 pf[8][2]; float mh[4], mrun = -3.0e38f, drun = 0.f;
#pragma unroll
        for (int hf = 0; hf < 4; ++hf) {
            int r = lane & 31, h = lane >> 5; asm volatile("" : "+v"(r), "+v"(h));
            f32x16 s[2];
#pragma unroll
            for (int k4 = 0; k4 < 2; ++k4) {
                const int kt = hf * 2 + k4;
                f32x16 acc;
#pragma unroll
                for (int e = 0; e < 16; ++e) acc[e] = 0.f;
#pragma unroll
                for (int k8 = 0; k8 < 4; ++k8) {
                    bf16x8 af[4];
#pragma unroll
                    for (int i = 0; i < 4; ++i) af[i] = *(const LAS bf16x8*)(lds + (32 * kt + r) * 512 + (((2 * (4 * k8 + i) + h) ^ r) << 4));
                    __builtin_amdgcn_sched_group_barrier(0x100, 4, 0);
                    __builtin_amdgcn_sched_group_barrier(0x008, 4, 0);
#pragma unroll
                    for (int i = 0; i < 4; ++i) acc = __builtin_amdgcn_mfma_f32_32x32x16_bf16(af[i], qf[4 * k8 + i], acc, 0, 0, 0);
                }
                s[k4] = acc;
            }
            float mx = -3.0e38f;
#pragma unroll
            for (int k4 = 0; k4 < 2; ++k4)
#pragma unroll
                for (int e = 0; e < 16; ++e) mx = fmaxf(mx, s[k4][e]);
            mx = fmaxf(mx, shx(mx, 32));
            float sum = 0.f;
#pragma unroll
            for (int k4 = 0; k4 < 2; ++k4)
#pragma unroll
                for (int e = 0; e < 16; ++e) { const float pv = __builtin_amdgcn_exp2f(s[k4][e] - mx); s[k4][e] = pv; sum += pv; }
            sum += shx(sum, 32);
            { const float mnew = fmaxf(mrun, mx); drun = drun * __builtin_amdgcn_exp2f(mrun - mnew) + sum * __builtin_amdgcn_exp2f(mx - mnew); mrun = mnew; mh[hf] = mx; }
#pragma unroll
            for (int k4 = 0; k4 < 2; ++k4)
#pragma unroll
                for (int s2 = 0; s2 < 2; ++s2) {
                    u32x4 w;
                    w.x = cvt_pk_bf16(s[k4][8 * s2 + 0], s[k4][8 * s2 + 1]); w.y = cvt_pk_bf16(s[k4][8 * s2 + 2], s[k4][8 * s2 + 3]);
                    w.z = cvt_pk_bf16(s[k4][8 * s2 + 4], s[k4][8 * s2 + 5]); w.w = cvt_pk_bf16(s[k4][8 * s2 + 6], s[k4][8 * s2 + 7]);
                    pf[hf * 2 + k4][s2] = __builtin_bit_cast(bf16x8, w);
                }
        }
        asm volatile("s_waitcnt lgkmcnt(0)" ::: "memory");
        __syncthreads();
        {
            ATT_VOFF();
            const char* vb = (const char*)(VT + (size_t)(layer * 1024 + hd * 256) * 4096 + b * MEML);
#pragma unroll
            for (int it = 0; it < 16; ++it)
                __builtin_amdgcn_global_load_lds((const unsigned*)(vb + (size_t)it * 16 * 4096 * 2 + ((it & 1) ? voff_o : voff_e)), (LAS unsigned*)(lds + (it * 8 + wave) * 1024), 16, 0, 0);
        }
        float fq[4];
        const float inv = 1.0f / drun;
#pragma unroll
        for (int q = 0; q < 4; ++q) fq[q] = __builtin_amdgcn_exp2f(mh[q] - mrun) * inv;
        asm volatile("s_waitcnt vmcnt(0)" ::: "memory");
        __syncthreads();
        bf16_t* op = O + (size_t)(t0 + r) * DM + hd * 256 + 4 * h;
        int rv = lane & 31, hv = lane >> 5; asm volatile("" : "+v"(rv), "+v"(hv));
#pragma unroll
        for (int dt = 0; dt < 8; ++dt) {
            f32x16 ac[4];
#pragma unroll
            for (int q = 0; q < 4; ++q)
#pragma unroll
                for (int e = 0; e < 16; ++e) ac[q][e] = 0.f;
            const LAS unsigned char* rowp = lds + (32 * dt + rv) * 512 + 8 * hv;
#pragma unroll
            for (int kt = 0; kt < 8; ++kt) {
                u32x4 vf[2];
#pragma unroll
                for (int s2 = 0; s2 < 2; ++s2) {
                    const u32x2 lo = *(const LAS u32x2*)(rowp + (((4 * kt + 2 * s2) ^ rv) << 4)), hi = *(const LAS u32x2*)(rowp + (((4 * kt + 2 * s2 + 1) ^ rv) << 4));
                    vf[s2].x = lo.x; vf[s2].y = lo.y; vf[s2].z = hi.x; vf[s2].w = hi.y;
                }
                __builtin_amdgcn_sched_group_barrier(0x100, 4, 0);
                __builtin_amdgcn_sched_group_barrier(0x008, 2, 0);
#pragma unroll
                for (int s2 = 0; s2 < 2; ++s2) ac[kt >> 1] = __builtin_amdgcn_mfma_f32_32x32x16_bf16(__builtin_bit_cast(bf16x8, vf[s2]), pf[kt][s2], ac[kt >> 1], 0, 0, 0);
            }
#pragma unroll
            for (int g4 = 0; g4 < 4; ++g4) {
                float o[4];
#pragma unroll
                for (int e = 0; e < 4; ++e) o[e] = (ac[0][4 * g4 + e] * fq[0] + ac[1][4 * g4 + e] * fq[1]) + (ac[2][4 * g4 + e] * fq[2] + ac[3][4 * g4 + e] * fq[3]);
                u32x2 w; w.x = cvt_pk_bf16(o[0], o[1]); w.y = cvt_pk_bf16(o[2], o[3]);
                *(u32x2*)(op + dt * 32 + 8 * g4) = w;
            }
        }
        asm volatile("s_waitcnt lgkmcnt(0)" ::: "memory");
    }
    __syncthreads();
}

__device__ void final_norm_phase(const bf16_t* xb, float* out, const float* g) {
    const int tid0 = opaque_tid(), lane = tid0 & 63, gw = blockIdx.x * 8 + (tid0 >> 6), nw = gridDim.x * 8;
    f32x4 gg[4];
#pragma unroll
    for (int i = 0; i < 4; ++i) gg[i] = *(const f32x4*)(g + i * 256 + lane * 4);
    for (int row = gw; row < T_TOK; row += 2 * nw) {
        u32x2 b2[2][4];
#pragma unroll
        for (int rr = 0; rr < 2; ++rr)
#pragma unroll
            for (int i = 0; i < 4; ++i) b2[rr][i] = *(const u32x2*)(xb + (size_t)(row + rr * nw) * DM + i * 256 + lane * 4);
#pragma unroll
        for (int rr = 0; rr < 2; ++rr) {
            f32x4 v[4]; float ss = 0.f;
#pragma unroll
            for (int i = 0; i < 4; ++i) {
                v[i][0] = bf_lo(b2[rr][i].x); v[i][1] = bf_hi(b2[rr][i].x); v[i][2] = bf_lo(b2[rr][i].y); v[i][3] = bf_hi(b2[rr][i].y);
                ss += (v[i][0] * v[i][0] + v[i][1] * v[i][1]) + (v[i][2] * v[i][2] + v[i][3] * v[i][3]);
            }
#pragma unroll
            for (int o = 32; o >= 1; o >>= 1) ss += shx(ss, o);
            const float rs = 1.0f / sqrtf(ss * (1.0f / 1024.0f) + NORM_EPS);
#pragma unroll
            for (int i = 0; i < 4; ++i) *(f32x4*)(out + (size_t)(row + rr * nw) * DM + i * 256 + lane * 4) = v[i] * rs * gg[i];
        }
    }
}

__global__ void __launch_bounds__(NTHREADS, 2) mega_fwd(Args a_unused) {
    extern __shared__ __attribute__((aligned(16))) unsigned char lds_raw[];
    LAS unsigned char* lds = (LAS unsigned char*)lds_raw;
    cg::grid_group grid = cg::this_grid();
    const int G = gridDim.x, c = blockIdx.x;
#define WSP(off) (get_args()->ws + (off))
#define XB_ ((bf16_t*)WSP(WS_XB))
#define HB_ ((bf16_t*)WSP(WS_HB))
#define HB2_ ((bf16_t*)WSP(WS_HB + (size_t)T_TOK * DM * 2))
#define PART_ ((float*)WSP(WS_PART))
#define OUT_ (get_args()->out)

    { unsigned* bar0 = (unsigned*)WSP(WS_BAR); if (blockIdx.x == 0 && threadIdx.x < 33) __hip_atomic_store(bar0 + 64 * threadIdx.x, 0u, __ATOMIC_RELAXED, __HIP_MEMORY_SCOPE_AGENT); }
    unsigned bar_k = 0;
#define GRID_BAR() do { bar_k += 1u; grid_barrier((unsigned*)WSP(WS_BAR), bar_k, 16u, (unsigned)G / 16u); } while (0)
    prep_phase(lds);
    grid.sync();
    {
        pg8::StaticOrder S; S.init(4096, 4096, G, c);
        { pg8::Gemm g = pg8::mk_gemm((const bf16_t*)WSP(WS_MEMB), (const bf16_t*)WSP(WS_K), DM); EpiBf16S E{(bf16_t*)WSP(WS_KALL), 4096, nullptr, 0, 1.0f}; pg8::gemm_phase(lds, g, S, E); }
        { pg8::Gemm g = pg8::mk_gemm((const bf16_t*)WSP(WS_VT), (const bf16_t*)WSP(WS_MEMB), DM); EpiBf16S E{(bf16_t*)WSP(WS_VTALL), 4096, nullptr, 0, 1.0f}; pg8::gemm_phase(lds, g, S, E); }
    }
#pragma unroll 1
    for (int l = 0; l < NLAYER; ++l) {
#pragma unroll 1
        for (int pass = 0; pass < 2; ++pass) {
            {
                pg8::StaticOrder S; S.init(T_TOK, 2 * DFF, G, c);
                pg8::Gemm g = pg8::mk_gemm(XB_, (const bf16_t*)WSP((pass ? WS_UP2 : WS_UP1) + l * SZ_UP), DM);
                EpiSwiglu E{HB_, PART_, 16}; pg8::gemm_phase(lds, g, S, E);
            }
            GRID_BAR();
            {
                pg8::StaticOrder S; S.init(T_TOK, DM, G, c);
                pg8::Gemm g = pg8::mk_gemm(HB_, (const bf16_t*)WSP((pass ? WS_DN2 : WS_DN1) + l * SZ_DN), DFF);
                EpiResid E{(l == 0 && pass == 0) ? get_args()->in[0] : (const float*)nullptr, XB_, PART_, 0.5f}; pg8::gemm_phase(lds, g, S, E);
            }
            GRID_BAR();
            if (pass == 0) {
                const int j = l >> 1; int np_q;
                if ((l & 1) == 0) {
                    {
                        pg8::StaticOrder S; S.init(T_TOK, 3 * DM, G, c);
                        pg8::Gemm g = pg8::mk_gemm(XB_, (const bf16_t*)WSP(WS_CIN + j * 3 * SZ_SQ), DM);
                        EpiConvIn E{HB_, HB2_, PART_, 16}; pg8::gemm_phase(lds, g, S, E);
                    }
                    GRID_BAR();
                    conv_phase(HB_, HB2_, get_args()->in[9] + (size_t)j * 3 * DM);
                    GRID_BAR();
                    {
                        pg8::StaticOrder S; S.init(T_TOK, DM, G, c);
                        pg8::Gemm g = pg8::mk_gemm(HB2_, (const bf16_t*)WSP(WS_COUT + j * SZ_SQ), DM);
                        EpiResid E{nullptr, XB_, PART_, 1.0f}; pg8::gemm_phase(lds, g, S, E);
                    }
                    GRID_BAR();
                    np_q = 16;
                } else {
#define U2_ HB_
#define PU_ ((float*)WSP(WS_HB + SSM_PU_OFF))
#define Z_ ((bf16_t*)WSP(WS_HB + SSM_PU_OFF))
#define MQ_ ((bf16_t*)WSP(WS_HB + SSM_MQ_OFF))
#define PM_ ((bf16_t*)WSP(WS_HB + SSM_P_OFF))
                    ssm_uprep_phase(XB_, PART_, get_args()->in[2] + (size_t)(l * 5 + 1) * DM, U2_);
                    ssm_build_phase(j, MQ_, PM_, lds);
                    GRID_BAR();
                    {
                        pg8::GroupOrder S{G, c};
                        pg8::Gemm g{U2_, PM_, 256, 384, (size_t)128 * 256 * 2};
                        EpiPU E{PU_}; pg8::gemm_phase(lds, g, S, E);
                    }
                    GRID_BAR();
                    ssm_cscan_phase(j, PU_, U2_);
                    GRID_BAR();
                    {
                        pg8::GroupOrder S{G, c};
                        pg8::Gemm g{U2_, MQ_, 384, 384, (size_t)256 * 384 * 2};
                        EpiY E{U2_, Z_, get_args()->in[18] + (size_t)j * DM}; pg8::gemm_phase(lds, g, S, E);
                    }
                    GRID_BAR();
                    {
                        pg8::StaticOrder S; S.init(T_TOK, 2 * DM, G, c);
                        pg8::Gemm g = pg8::mk_gemm(Z_, (const bf16_t*)WSP(WS_GLU + j * 2 * SZ_SQ), DM);
                        EpiGlu E{XB_, PART_}; pg8::gemm_phase(lds, g, S, E);
                    }
                    GRID_BAR();
                    np_q = 32;
                }
                {
                    pg8::StaticOrder S; S.init(T_TOK, DM, G, c);
                    pg8::Gemm g = pg8::mk_gemm(XB_, (const bf16_t*)WSP(WS_Q + l * SZ_SQ), DM);
                    EpiBf16S E{HB_, DM, PART_, np_q, 0.0625f * 1.44269504089f}; pg8::gemm_phase(lds, g, S, E);
                }
                GRID_BAR();
                attn_phase(HB_, (const bf16_t*)WSP(WS_KALL), (const bf16_t*)WSP(WS_VTALL), HB2_, l, lds);
                GRID_BAR();
                {
                    pg8::StaticOrder S; S.init(T_TOK, DM, G, c);
                    pg8::Gemm g = pg8::mk_gemm(HB2_, (const bf16_t*)WSP(WS_O + l * SZ_SQ), DM);
                    EpiResid E{nullptr, XB_, PART_, 1.0f}; pg8::gemm_phase(lds, g, S, E);
                }
                GRID_BAR();
            }
        }
    }
    final_norm_phase(XB_, OUT_, get_args()->in[3]);
}

extern "C" void kernel_launch(void* const* d_in, const int* in_sizes, int n_in, void* d_out, int out_size, void* d_ws, size_t ws_size, hipStream_t stream) {
    static int grid_blocks = 0;
    if (grid_blocks == 0) {
        if (n_in != 23 || out_size != T_TOK * DM || ws_size < WS_END) { fprintf(stderr, "kernel_launch: unexpected shapes (n_in %d out %d ws %zu need %zu)\n", n_in, out_size, ws_size, (size_t)WS_END); grid_blocks = -1; return; }
        int dev = 0, cus = 0, per_cu = 0;
        hipGetDevice(&dev);
        hipDeviceGetAttribute(&cus, hipDeviceAttributeMultiprocessorCount, dev);
        if (hipFuncSetAttribute((const void*)mega_fwd, hipFuncAttributeMaxDynamicSharedMemorySize, LDS_BYTES) != hipSuccess) { fprintf(stderr, "kernel_launch: hipFuncSetAttribute failed\n"); grid_blocks = -1; return; }
        if (hipOccupancyMaxActiveBlocksPerMultiprocessor(&per_cu, (const void*)mega_fwd, NTHREADS, LDS_BYTES) != hipSuccess || per_cu < 1) { fprintf(stderr, "kernel_launch: occupancy query gave %d\n", per_cu); per_cu = 1; }
        (void)hipGetLastError();
        grid_blocks = cus * 1;
    }
    if (grid_blocks < 0) return;
    Args a{};
    for (int i = 0; i < 23; ++i) a.in[i] = (const float*)d_in[i];
    a.out = (float*)d_out; a.ws = (unsigned char*)d_ws;
    void* args[] = {&a};
    hipError_t e = hipLaunchCooperativeKernel((const void*)mega_fwd, dim3(grid_blocks), dim3(NTHREADS), args, LDS_BYTES, stream);
    if (e != hipSuccess) fprintf(stderr, "cooperative launch failed: %s (grid %d)\n", hipGetErrorString(e), grid_blocks);
}
```

```cpp
#include <hip/hip_runtime.h>
#include <hip/hip_cooperative_groups.h>
#include <cstdio>
namespace cg = cooperative_groups;

#define LAS __attribute__((address_space(3)))
typedef unsigned short bf16_t;
typedef short bf16x8 __attribute__((ext_vector_type(8)));
typedef float f32x4 __attribute__((ext_vector_type(4)));
typedef float f32x16 __attribute__((ext_vector_type(16)));
typedef unsigned u32x4 __attribute__((ext_vector_type(4)));
typedef unsigned u32x2 __attribute__((ext_vector_type(2)));

constexpr int T_TOK = 32768, DM = 1024, DFF = 2816, SEQ = 2048, NB = 16, MEML = 256, NLAYER = 4;
constexpr int NTHREADS = 512;
constexpr int LDS_BYTES = 131072 + 32768;
constexpr float NORM_EPS = 1e-6f;

constexpr size_t SZ_UP = (size_t)2 * DFF * DM * 2, SZ_DN = (size_t)DM * DFF * 2, SZ_SQ = (size_t)DM * DM * 2;
constexpr size_t WS_UP1 = 0;
constexpr size_t WS_DN1 = WS_UP1 + 4 * SZ_UP;
constexpr size_t WS_UP2 = WS_DN1 + 4 * SZ_DN;
constexpr size_t WS_DN2 = WS_UP2 + 4 * SZ_UP;
constexpr size_t WS_CIN = WS_DN2 + 4 * SZ_DN;
constexpr size_t WS_COUT = WS_CIN + 2 * 3 * SZ_SQ;
constexpr size_t WS_GLU = WS_COUT + 2 * SZ_SQ;
constexpr size_t WS_Q = WS_GLU + 2 * 2 * SZ_SQ;
constexpr size_t WS_K = WS_Q + 4 * SZ_SQ;
constexpr size_t WS_VT = WS_K + 4 * SZ_SQ;
constexpr size_t WS_O = WS_VT + 4 * SZ_SQ;
constexpr size_t WS_XB = WS_O + 4 * SZ_SQ;
constexpr size_t WS_HB = WS_XB + (size_t)T_TOK * DM * 2;
constexpr size_t WS_MEMB = WS_HB + (size_t)T_TOK * DFF * 2;
constexpr size_t WS_KALL = WS_MEMB + (size_t)4096 * DM * 2;
constexpr size_t WS_VTALL = WS_KALL + (size_t)4096 * 4096 * 2;
constexpr size_t WS_PART = WS_VTALL + (size_t)4096 * 4096 * 2;
constexpr size_t WS_DISC = WS_PART + (size_t)T_TOK * 32 * 4;
constexpr size_t WS_BAR = WS_DISC + (size_t)2 * 64 * 64 * 8 * 4;
constexpr size_t WS_END = WS_BAR + 256 * 33;

__device__ __forceinline__ unsigned cvt_pk_bf16(float lo, float hi) { unsigned r; asm volatile("v_cvt_pk_bf16_f32 %0, %1, %2" : "=v"(r) : "v"(lo), "v"(hi)); return r; }
__device__ __forceinline__ float bf_lo(unsigned w) { return __uint_as_float(w << 16); }
__device__ __forceinline__ float bf_hi(unsigned w) { return __uint_as_float(w & 0xffff0000u); }
__device__ __forceinline__ float fast_sigmoid(float x) { return __builtin_amdgcn_rcpf(1.0f + __builtin_amdgcn_exp2f(-1.44269504089f * x)); }
__device__ __forceinline__ float gelu_tanh(float x) { const float a = 1.5957691216f * (x + 0.044715f * x * x * x); return x * fast_sigmoid(a); }

__device__ __forceinline__ void grid_barrier(unsigned* bar, unsigned k, unsigned nsub, unsigned per_sub) {
    asm volatile("s_waitcnt vmcnt(0)" ::: "memory");
    __syncthreads();
    if (threadIdx.x == 0) {
        __builtin_amdgcn_fence(__ATOMIC_RELEASE, "agent");
        asm volatile("s_waitcnt vmcnt(0)" ::: "memory");
        const unsigned old = __hip_atomic_fetch_add(bar + 64 * (1 + (blockIdx.x % nsub)), 1u, __ATOMIC_RELAXED, __HIP_MEMORY_SCOPE_AGENT);
        if (old + 1u == k * per_sub) {
            const unsigned oldt = __hip_atomic_fetch_add(bar, 1u, __ATOMIC_RELAXED, __HIP_MEMORY_SCOPE_AGENT);
            if (oldt + 1u == k * nsub)
                for (unsigned i = 0; i < nsub; ++i) __hip_atomic_store(bar + 64 * (17 + i), k, __ATOMIC_RELAXED, __HIP_MEMORY_SCOPE_AGENT);
        }
        while (__hip_atomic_load(bar + 64 * (17 + (blockIdx.x % nsub)), __ATOMIC_RELAXED, __HIP_MEMORY_SCOPE_AGENT) < k) __builtin_amdgcn_s_sleep(1);
        __builtin_amdgcn_fence(__ATOMIC_ACQUIRE, "agent");
        asm volatile("s_waitcnt vmcnt(0)" ::: "memory");
    }
    __syncthreads();
}
__device__ __forceinline__ float shx(float v, int mask) {
    unsigned m = ~0u; asm volatile("" : "+s"(m));
    const int lane = __builtin_amdgcn_mbcnt_hi(m, __builtin_amdgcn_mbcnt_lo(m, 0));
    return __int_as_float(__builtin_amdgcn_ds_bpermute((lane ^ mask) << 2, __float_as_int(v)));
}
template <class T> __device__ __forceinline__ T* launder(T* p) { asm volatile("" : "+s"(p)); return p; }
__device__ __forceinline__ int opaque_tid() { int t = threadIdx.x; asm volatile("" : "+v"(t)); return t; }

namespace pg8 {
constexpr int BM = 256, BK = 64, HALF = 128, HTB = HALF * BK * 2, STAGE_BYTES = 8 * HTB, NXCD = 8, WGM = 4;
__host__ __device__ __forceinline__ int lds_byte(int r, int c) { const int st = (r >> 4) * 2 + (c >> 5), rr = r & 15, cc = c & 31, ob = rr * 64 + cc * 2; return st * 1024 + (ob ^ (((ob >> 9) & 1) << 5)); }
__host__ __device__ __forceinline__ void stage_rc(int b, int& R, int& C) { const int st = b / 1024, sb = b % 1024, swz = sb ^ (((sb >> 9) & 1) << 5); R = (st >> 1) * 16 + swz / 64; C = (st & 1) * 32 + (swz % 64) / 2; }
__host__ __device__ __forceinline__ int perm32(int rho) { const int n = rho >> 4, i = rho & 15; return 8 * (i >> 2) + 4 * n + (i & 3); }

struct Unit { int pm, pn; };
struct Gemm { const bf16_t* A; const bf16_t* Bt; int K, lda; size_t tstepB; };
__device__ __forceinline__ Gemm mk_gemm(const bf16_t* A, const bf16_t* Bt, int K) { return Gemm{A, Bt, K, K, (size_t)512 * K}; }

struct StaticOrder {
    int nM, nN, nwg, G, c;
    __device__ void init(int M, int N, int G_, int c_) { nM = M / BM; nN = N / BM; nwg = nM * nN; G = G_; c = c_; }
    __device__ bool next(int i, Unit& u) const {
        const long L = (long)i * G + c; if (L >= nwg) return false;
        int wgid = (int)L; { const int q = nwg / NXCD, r = nwg % NXCD, xcd = wgid % NXCD, off = wgid / NXCD; wgid = (xcd < r ? xcd * (q + 1) : r * (q + 1) + (xcd - r) * q) + off; }
        const int nig = WGM * nN, gid = wgid / nig, fm = gid * WGM, gsz = (nM - fm) < WGM ? (nM - fm) : WGM;
        u.pm = fm + ((wgid % nig) % gsz); u.pn = (wgid % nig) / gsz; return true;
    }
};

struct GroupOrder {
    int G, c;
    __device__ bool next(int i, Unit& u) const { const int L = i * G + c; if (L >= 512) return false; u.pm = L; u.pn = L >> 3; return true; }
};

template <class Epi, class Sched>
__device__ __forceinline__ void gemm_phase(LAS unsigned char* lds, const Gemm g, const Sched& S, const Epi& E) {
    const int tid = opaque_tid(), wid = __builtin_amdgcn_readfirstlane(tid >> 6), lane = tid & 63, wr = wid >> 2, wc = wid & 3, fr = lane & 15, fq = lane >> 4;
    const int K = g.K, nt = K / BK;
    unsigned voffA[2], voffB[2];
#pragma unroll
    for (int i = 0; i < 2; ++i) { int R, C; stage_rc(tid * 16 + i * 8192, R, C); const int Rb = Epi::PERM ? ((R & ~31) + perm32(R & 31)) : R;
        voffA[i] = (unsigned)(R * g.lda + C) * 2u; voffB[i] = (unsigned)(Rb * K + C) * 2u; }
    const size_t kstep = (size_t)(BK * 2);
    const size_t hstepA = (size_t)HALF * g.lda * 2, hstepB = (size_t)HALF * K * 2;
    const size_t tstepA = 2 * hstepA, tstepB = g.tstepB;
    const unsigned ldsw = (unsigned)wid * 1024u;
    const int aoff = lds_byte(wr * 64 + fr, fq * 8), boff = lds_byte(wc * 32 + fr, fq * 8);
#define PG8_SA(b, h) (((b) * 2 + (h)) * HTB)
#define PG8_SB(b, h) ((4 + (b) * 2 + (h)) * HTB)
#define PG8_STAGE(bufoff, gbase, voff) do { _Pragma("unroll") for (int _i = 0; _i < 2; ++_i) { unsigned vo_ = (voff)[_i]; asm volatile("" : "+v"(vo_));   \
        __builtin_amdgcn_global_load_lds((const unsigned*)((const char*)(gbase) + vo_), (LAS unsigned*)(lds + (bufoff) + ldsw + _i * 8192), 16, 0, 0); } } while (0)
#define PG8_LDA(dst, b, h) do { _Pragma("unroll") for (int m = 0; m < 4; ++m) _Pragma("unroll") for (int k = 0; k < 2; ++k) dst[m][k] = *(const LAS bf16x8*)(lds + PG8_SA(b, h) + aoff + m * 2048 + k * 1024); } while (0)
#define PG8_LDB(dst, b, h) do { _Pragma("unroll") for (int n = 0; n < 2; ++n) _Pragma("unroll") for (int k = 0; k < 2; ++k) dst[n][k] = *(const LAS bf16x8*)(lds + PG8_SB(b, h) + boff + n * 2048 + k * 1024); } while (0)
#define PG8_MMA(ai, bj, At, Bt) do { __builtin_amdgcn_s_setprio(1); _Pragma("unroll") for (int m = 0; m < 4; ++m) _Pragma("unroll") for (int n = 0; n < 2; ++n) _Pragma("unroll") for (int k = 0; k < 2; ++k) \
        acc[ai][bj][m][n] = __builtin_amdgcn_mfma_f32_16x16x32_bf16(Bt[n][k], At[m][k], acc[ai][bj][m][n], 0, 0, 0); __builtin_amdgcn_s_setprio(0); } while (0)
#define PG8_WAIT_V(n) asm volatile("s_waitcnt vmcnt(" #n ")" ::: "memory")
#define PG8_WAIT_L(n) asm volatile("s_waitcnt lgkmcnt(" #n ")" ::: "memory")
#define PG8_BAR __builtin_amdgcn_s_barrier()
#define PG8_SCHED __builtin_amdgcn_sched_barrier(0)
    const bool lp = Epi::LDSPART && E.lds_part();
#define PG8_PART_DMA(unit, buf) do { if constexpr (Epi::LDSPART) { if (lp) { const char* ps_ = (const char*)E.part + ((size_t)(unit).pm * 256 + 32 * wid) * 128; const unsigned pv_ = (unsigned)((lane >> 2) * 128 + (lane & 3) * 16); \
        __builtin_amdgcn_global_load_lds((const unsigned*)(ps_ + pv_), (LAS unsigned*)(lds + STAGE_BYTES + (buf) * 16384 + (32 * wid) * 64), 16, 0, 0); \
        __builtin_amdgcn_global_load_lds((const unsigned*)(ps_ + 2048 + pv_), (LAS unsigned*)(lds + STAGE_BYTES + (buf) * 16384 + (32 * wid + 16) * 64), 16, 0, 0); } } } while (0)
    Unit cur, nxt; int ui = 0;
    if (!S.next(0, cur)) return;
    f32x4 acc[2][2][4][2];
#pragma unroll
    for (int a = 0; a < 2; ++a)
#pragma unroll
        for (int b = 0; b < 2; ++b)
#pragma unroll
            for (int m = 0; m < 4; ++m)
#pragma unroll
                for (int n = 0; n < 2; ++n) acc[a][b][m][n] = (f32x4){0.f, 0.f, 0.f, 0.f};
    bf16x8 At[4][2], B0[2][2], B1[2][2];
    const char* cA = (const char*)g.A + (size_t)cur.pm * tstepA; const char* cB = (const char*)g.Bt + (size_t)cur.pn * tstepB;
    PG8_PART_DMA(cur, 0);
    PG8_STAGE(PG8_SB(0, 0), cB, voffB); PG8_STAGE(PG8_SA(0, 0), cA, voffA); PG8_STAGE(PG8_SB(0, 1), cB + hstepB, voffB); PG8_STAGE(PG8_SA(0, 1), cA + hstepA, voffA);
    if (wr == 1) PG8_BAR;
    PG8_WAIT_V(4); PG8_BAR;
    PG8_STAGE(PG8_SB(1, 0), cB + kstep, voffB); PG8_STAGE(PG8_SA(1, 0), cA + kstep, voffA); PG8_STAGE(PG8_SB(1, 1), cB + hstepB + kstep, voffB);
    PG8_WAIT_V(6); PG8_BAR;
    for (;;) {
        const bool has_next = S.next(ui + 1, nxt);
        const char* nA = has_next ? (const char*)g.A + (size_t)nxt.pm * tstepA : cA; const char* nB = has_next ? (const char*)g.Bt + (size_t)nxt.pn * tstepB : cB;
        for (int t = 0; t < nt; t += 2) {
            const bool last = (t == nt - 2);
            const char* a1 = cA + (size_t)(t + 1) * kstep;
            const char* a2 = last ? nA : cA + (size_t)(t + 2) * kstep; const char* b2 = last ? nB : cB + (size_t)(t + 2) * kstep;
            const char* a3 = a2 + kstep; const char* b3 = b2 + kstep;
            PG8_LDB(B0, 0, 0); PG8_SCHED; PG8_LDA(At, 0, 0); PG8_STAGE(PG8_SA(1, 1), a1 + hstepA, voffA);
            PG8_WAIT_L(8); PG8_BAR; PG8_WAIT_L(0); PG8_MMA(0, 0, At, B0); PG8_BAR; PG8_SCHED;
            PG8_LDB(B1, 0, 1); PG8_STAGE(PG8_SB(0, 0), b2, voffB);
            PG8_BAR; PG8_WAIT_L(0); PG8_MMA(0, 1, At, B1); PG8_BAR;
            PG8_LDA(At, 0, 1); PG8_STAGE(PG8_SA(0, 0), a2, voffA);
            PG8_BAR; PG8_WAIT_L(0); PG8_MMA(1, 0, At, B0); PG8_BAR; PG8_SCHED;
            PG8_STAGE(PG8_SB(0, 1), b2 + hstepB, voffB);
            PG8_WAIT_V(6); PG8_BAR;
            if (last && has_next) PG8_PART_DMA(nxt, (ui + 1) & 1);
            PG8_MMA(1, 1, At, B1); PG8_BAR;
            PG8_LDB(B0, 1, 0); PG8_SCHED; PG8_LDA(At, 1, 0); PG8_STAGE(PG8_SA(0, 1), a2 + hstepA, voffA);
            PG8_WAIT_L(8); PG8_BAR; PG8_WAIT_L(0); PG8_MMA(0, 0, At, B0); PG8_BAR; PG8_SCHED;
            PG8_LDB(B1, 1, 1); PG8_STAGE(PG8_SB(1, 0), b3, voffB);
            PG8_BAR; PG8_WAIT_L(0); PG8_MMA(0, 1, At, B1); PG8_BAR;
            PG8_LDA(At, 1, 1); PG8_STAGE(PG8_SA(1, 0), a3, voffA);
            PG8_BAR; PG8_WAIT_L(0); PG8_MMA(1, 0, At, B0); PG8_BAR; PG8_SCHED;
            PG8_STAGE(PG8_SB(1, 1), b3 + hstepB, voffB);
            PG8_WAIT_V(6); PG8_BAR; PG8_MMA(1, 1, At, B1); PG8_BAR;
        }
        E(acc, cur, wr, wc, fr, fq, lp ? (const LAS unsigned char*)(lds + STAGE_BYTES + (ui & 1) * 16384) : (const LAS unsigned char*)nullptr);
        if (!has_next) break;
#pragma unroll
        for (int a = 0; a < 2; ++a)
#pragma unroll
            for (int b = 0; b < 2; ++b)
#pragma unroll
                for (int m = 0; m < 4; ++m)
#pragma unroll
                    for (int n = 0; n < 2; ++n) acc[a][b][m][n] = (f32x4){0.f, 0.f, 0.f, 0.f};
        cur = nxt; cA = nA; cB = nB; ++ui;
    }
    PG8_WAIT_V(0);
    if (wr == 0) PG8_BAR;
    PG8_BAR;
#undef PG8_PART_DMA
#undef PG8_SA
#undef PG8_SB
#undef PG8_STAGE
#undef PG8_LDA
#undef PG8_LDB
#undef PG8_MMA
#undef PG8_WAIT_V
#undef PG8_WAIT_L
#undef PG8_BAR
#undef PG8_SCHED
}
}
using pg8::Unit;

__device__ __forceinline__ void rows_rstd(const float* part, int row0, int np, int fq, float (&rs)[8]) {
#pragma unroll
    for (int hf = 0; hf < 2; ++hf) {
        f32x4 pa[4], pb[4];
#pragma unroll
        for (int g4 = 0; g4 < 4; ++g4) {
            const float* p = part + (size_t)(row0 + hf * 128 + g4 * 16) * 32;
            if (np == 16) { pa[g4] = *(const f32x4*)(p + 4 * fq); pb[g4] = (f32x4){0.f, 0.f, 0.f, 0.f}; }
            else { pa[g4] = *(const f32x4*)(p + 8 * fq); pb[g4] = *(const f32x4*)(p + 8 * fq + 4); }
        }
#pragma unroll
        for (int g4 = 0; g4 < 4; ++g4) {
            float sm = ((pa[g4][0] + pa[g4][1]) + (pa[g4][2] + pa[g4][3])) + ((pb[g4][0] + pb[g4][1]) + (pb[g4][2] + pb[g4][3]));
            sm += shx(sm, 16); sm += shx(sm, 32);
            rs[hf * 4 + g4] = __builtin_amdgcn_rsqf(sm * (1.0f / 1024.0f) + NORM_EPS);
        }
        if (np != 16) asm volatile("" ::: "memory");
    }
}

__device__ __forceinline__ void rows_rstd_lds(const LAS unsigned char* lp, int rl0, int fq, float (&rs)[8]) {
    f32x4 pa[8];
#pragma unroll
    for (int g = 0; g < 8; ++g) pa[g] = *(const LAS f32x4*)(lp + (rl0 + (g >> 2) * 128 + (g & 3) * 16) * 64 + fq * 16);
#pragma unroll
    for (int g = 0; g < 8; ++g) {
        float sm = (pa[g][0] + pa[g][1]) + (pa[g][2] + pa[g][3]);
        sm += shx(sm, 16); sm += shx(sm, 32);
        rs[g] = __builtin_amdgcn_rsqf(sm * (1.0f / 1024.0f) + NORM_EPS);
    }
}

struct EpiBf16S {
    static constexpr bool PERM = true, LDSPART = true;
    bf16_t* O; int ldc; const float* part; int np; float cscale;
    __device__ __forceinline__ bool lds_part() const { return part != nullptr && np == 16; }
    __device__ __forceinline__ void operator()(const f32x4 (&acc)[2][2][4][2], const Unit& u, int wr, int wc, int fr, int fq, const LAS unsigned char* lp) const {
        { const int ln_ = opaque_tid() & 63; fr = ln_ & 15; fq = ln_ >> 4; }
        const int row0 = u.pm * 256 + wr * 64 + fr, col0 = u.pn * 256 + wc * 32 + 8 * fq;
        float rs[8];
        if (lp) rows_rstd_lds(lp, wr * 64 + fr, fq, rs);
        else if (part) rows_rstd(part, row0, np, fq, rs);
        else {
#pragma unroll
            for (int g = 0; g < 8; ++g) rs[g] = 1.0f; }
#pragma unroll
        for (int ai = 0; ai < 2; ++ai)
#pragma unroll
            for (int m = 0; m < 4; ++m) {
                const int row = row0 + ai * 128 + m * 16;
                const float sc = cscale * rs[ai * 4 + m];
                bf16_t* rowp = O + (size_t)row * ldc + col0;
#pragma unroll
                for (int bj = 0; bj < 2; ++bj) { const f32x4 v0 = acc[ai][bj][m][0] * sc, v1 = acc[ai][bj][m][1] * sc;
                    u32x4 w; w.x = cvt_pk_bf16(v0[0], v0[1]); w.y = cvt_pk_bf16(v0[2], v0[3]); w.z = cvt_pk_bf16(v1[0], v1[1]); w.w = cvt_pk_bf16(v1[2], v1[3]);
                    *(u32x4*)(rowp + bj * 128) = w; }
            }
    }
};
struct EpiSwiglu {
    static constexpr bool PERM = true, LDSPART = true;
    bf16_t* H; const float* part; int np;
    __device__ __forceinline__ bool lds_part() const { return np == 16; }
    __device__ __forceinline__ void operator()(const f32x4 (&acc)[2][2][4][2], const Unit& u, int wr, int wc, int fr, int fq, const LAS unsigned char* lp) const {
        { const int ln_ = opaque_tid() & 63; fr = ln_ & 15; fq = ln_ >> 4; }
        const int row0 = u.pm * 256 + wr * 64 + fr, col0 = u.pn * 128 + wc * 32 + 8 * fq;
        float rsv[8]; if (lp) rows_rstd_lds(lp, wr * 64 + fr, fq, rsv); else rows_rstd(part, row0, np, fq, rsv);
#pragma unroll
        for (int ai = 0; ai < 2; ++ai)
#pragma unroll
            for (int m = 0; m < 4; ++m) {
                const int row = row0 + ai * 128 + m * 16;
                const float rs = rsv[ai * 4 + m], c1 = -1.44269504089f * rs, r2 = rs * rs;
                float o[8];
#pragma unroll
                for (int n = 0; n < 2; ++n) {
                    const f32x4 gv = acc[ai][0][m][n], uv = acc[ai][1][m][n];
                    const f32x4 ev = gv * c1, tv = (gv * uv) * r2;
#pragma unroll
                    for (int j = 0; j < 4; ++j) o[n * 4 + j] = tv[j] * __builtin_amdgcn_rcpf(1.0f + __builtin_amdgcn_exp2f(ev[j]));
                }
                u32x4 w; w.x = cvt_pk_bf16(o[0], o[1]); w.y = cvt_pk_bf16(o[2], o[3]); w.z = cvt_pk_bf16(o[4], o[5]); w.w = cvt_pk_bf16(o[6], o[7]);
                *(u32x4*)(H + (size_t)row * DFF + col0) = w;
            }
    }
};
struct EpiConvIn {
    static constexpr bool PERM = true, LDSPART = true;
    bf16_t* U; bf16_t* Bg; const float* part; int np;
    __device__ __forceinline__ bool lds_part() const { return np == 16; }
    __device__ __forceinline__ void operator()(const f32x4 (&acc)[2][2][4][2], const Unit& u, int wr, int wc, int fr, int fq, const LAS unsigned char* lp) const {
        { const int ln_ = opaque_tid() & 63; fr = ln_ & 15; fq = ln_ >> 4; }
        const int row0 = u.pm * 256 + wr * 64 + fr;
        float rsv[8]; if (lp) rows_rstd_lds(lp, wr * 64 + fr, fq, rsv); else rows_rstd(part, row0, np, fq, rsv);
#pragma unroll
        for (int ai = 0; ai < 2; ++ai)
#pragma unroll
            for (int m = 0; m < 4; ++m) {
                const int row = row0 + ai * 128 + m * 16;
                const float rs = rsv[ai * 4 + m];
                if (u.pn < 8) {
                    const float r2 = rs * rs; float o[8];
#pragma unroll
                    for (int n = 0; n < 2; ++n)
#pragma unroll
                        for (int j = 0; j < 4; ++j) o[n * 4 + j] = acc[ai][0][m][n][j] * acc[ai][1][m][n][j] * r2;
                    u32x4 w; w.x = cvt_pk_bf16(o[0], o[1]); w.y = cvt_pk_bf16(o[2], o[3]); w.z = cvt_pk_bf16(o[4], o[5]); w.w = cvt_pk_bf16(o[6], o[7]);
                    *(u32x4*)(U + (size_t)row * DM + u.pn * 128 + wc * 32 + 8 * fq) = w;
                } else {
#pragma unroll
                    for (int bj = 0; bj < 2; ++bj) { const f32x4 v0 = acc[ai][bj][m][0] * rs, v1 = acc[ai][bj][m][1] * rs;
                        u32x4 w; w.x = cvt_pk_bf16(v0[0], v0[1]); w.y = cvt_pk_bf16(v0[2], v0[3]); w.z = cvt_pk_bf16(v1[0], v1[1]); w.w = cvt_pk_bf16(v1[2], v1[3]);
                        *(u32x4*)(Bg + (size_t)row * DM + (u.pn - 8) * 256 + bj * 128 + wc * 32 + 8 * fq) = w; }
                }
            }
    }
};
struct EpiResid {
    static constexpr bool PERM = true, LDSPART = false;
    __device__ __forceinline__ bool lds_part() const { return false; }
    const float* xin; bf16_t* xb; float* part; float scale;
    __device__ __forceinline__ void operator()(const f32x4 (&acc)[2][2][4][2], const Unit& u, int wr, int wc, int fr, int fq, const LAS unsigned char* lp) const {
        { const int ln_ = opaque_tid() & 63; fr = ln_ & 15; fq = ln_ >> 4; }
        const int row0 = u.pm * 256 + wr * 64 + fr, col0 = u.pn * 256 + wc * 32 + 8 * fq;
        if (xin == nullptr) {
#pragma unroll
            for (int ai = 0; ai < 2; ++ai) {
                u32x4 rb[4][2];
#pragma unroll
                for (int m = 0; m < 4; ++m)
#pragma unroll
                    for (int bj = 0; bj < 2; ++bj) rb[m][bj] = *(const u32x4*)((const char*)xb + (unsigned)((row0 + ai * 128 + m * 16) * DM + col0 + bj * 128) * 2u);
#pragma unroll
                for (int m = 0; m < 4; ++m) {
                    const int row = row0 + ai * 128 + m * 16; float ss = 0.f;
#pragma unroll
                    for (int bj = 0; bj < 2; ++bj) {
                        const u32x4 b4 = rb[m][bj];
                        f32x4 v0, v1; v0[0] = bf_lo(b4.x); v0[1] = bf_hi(b4.x); v0[2] = bf_lo(b4.y); v0[3] = bf_hi(b4.y); v1[0] = bf_lo(b4.z); v1[1] = bf_hi(b4.z); v1[2] = bf_lo(b4.w); v1[3] = bf_hi(b4.w);
                        v0 = v0 + acc[ai][bj][m][0] * scale; v1 = v1 + acc[ai][bj][m][1] * scale;
                        u32x4 w; w.x = cvt_pk_bf16(v0[0], v0[1]); w.y = cvt_pk_bf16(v0[2], v0[3]); w.z = cvt_pk_bf16(v1[0], v1[1]); w.w = cvt_pk_bf16(v1[2], v1[3]);
                        *(u32x4*)((char*)xb + (unsigned)(row * DM + col0 + bj * 128) * 2u) = w;
                        ss += ((v0[0] * v0[0] + v0[1] * v0[1]) + (v0[2] * v0[2] + v0[3] * v0[3])) + ((v1[0] * v1[0] + v1[1] * v1[1]) + (v1[2] * v1[2] + v1[3] * v1[3]));
                    }
                    ss += shx(ss, 16); ss += shx(ss, 32);
                    if (fq == 0) part[(size_t)row * 32 + u.pn * 4 + wc] = ss;
                }
                asm volatile("" ::: "memory");
            }
        } else {
#pragma unroll
            for (int gp = 0; gp < 4; ++gp) {
                const int ai = gp >> 1;
                f32x4 rb[2][4];
#pragma unroll
                for (int mm = 0; mm < 2; ++mm)
#pragma unroll
                    for (int q = 0; q < 4; ++q) rb[mm][q] = *(const f32x4*)(xin + (size_t)(row0 + ai * 128 + ((gp & 1) * 2 + mm) * 16) * DM + col0 + (q >> 1) * 128 + (q & 1) * 4);
#pragma unroll
                for (int mm = 0; mm < 2; ++mm) {
                    const int m = (gp & 1) * 2 + mm, row = row0 + ai * 128 + m * 16; float ss = 0.f;
#pragma unroll
                    for (int bj = 0; bj < 2; ++bj) {
                        const f32x4 v0 = rb[mm][bj * 2 + 0] + acc[ai][bj][m][0] * scale, v1 = rb[mm][bj * 2 + 1] + acc[ai][bj][m][1] * scale;
                        u32x4 w; w.x = cvt_pk_bf16(v0[0], v0[1]); w.y = cvt_pk_bf16(v0[2], v0[3]); w.z = cvt_pk_bf16(v1[0], v1[1]); w.w = cvt_pk_bf16(v1[2], v1[3]);
                        *(u32x4*)((char*)xb + (unsigned)(row * DM + col0 + bj * 128) * 2u) = w;
                        ss += ((v0[0] * v0[0] + v0[1] * v0[1]) + (v0[2] * v0[2] + v0[3] * v0[3])) + ((v1[0] * v1[0] + v1[1] * v1[1]) + (v1[2] * v1[2] + v1[3] * v1[3]));
                    }
                    ss += shx(ss, 16); ss += shx(ss, 32);
                    if (fq == 0) part[(size_t)row * 32 + u.pn * 4 + wc] = ss;
                }
                asm volatile("" ::: "memory");
            }
        }
    }
};
struct EpiGlu {
    static constexpr bool PERM = true, LDSPART = false;
    __device__ __forceinline__ bool lds_part() const { return false; }
    bf16_t* xb; float* part;
    __device__ __forceinline__ void operator()(const f32x4 (&acc)[2][2][4][2], const Unit& u, int wr, int wc, int fr, int fq, const LAS unsigned char* lp) const {
        { const int ln_ = opaque_tid() & 63; fr = ln_ & 15; fq = ln_ >> 4; }
        const int row0 = u.pm * 256 + wr * 64 + fr, col0 = u.pn * 128 + wc * 32 + 8 * fq;
#pragma unroll
        for (int ai = 0; ai < 2; ++ai) {
            u32x4 rb[4];
#pragma unroll
            for (int m = 0; m < 4; ++m) rb[m] = *(const u32x4*)((const char*)xb + (unsigned)((row0 + ai * 128 + m * 16) * DM + col0) * 2u);
#pragma unroll
            for (int m = 0; m < 4; ++m) {
                const int row = row0 + ai * 128 + m * 16;
                const u32x4 b4 = rb[m];
                f32x4 v0, v1; v0[0] = bf_lo(b4.x); v0[1] = bf_hi(b4.x); v0[2] = bf_lo(b4.y); v0[3] = bf_hi(b4.y); v1[0] = bf_lo(b4.z); v1[1] = bf_hi(b4.z); v1[2] = bf_lo(b4.w); v1[3] = bf_hi(b4.w);
#pragma unroll
                for (int j = 0; j < 4; ++j) { v0[j] += acc[ai][0][m][0][j] * fast_sigmoid(acc[ai][1][m][0][j]); v1[j] += acc[ai][0][m][1][j] * fast_sigmoid(acc[ai][1][m][1][j]); }
                u32x4 w; w.x = cvt_pk_bf16(v0[0], v0[1]); w.y = cvt_pk_bf16(v0[2], v0[3]); w.z = cvt_pk_bf16(v1[0], v1[1]); w.w = cvt_pk_bf16(v1[2], v1[3]);
                *(u32x4*)((char*)xb + (unsigned)(row * DM + col0) * 2u) = w;
                float ss = ((v0[0] * v0[0] + v0[1] * v0[1]) + (v0[2] * v0[2] + v0[3] * v0[3])) + ((v1[0] * v1[0] + v1[1] * v1[1]) + (v1[2] * v1[2] + v1[3] * v1[3]));
                ss += shx(ss, 16); ss += shx(ss, 32);
                if (fq == 0) part[(size_t)row * 32 + u.pn * 4 + wc] = ss;
            }
            asm volatile("" ::: "memory");
        }
    }
};

__device__ __forceinline__ int srccol(int kind, int n0) {
    if (kind == 0) return n0;
    const int pn = n0 >> 8, r = n0 & 255, bj = r >> 7, rr = r & 127;
    if (kind == 1) return bj * DFF + 128 * pn + rr;
    if (kind == 2) return n0 < 2048 ? (bj ? 2048 : 0) + 128 * pn + rr : 1024 + (n0 - 2048);
    return bj * 1024 + 128 * pn + rr;
}
__device__ void transpose_job(LAS float* tile, const float* W, int Nsrc, int K, bf16_t* dst, int Ndst, int kind, const float* gain) {
    const int tid = opaque_tid();
    const int tilesK = K >> 7, ntile = tilesK * (Ndst >> 7);
    for (int t = blockIdx.x; t < ntile; t += gridDim.x) {
        const int tn = t / tilesK, tk = t - tn * tilesK, n0 = tn * 128, k0 = tk * 128;
        const int sc = srccol(kind, n0);
        const int c4 = (tid & 31) * 4, kr = tid >> 5;
        f32x4 v[8];
#pragma unroll
        for (int i = 0; i < 8; ++i) v[i] = *(const f32x4*)(W + (size_t)(k0 + kr + 16 * i) * Nsrc + sc + c4);
#pragma unroll
        for (int i = 0; i < 8; ++i) {
            const int k = kr + 16 * i; const float gk = gain ? gain[k0 + k] : 1.0f;
            tile[k * 129 + c4 + 0] = v[i][0] * gk; tile[k * 129 + c4 + 1] = v[i][1] * gk; tile[k * 129 + c4 + 2] = v[i][2] * gk; tile[k * 129 + c4 + 3] = v[i][3] * gk;
        }
        __syncthreads();
#pragma unroll
        for (int i = 0; i < 4; ++i) {
            const int q = tid + NTHREADS * i, n = q >> 4, kc = (q & 15) * 8;
            float f[8];
#pragma unroll
            for (int e = 0; e < 8; ++e) f[e] = tile[(kc + e) * 129 + n];
            u32x4 w; w.x = cvt_pk_bf16(f[0], f[1]); w.y = cvt_pk_bf16(f[2], f[3]); w.z = cvt_pk_bf16(f[4], f[5]); w.w = cvt_pk_bf16(f[6], f[7]);
            *(u32x4*)(dst + (size_t)(n0 + n) * K + k0 + kc) = w;
        }
        __syncthreads();
    }
}

struct Args { const float* in[23]; float* out; unsigned char* ws; };
typedef const __attribute__((address_space(4))) Args* CArgs;
__device__ __forceinline__ CArgs get_args() { CArgs p = (CArgs)__builtin_amdgcn_kernarg_segment_ptr(); asm volatile("" : "+s"(p)); return p; }

__device__ __forceinline__ void sincos_d(double th, double& s, double& c) {
    const double twopi = 6.283185307179586476925;
    const double k = rint(th / twopi); const double r = th - k * twopi;
    const double q = r * 0.125, q2 = q * q;
    double sq = q * (1.0 + q2 * (-1.0 / 6.0 + q2 * (1.0 / 120.0 + q2 * (-1.0 / 5040.0 + q2 * (1.0 / 362880.0 + q2 * (-1.0 / 39916800.0 + q2 * (1.0 / 6227020800.0)))))));
    double cq = 1.0 + q2 * (-0.5 + q2 * (1.0 / 24.0 + q2 * (-1.0 / 720.0 + q2 * (1.0 / 40320.0 + q2 * (-1.0 / 3628800.0 + q2 * (1.0 / 479001600.0 + q2 * (-1.0 / 87178291200.0)))))));
#pragma unroll
    for (int i = 0; i < 3; ++i) { const double s2 = 2.0 * sq * cq, c2 = cq * cq - sq * sq; sq = s2; cq = c2; }
    s = sq; c = cq;
}
__device__ __forceinline__ double exp_d(double x) {
    const double ln2 = 0.693147180559945309417;
    const double k = rint(x / ln2); const double r = x - k * ln2;
    double p = 1.0 + r * (1.0 + r * (0.5 + r * (1.0 / 6.0 + r * (1.0 / 24.0 + r * (1.0 / 120.0 + r * (1.0 / 720.0 + r * (1.0 / 5040.0 + r * (1.0 / 40320.0 + r * (1.0 / 362880.0 + r * (1.0 / 3628800.0 + r * (1.0 / 39916800.0 + r * (1.0 / 479001600.0))))))))))));
    return ldexp(p, (int)k);
}

__device__ __forceinline__ void ssm_disc(CArgs a, int j, int g, int p, double& abr, double& abi, double& cfr, double& cfi) {
    const size_t gp = ((size_t)j * 64 + g) * 64 + p;
    const double lre = fmin((double)a->in[11][gp], -1e-4), lim = (double)a->in[12][gp];
    const double dt = exp_d((double)a->in[13][j * 64 + g]);
    const double mag = exp_d(lre * dt); double sn, cs; sincos_d(lim * dt, sn, cs);
    abr = mag * cs; abi = mag * sn;
    const double den = lre * lre + lim * lim, nre = abr - 1.0, nim = abi;
    cfr = (nre * lre + nim * lim) / den; cfi = (nim * lre - nre * lim) / den;
}
__device__ void prep_phase(LAS unsigned char* lds) {
    LAS float* tile = (LAS float*)lds;
    CArgs ap = get_args();
    unsigned char* ws = ap->ws;
    const float* norm_g = ap->in[2];
    for (int l = 0; l < NLAYER; ++l) {
        const float* g = norm_g + (size_t)l * 5 * DM;
        transpose_job(tile, ap->in[4] + (size_t)l * DM * 2 * DFF, 2 * DFF, DM, (bf16_t*)(ws + WS_UP1 + l * SZ_UP), 2 * DFF, 1, g + 0 * DM);
        transpose_job(tile, ap->in[5] + (size_t)l * DFF * DM, DM, DFF, (bf16_t*)(ws + WS_DN1 + l * SZ_DN), DM, 0, nullptr);
        transpose_job(tile, ap->in[6] + (size_t)l * DM * 2 * DFF, 2 * DFF, DM, (bf16_t*)(ws + WS_UP2 + l * SZ_UP), 2 * DFF, 1, g + 4 * DM);
        transpose_job(tile, ap->in[7] + (size_t)l * DFF * DM, DM, DFF, (bf16_t*)(ws + WS_DN2 + l * SZ_DN), DM, 0, nullptr);
        transpose_job(tile, ap->in[20] + (size_t)l * DM * DM, DM, DM, (bf16_t*)(ws + WS_Q + l * SZ_SQ), DM, 0, g + 2 * DM);
        transpose_job(tile, ap->in[21] + (size_t)l * DM * 2 * DM, 2 * DM, DM, (bf16_t*)(ws + WS_K + l * SZ_SQ), DM, 0, g + 3 * DM);
        transpose_job(tile, ap->in[21] + (size_t)l * DM * 2 * DM + DM, 2 * DM, DM, (bf16_t*)(ws + WS_VT + l * SZ_SQ), DM, 0, g + 3 * DM);
        transpose_job(tile, ap->in[22] + (size_t)l * DM * DM, DM, DM, (bf16_t*)(ws + WS_O + l * SZ_SQ), DM, 0, nullptr);
        if ((l & 1) == 0) {
            const int j = l >> 1;
            transpose_job(tile, ap->in[8] + (size_t)j * DM * 3 * DM, 3 * DM, DM, (bf16_t*)(ws + WS_CIN + j * 3 * SZ_SQ), 3 * DM, 2, g + 1 * DM);
            transpose_job(tile, ap->in[10] + (size_t)j * DM * DM, DM, DM, (bf16_t*)(ws + WS_COUT + j * SZ_SQ), DM, 0, nullptr);
        } else {
            const int j = l >> 1;
            transpose_job(tile, ap->in[19] + (size_t)j * DM * 2 * DM, 2 * DM, DM, (bf16_t*)(ws + WS_GLU + j * 2 * SZ_SQ), 2 * DM, 3, nullptr);
        }
    }
    const int tid0 = opaque_tid(), lane = tid0 & 63, gw = blockIdx.x * 8 + (tid0 >> 6), nw = gridDim.x * 8;
    const float* x = ap->in[0]; bf16_t* xb = (bf16_t*)(ws + WS_XB); float* part = (float*)(ws + WS_PART);
    for (int row = gw; row < T_TOK; row += 2 * nw) {
        f32x4 v[2][4];
#pragma unroll
        for (int rr = 0; rr < 2; ++rr)
#pragma unroll
            for (int i = 0; i < 4; ++i) v[rr][i] = *(const f32x4*)(x + (size_t)(row + rr * nw) * DM + i * 256 + lane * 4);
#pragma unroll
        for (int rr = 0; rr < 2; ++rr) {
            float ss = 0.f;
#pragma unroll
            for (int i = 0; i < 4; ++i) {
                const f32x4 t = v[rr][i];
                u32x2 w; w.x = cvt_pk_bf16(t[0], t[1]); w.y = cvt_pk_bf16(t[2], t[3]);
                *(u32x2*)(xb + (size_t)(row + rr * nw) * DM + i * 256 + lane * 4) = w;
                ss += (t[0] * t[0] + t[1] * t[1]) + (t[2] * t[2] + t[3] * t[3]);
            }
#pragma unroll
            for (int o = 32; o >= 1; o >>= 1) ss += shx(ss, o);
            if (lane < 16) part[(size_t)(row + rr * nw) * 32 + lane] = lane == 0 ? ss : 0.f;
        }
    }
    const float* mem = ap->in[1]; bf16_t* memb = (bf16_t*)(ws + WS_MEMB);
    for (int row = gw; row < NB * MEML; row += nw) {
        f32x4 v[4]; float ss = 0.f;
#pragma unroll
        for (int i = 0; i < 4; ++i) { v[i] = *(const f32x4*)(mem + (size_t)row * DM + i * 256 + lane * 4); ss += (v[i][0] * v[i][0] + v[i][1] * v[i][1]) + (v[i][2] * v[i][2] + v[i][3] * v[i][3]); }
#pragma unroll
        for (int o = 32; o >= 1; o >>= 1) ss += shx(ss, o);
        const float rs = __builtin_amdgcn_rsqf(ss * (1.0f / 1024.0f) + NORM_EPS);
#pragma unroll
        for (int i = 0; i < 4; ++i) { u32x2 w; w.x = cvt_pk_bf16(v[i][0] * rs, v[i][1] * rs); w.y = cvt_pk_bf16(v[i][2] * rs, v[i][3] * rs);
            *(u32x2*)(memb + (size_t)row * DM + i * 256 + lane * 4) = w; }
    }
    float* disc = (float*)(ws + WS_DISC);
    for (int idx = blockIdx.x * NTHREADS + tid0; idx < 2 * 64 * 64; idx += gridDim.x * NTHREADS) {
        double abr, abi, cfr, cfi; ssm_disc(ap, idx >> 12, (idx >> 6) & 63, idx & 63, abr, abi, cfr, cfi);
        double pr = abr, pi = abi;
#pragma unroll
        for (int q = 0; q < 4; ++q) { const double nr = pr * pr - pi * pi, ni = 2.0 * pr * pi; pr = nr; pi = ni; }
        f32x4 v0, v1; v0[0] = (float)abr; v0[1] = (float)abi; v0[2] = (float)cfr; v0[3] = (float)cfi; v1[0] = (float)pr; v1[1] = (float)pi; v1[2] = 0.f; v1[3] = 0.f;
        *(f32x4*)(disc + (size_t)idx * 8) = v0; *(f32x4*)(disc + (size_t)idx * 8 + 4) = v1;
    }
}

__device__ void conv_phase(const bf16_t* U, bf16_t* Bg, const float* cw) {
    const size_t total = (size_t)T_TOK * 128;
    for (size_t idx = (size_t)blockIdx.x * NTHREADS + opaque_tid(); idx < total; idx += (size_t)gridDim.x * NTHREADS) {
        const int t = (int)(idx >> 7), c8 = (int)(idx & 127) * 8, pos = t & (SEQ - 1);
        const size_t off = (size_t)t * DM + c8;
        const u32x4 u0 = *(const u32x4*)(U + off);
        u32x4 u1 = (u32x4){0u, 0u, 0u, 0u}, u2 = (u32x4){0u, 0u, 0u, 0u};
        if (pos >= 1) u1 = *(const u32x4*)(U + off - DM);
        if (pos >= 2) u2 = *(const u32x4*)(U + off - 2 * DM);
        const u32x4 bb = *(const u32x4*)(Bg + off);
        float o[8];
#pragma unroll
        for (int i = 0; i < 4; ++i) {
            const int c = c8 + 2 * i;
            const float w0a = cw[c], w0b = cw[c + 1], w1a = cw[DM + c], w1b = cw[DM + c + 1], w2a = cw[2 * DM + c], w2b = cw[2 * DM + c + 1];
            o[2 * i] = bf_lo(bb[i]) * (w0a * bf_lo(u2[i]) + w1a * bf_lo(u1[i]) + w2a * bf_lo(u0[i]));
            o[2 * i + 1] = bf_hi(bb[i]) * (w0b * bf_hi(u2[i]) + w1b * bf_hi(u1[i]) + w2b * bf_hi(u0[i]));
        }
        u32x4 w; w.x = cvt_pk_bf16(o[0], o[1]); w.y = cvt_pk_bf16(o[2], o[3]); w.z = cvt_pk_bf16(o[4], o[5]); w.w = cvt_pk_bf16(o[6], o[7]);
        *(u32x4*)(Bg + off) = w;
    }
}

constexpr size_t SSM_PU_OFF = (size_t)64 * 2048 * 384 * 2;
constexpr size_t SSM_MQ_OFF = SSM_PU_OFF + (size_t)64 * 2048 * 128 * 4;
constexpr size_t SSM_P_OFF = SSM_MQ_OFF + (size_t)64 * 256 * 384 * 2;
static_assert(SSM_P_OFF + (size_t)64 * 128 * 256 * 2 <= (size_t)T_TOK * DFF * 2, "ssm scratch must fit the hidden buffer");

__device__ void ssm_uprep_phase(const bf16_t* xb, const float* part, const float* gain, bf16_t* U2) {
    const int tid = opaque_tid(), lane = tid & 63, gw = blockIdx.x * 8 + (tid >> 6), nw = gridDim.x * 8;
    const int s = lane & 15, gq = lane >> 4;
    for (int item0 = gw; item0 < 32768; item0 += 2 * nw) {
        f32x4 pp[2][4]; u32x4 xa[2][2];
#pragma unroll
        for (int rr = 0; rr < 2; ++rr) {
            const int item = item0 + rr * nw, g = (item & 15) * 4 + gq, c = (item >> 4) & 127, b = item >> 11, row = b * SEQ + c * 16 + s;
#pragma unroll
            for (int q = 0; q < 4; ++q) pp[rr][q] = *(const f32x4*)(part + (size_t)row * 32 + 4 * q);
            xa[rr][0] = *(const u32x4*)(xb + (size_t)row * DM + g * 16); xa[rr][1] = *(const u32x4*)(xb + (size_t)row * DM + g * 16 + 8);
        }
#pragma unroll
        for (int rr = 0; rr < 2; ++rr) {
            const int item = item0 + rr * nw, g = (item & 15) * 4 + gq, c = (item >> 4) & 127, b = item >> 11;
            float ssq = 0.f;
#pragma unroll
            for (int q = 0; q < 4; ++q) ssq += (pp[rr][q][0] + pp[rr][q][1]) + (pp[rr][q][2] + pp[rr][q][3]);
            const float rs = __builtin_amdgcn_rsqf(ssq * (1.0f / 1024.0f) + NORM_EPS);
            const unsigned xw[8] = {xa[rr][0].x, xa[rr][0].y, xa[rr][0].z, xa[rr][0].w, xa[rr][1].x, xa[rr][1].y, xa[rr][1].z, xa[rr][1].w};
            unsigned w[8];
#pragma unroll
            for (int q4 = 0; q4 < 4; ++q4) {
                const f32x4 gv = *(const f32x4*)(gain + g * 16 + q4 * 4);
                w[q4 * 2] = cvt_pk_bf16(bf_lo(xw[q4 * 2]) * rs * gv[0], bf_hi(xw[q4 * 2]) * rs * gv[1]); w[q4 * 2 + 1] = cvt_pk_bf16(bf_lo(xw[q4 * 2 + 1]) * rs * gv[2], bf_hi(xw[q4 * 2 + 1]) * rs * gv[3]);
            }
            bf16_t* dst = U2 + ((size_t)g * 2048 + b * 128 + c) * 384 + 16 * s;
            *(u32x4*)dst = (u32x4){w[0], w[1], w[2], w[3]}; *(u32x4*)(dst + 8) = (u32x4){w[4], w[5], w[6], w[7]};
        }
    }
}

__device__ void ssm_build_phase(int j, bf16_t* MQ, bf16_t* P, LAS unsigned char* lds) {
    CArgs a = get_args();
    LAS float* ApR = (LAS float*)lds; LAS float* ApI = ApR + 17 * 64;
    LAS float* BbR = ApI + 17 * 64; LAS float* BbI = BbR + 1024;
    LAS float* CR = BbI + 1024; LAS float* CI = CR + 1024; LAS float* Kt = CI + 1024;
    const int tid = opaque_tid();
    for (int item = blockIdx.x; item < 256; item += gridDim.x) {
        const int g = item >> 2, q4 = item & 3;
        if (tid < 64) {
            const int p = tid; const f32x4 dv = *(const f32x4*)((const float*)(a->ws + WS_DISC) + (((size_t)j * 64 + g) * 64 + p) * 8);
            const float abr = dv[0], abi = dv[1], cfr = dv[2], cfi = dv[3];
            float pr = 1.0f, pi = 0.0f;
            for (int n = 0; n <= 16; ++n) { ApR[n * 64 + p] = pr; ApI[n * 64 + p] = pi; const float nr = pr * abr - pi * abi, ni = pr * abi + pi * abr; pr = nr; pi = ni; }
            const size_t gp = ((size_t)j * 64 + g) * 64 + p;
            for (int h = 0; h < 16; ++h) { const float br = a->in[14][gp * 16 + h], bi = a->in[15][gp * 16 + h]; BbR[p * 16 + h] = cfr * br - cfi * bi; BbI[p * 16 + h] = cfr * bi + cfi * br; }
        }
        for (int i = tid; i < 1024; i += NTHREADS) { const size_t ci = ((size_t)j * 64 + g) * 1024 + i; CR[i] = a->in[16][ci]; CI[i] = a->in[17][ci]; }
        __syncthreads();
        for (int e = tid; e < 1024; e += NTHREADS) {
            const int tau = e >> 6, h = 4 * q4 + ((e >> 4) & 3), hp = e & 15; float acc = 0.f;
            for (int p = 0; p < 64; ++p) { const float cr = CR[h * 64 + p], ci = CI[h * 64 + p], ar = ApR[tau * 64 + p], ai = ApI[tau * 64 + p], br = BbR[p * 16 + hp], bi = BbI[p * 16 + hp];
                acc += (cr * ar - ci * ai) * br - (cr * ai + ci * ar) * bi; }
            Kt[e] = acc;
        }
        __syncthreads();
        bf16_t* mq = MQ + (size_t)g * 256 * 384;
        for (int e = tid; e < 64 * 192; e += NTHREADS) {
            const int rl = e / 192, k = (e - rl * 192) * 2, t = rl >> 2, hl = rl & 3, h = 4 * q4 + hl, n = t * 16 + h; float v[2];
#pragma unroll
            for (int q = 0; q < 2; ++q) { const int kk = k + q;
                if (kk < 256) { const int sidx = kk >> 4, hp = kk & 15; v[q] = (sidx <= t) ? Kt[(t - sidx) * 64 + hl * 16 + hp] : 0.f; }
                else if (kk < 320) { const int p = kk - 256; v[q] = CR[h * 64 + p] * ApR[(t + 1) * 64 + p] - CI[h * 64 + p] * ApI[(t + 1) * 64 + p]; }
                else { const int p = kk - 320; v[q] = -(CR[h * 64 + p] * ApI[(t + 1) * 64 + p] + CI[h * 64 + p] * ApR[(t + 1) * 64 + p]); } }
            *(unsigned*)(mq + (size_t)n * 384 + k) = cvt_pk_bf16(v[0], v[1]);
        }
        bf16_t* pp = P + (size_t)g * 128 * 256;
        for (int e = tid; e < 32 * 128; e += NTHREADS) {
            const int rl = e >> 7, k = (e & 127) * 2, im = rl >> 4, p = 16 * q4 + (rl & 15), r = im * 64 + p, sidx = k >> 4; float v[2];
            const float ar = ApR[(15 - sidx) * 64 + p], ai = ApI[(15 - sidx) * 64 + p];
#pragma unroll
            for (int q = 0; q < 2; ++q) { const int hp = (k + q) & 15; const float br = BbR[p * 16 + hp], bi = BbI[p * 16 + hp]; v[q] = im ? (ar * bi + ai * br) : (ar * br - ai * bi); }
            *(unsigned*)(pp + (size_t)r * 256 + k) = cvt_pk_bf16(v[0], v[1]);
        }
        __syncthreads();
    }
}

__device__ void ssm_cscan_phase(int j, const float* PU, bf16_t* U2) {
    CArgs a = get_args();
    const int tid = opaque_tid(), wave = tid >> 6, lane = tid & 63;
    if (wave >= 4) return;
    for (int item = blockIdx.x * 4 + wave; item < NB * 64; item += gridDim.x * 4) {
        const int b = item >> 6, g = item & 63, p = lane;
        const f32x4 dv = *(const f32x4*)((const float*)(a->ws + WS_DISC) + (((size_t)j * 64 + g) * 64 + p) * 8 + 4);
        const float a16r = dv[0], a16i = dv[1];
        float sr = 0.f, si = 0.f;
        const float* pu = PU + ((size_t)g * 2048 + b * 128) * 128 + p;
        bf16_t* uo = U2 + ((size_t)g * 2048 + b * 128) * 384 + 256 + p;
        for (int c0 = 0; c0 < 128; c0 += 32) {
            float lr[32], li[32];
#pragma unroll
            for (int q = 0; q < 32; ++q) { lr[q] = pu[(size_t)(c0 + q) * 128]; li[q] = pu[(size_t)(c0 + q) * 128 + 64]; }
#pragma unroll
            for (int q = 0; q < 32; ++q) {
                uo[(size_t)(c0 + q) * 384] = (bf16_t)(cvt_pk_bf16(sr, 0.f) & 0xffffu); uo[(size_t)(c0 + q) * 384 + 64] = (bf16_t)(cvt_pk_bf16(si, 0.f) & 0xffffu);
                const float nr = a16r * sr - a16i * si + lr[q], ni = a16r * si + a16i * sr + li[q]; sr = nr; si = ni;
            }
        }
    }
}

struct EpiPU {
    static constexpr bool PERM = false, LDSPART = false;
    __device__ __forceinline__ bool lds_part() const { return false; }
    float* PU;
    __device__ __forceinline__ void operator()(const f32x4 (&acc)[2][2][4][2], const Unit& u, int wr, int wc, int fr, int fq, const LAS unsigned char* lp) const {
        { const int ln_ = opaque_tid() & 63; fr = ln_ & 15; fq = ln_ >> 4; }
        const int row0 = u.pm * 256 + wr * 64 + fr, col0 = wc * 32 + 4 * fq;
#pragma unroll
        for (int ai = 0; ai < 2; ++ai)
#pragma unroll
            for (int m = 0; m < 4; ++m)
#pragma unroll
                for (int n = 0; n < 2; ++n) *(f32x4*)(PU + (size_t)(row0 + ai * 128 + m * 16) * 128 + col0 + n * 16) = acc[ai][0][m][n];
    }
};
struct EpiY {
    static constexpr bool PERM = true, LDSPART = false;
    __device__ __forceinline__ bool lds_part() const { return false; }
    const bf16_t* U2; bf16_t* Z; const float* dsk;
    __device__ __forceinline__ void operator()(const f32x4 (&acc)[2][2][4][2], const Unit& u, int wr, int wc, int fr, int fq, const LAS unsigned char* lp) const {
        { const int ln_ = opaque_tid() & 63; fr = ln_ & 15; fq = ln_ >> 4; }
        const int g = u.pm >> 3, rg0 = (u.pm & 7) * 256 + wr * 64 + fr, h0 = 8 * (fq & 1), tq = 2 * wc + (fq >> 1);
        const f32x4 d0 = *(const f32x4*)(dsk + g * 16 + h0), d1 = *(const f32x4*)(dsk + g * 16 + h0 + 4);
#pragma unroll
        for (int gp = 0; gp < 4; ++gp) {
            const int ai = gp >> 1;
            u32x4 uw[2][2];
#pragma unroll
            for (int mm = 0; mm < 2; ++mm)
#pragma unroll
                for (int bj = 0; bj < 2; ++bj) uw[mm][bj] = *(const u32x4*)(U2 + ((size_t)g * 2048 + rg0 + ai * 128 + ((gp & 1) * 2 + mm) * 16) * 384 + 16 * (8 * bj + tq) + h0);
#pragma unroll
            for (int mm = 0; mm < 2; ++mm) {
                const int m = (gp & 1) * 2 + mm;
                const int rg = rg0 + ai * 128 + m * 16, b = rg >> 7, cc = rg & 127;
                bf16_t* zrow = Z + (size_t)(b * SEQ + 16 * cc) * DM + g * 16 + h0;
#pragma unroll
                for (int bj = 0; bj < 2; ++bj) {
                    const u32x4 uv = uw[mm][bj];
                    const f32x4 y0 = acc[ai][bj][m][0], y1 = acc[ai][bj][m][1];
                    u32x4 w;
                    w.x = cvt_pk_bf16(gelu_tanh(y0[0] + d0[0] * bf_lo(uv.x)), gelu_tanh(y0[1] + d0[1] * bf_hi(uv.x)));
                    w.y = cvt_pk_bf16(gelu_tanh(y0[2] + d0[2] * bf_lo(uv.y)), gelu_tanh(y0[3] + d0[3] * bf_hi(uv.y)));
                    w.z = cvt_pk_bf16(gelu_tanh(y1[0] + d1[0] * bf_lo(uv.z)), gelu_tanh(y1[1] + d1[1] * bf_hi(uv.z)));
                    w.w = cvt_pk_bf16(gelu_tanh(y1[2] + d1[2] * bf_lo(uv.w)), gelu_tanh(y1[3] + d1[3] * bf_hi(uv.w)));
                    *(u32x4*)(zrow + (size_t)(8 * bj + tq) * DM) = w;
                }
            }
            asm volatile("" ::: "memory");
        }
    }
};

__device__ void attn_phase(const bf16_t* Q, const bf16_t* Kall, const bf16_t* VT, bf16_t* O, int layer, LAS unsigned char* lds) {
    const int tid0 = opaque_tid(), wave = __builtin_amdgcn_readfirstlane(tid0 >> 6);
    for (int unit = blockIdx.x; unit < NB * 4 * 8; unit += gridDim.x) {
        int lane = tid0 & 63; asm volatile("" : "+v"(lane));
        const int r = lane & 31, h = lane >> 5;
#define ATT_VOFF() int ln_ = tid0 & 63; asm volatile("" : "+v"(ln_)); const int rb = 2 * wave + (ln_ >> 5), cc0 = (ln_ & 31) ^ rb; \
        const unsigned voff_e = (unsigned)(rb * 4096 + cc0 * 8) * 2u, voff_o = (unsigned)(rb * 4096 + (cc0 ^ 16) * 8) * 2u
        const int b = unit >> 5, hd = (unit >> 3) & 3, qt = unit & 7;
        const int t0 = b * SEQ + qt * 256 + wave * 32;
        const bf16_t* qp = Q + (size_t)(t0 + r) * DM + hd * 256 + 8 * h;
        bf16x8 qf[16];
#pragma unroll
        for (int kk = 0; kk < 16; ++kk) qf[kk] = *(const bf16x8*)(qp + 16 * kk);
        __syncthreads();
        {
            ATT_VOFF();
            const char* kb = (const char*)(Kall + (size_t)(b * MEML) * 4096 + layer * 1024 + hd * 256);
#pragma unroll
            for (int it = 0; it < 16; ++it)
                __builtin_amdgcn_global_load_lds((const unsigned*)(kb + (size_t)it * 16 * 4096 * 2 + ((it & 1) ? voff_o : voff_e)), (LAS unsigned*)(lds + (it * 8 + wave) * 1024), 16, 0, 0);
        }
        asm volatile("s_waitcnt vmcnt(0)" ::: "memory");
        __syncthreads();
        bf16x8 pf[8][2]; float mh[4], mrun = -3.0e38f, drun = 0.f;
#pragma unroll
        for (int hf = 0; hf < 4; ++hf) {
            int r = lane & 31, h = lane >> 5; asm volatile("" : "+v"(r), "+v"(h));
            f32x16 s[2];
#pragma unroll
            for (int k4 = 0; k4 < 2; ++k4) {
                const int kt = hf * 2 + k4;
                f32x16 acc;
#pragma unroll
                for (int e = 0; e < 16; ++e) acc[e] = 0.f;
#pragma unroll
                for (int k8 = 0; k8 < 4; ++k8) {
                    bf16x8 af[4];
#pragma unroll
                    for (int i = 0; i < 4; ++i) af[i] = *(const LAS bf16x8*)(lds + (32 * kt + r) * 512 + (((2 * (4 * k8 + i) + h) ^ r) << 4));
                    __builtin_amdgcn_sched_group_barrier(0x100, 4, 0);
                    __builtin_amdgcn_sched_group_barrier(0x008, 4, 0);
#pragma unroll
                    for (int i = 0; i < 4; ++i) acc = __builtin_amdgcn_mfma_f32_32x32x16_bf16(af[i], qf[4 * k8 + i], acc, 0, 0, 0);
                }
                s[k4] = acc;
            }
            float mx = -3.0e38f;
#pragma unroll
            for (int k4 = 0; k4 < 2; ++k4)
#pragma unroll
                for (int e = 0; e < 16; ++e) mx = fmaxf(mx, s[k4][e]);
            mx = fmaxf(mx, shx(mx, 32));
            float sum = 0.f;
#pragma unroll
            for (int k4 = 0; k4 < 2; ++k4)
#pragma unroll
                for (int e = 0; e < 16; ++e) { const float pv = __builtin_amdgcn_exp2f(s[k4][e] - mx); s[k4][e] = pv; sum += pv; }
            sum += shx(sum, 32);
            { const float mnew = fmaxf(mrun, mx); drun = drun * __builtin_amdgcn_exp2f(mrun - mnew) + sum * __builtin_amdgcn_exp2f(mx - mnew); mrun = mnew; mh[hf] = mx; }
#pragma unroll
            for (int k4 = 0; k4 < 2; ++k4)
#pragma unroll
                for (int s2 = 0; s2 < 2; ++s2) {
                    u32x4 w;
                    w.x = cvt_pk_bf16(s[k4][8 * s2 + 0], s[k4][8 * s2 + 1]); w.y = cvt_pk_bf16(s[k4][8 * s2 + 2], s[k4][8 * s2 + 3]);
                    w.z = cvt_pk_bf16(s[k4][8 * s2 + 4], s[k4][8 * s2 + 5]); w.w = cvt_pk_bf16(s[k4][8 * s2 + 6], s[k4][8 * s2 + 7]);
                    pf[hf * 2 + k4][s2] = __builtin_bit_cast(bf16x8, w);
                }
        }
        asm volatile("s_waitcnt lgkmcnt(0)" ::: "memory");
        __syncthreads();
        {
            ATT_VOFF();
            const char* vb = (const char*)(VT + (size_t)(layer * 1024 + hd * 256) * 4096 + b * MEML);
#pragma unroll
            for (int it = 0; it < 16; ++it)
                __builtin_amdgcn_global_load_lds((const unsigned*)(vb + (size_t)it * 16 * 4096 * 2 + ((it & 1) ? voff_o : voff_e)), (LAS unsigned*)(lds + (it * 8 + wave) * 1024), 16, 0, 0);
        }
        float fq[4];
        const float inv = 1.0f / drun;
#pragma unroll
        for (int q = 0; q < 4; ++q) fq[q] = __builtin_amdgcn_exp2f(mh[q] - mrun) * inv;
        asm volatile("s_waitcnt vmcnt(0)" ::: "memory");
        __syncthreads();
        bf16_t* op = O + (size_t)(t0 + r) * DM + hd * 256 + 4 * h;
        int rv = lane & 31, hv = lane >> 5; asm volatile("" : "+v"(rv), "+v"(hv));
#pragma unroll
        for (int dt = 0; dt < 8; ++dt) {
            f32x16 ac[4];
#pragma unroll
            for (int q = 0; q < 4; ++q)
#pragma unroll
                for (int e = 0; e < 16; ++e) ac[q][e] = 0.f;
            const LAS unsigned char* rowp = lds + (32 * dt + rv) * 512 + 8 * hv;
#pragma unroll
            for (int kt = 0; kt < 8; ++kt) {
                u32x4 vf[2];
#pragma unroll
                for (int s2 = 0; s2 < 2; ++s2) {
                    const u32x2 lo = *(const LAS u32x2*)(rowp + (((4 * kt + 2 * s2) ^ rv) << 4)), hi = *(const LAS u32x2*)(rowp + (((4 * kt + 2 * s2 + 1) ^ rv) << 4));
                    vf[s2].x = lo.x; vf[s2].y = lo.y; vf[s2].z = hi.x; vf[s2].w = hi.y;
                }
                __builtin_amdgcn_sched_group_barrier(0x100, 4, 0);
                __builtin_amdgcn_sched_group_barrier(0x008, 2, 0);
#pragma unroll
                for (int s2 = 0; s2 < 2; ++s2) ac[kt >> 1] = __builtin_amdgcn_mfma_f32_32x32x16_bf16(__builtin_bit_cast(bf16x8, vf[s2]), pf[kt][s2], ac[kt >> 1], 0, 0, 0);
            }
#pragma unroll
            for (int g4 = 0; g4 < 4; ++g4) {
                float o[4];
#pragma unroll
                for (int e = 0; e < 4; ++e) o[e] = (ac[0][4 * g4 + e] * fq[0] + ac[1][4 * g4 + e] * fq[1]) + (ac[2][4 * g4 + e] * fq[2] + ac[3][4 * g4 + e] * fq[3]);
                u32x2 w; w.x = cvt_pk_bf16(o[0], o[1]); w.y = cvt_pk_bf16(o[2], o[3]);
                *(u32x2*)(op + dt * 32 + 8 * g4) = w;
            }
        }
        asm volatile("s_waitcnt lgkmcnt(0)" ::: "memory");
    }
    __syncthreads();
}

__device__ void final_norm_phase(const bf16_t* xb, float* out, const float* g) {
    const int tid0 = opaque_tid(), lane = tid0 & 63, gw = blockIdx.x * 8 + (tid0 >> 6), nw = gridDim.x * 8;
    f32x4 gg[4];
#pragma unroll
    for (int i = 0; i < 4; ++i) gg[i] = *(const f32x4*)(g + i * 256 + lane * 4);
    for (int row = gw; row < T_TOK; row += 2 * nw) {
        u32x2 b2[2][4];
#pragma unroll
        for (int rr = 0; rr < 2; ++rr)
#pragma unroll
            for (int i = 0; i < 4; ++i) b2[rr][i] = *(const u32x2*)(xb + (size_t)(row + rr * nw) * DM + i * 256 + lane * 4);
#pragma unroll
        for (int rr = 0; rr < 2; ++rr) {
            f32x4 v[4]; float ss = 0.f;
#pragma unroll
            for (int i = 0; i < 4; ++i) {
                v[i][0] = bf_lo(b2[rr][i].x); v[i][1] = bf_hi(b2[rr][i].x); v[i][2] = bf_lo(b2[rr][i].y); v[i][3] = bf_hi(b2[rr][i].y);
                ss += (v[i][0] * v[i][0] + v[i][1] * v[i][1]) + (v[i][2] * v[i][2] + v[i][3] * v[i][3]);
            }
#pragma unroll
            for (int o = 32; o >= 1; o >>= 1) ss += shx(ss, o);
            const float rs = 1.0f / sqrtf(ss * (1.0f / 1024.0f) + NORM_EPS);
#pragma unroll
            for (int i = 0; i < 4; ++i) *(f32x4*)(out + (size_t)(row + rr * nw) * DM + i * 256 + lane * 4) = v[i] * rs * gg[i];
        }
    }
}

__global__ void __launch_bounds__(NTHREADS, 2) mega_fwd(Args a_unused) {
    extern __shared__ __attribute__((aligned(16))) unsigned char lds_raw[];
    LAS unsigned char* lds = (LAS unsigned char*)lds_raw;
    cg::grid_group grid = cg::this_grid();
    const int G = gridDim.x, c = blockIdx.x;
#define WSP(off) (get_args()->ws + (off))
#define XB_ ((bf16_t*)WSP(WS_XB))
#define HB_ ((bf16_t*)WSP(WS_HB))
#define HB2_ ((bf16_t*)WSP(WS_HB + (size_t)T_TOK * DM * 2))
#define PART_ ((float*)WSP(WS_PART))
#define OUT_ (get_args()->out)

    { unsigned* bar0 = (unsigned*)WSP(WS_BAR); if (blockIdx.x == 0 && threadIdx.x < 33) __hip_atomic_store(bar0 + 64 * threadIdx.x, 0u, __ATOMIC_RELAXED, __HIP_MEMORY_SCOPE_AGENT); }
    unsigned bar_k = 0;
#define GRID_BAR() do { bar_k += 1u; grid_barrier((unsigned*)WSP(WS_BAR), bar_k, 16u, (unsigned)G / 16u); } while (0)
    prep_phase(lds);
    grid.sync();
    {
        pg8::StaticOrder S; S.init(4096, 4096, G, c);
        { pg8::Gemm g = pg8::mk_gemm((const bf16_t*)WSP(WS_MEMB), (const bf16_t*)WSP(WS_K), DM); EpiBf16S E{(bf16_t*)WSP(WS_KALL), 4096, nullptr, 0, 1.0f}; pg8::gemm_phase(lds, g, S, E); }
        { pg8::Gemm g = pg8::mk_gemm((const bf16_t*)WSP(WS_VT), (const bf16_t*)WSP(WS_MEMB), DM); EpiBf16S E{(bf16_t*)WSP(WS_VTALL), 4096, nullptr, 0, 1.0f}; pg8::gemm_phase(lds, g, S, E); }
    }
#pragma unroll 1
    for (int l = 0; l < NLAYER; ++l) {
#pragma unroll 1
        for (int pass = 0; pass < 2; ++pass) {
            {
                pg8::StaticOrder S; S.init(T_TOK, 2 * DFF, G, c);
                pg8::Gemm g = pg8::mk_gemm(XB_, (const bf16_t*)WSP((pass ? WS_UP2 : WS_UP1) + l * SZ_UP), DM);
                EpiSwiglu E{HB_, PART_, 16}; pg8::gemm_phase(lds, g, S, E);
            }
            GRID_BAR();
            {
                pg8::StaticOrder S; S.init(T_TOK, DM, G, c);
                pg8::Gemm g = pg8::mk_gemm(HB_, (const bf16_t*)WSP((pass ? WS_DN2 : WS_DN1) + l * SZ_DN), DFF);
                EpiResid E{(l == 0 && pass == 0) ? get_args()->in[0] : (const float*)nullptr, XB_, PART_, 0.5f}; pg8::gemm_phase(lds, g, S, E);
            }
            GRID_BAR();
            if (pass == 0) {
                const int j = l >> 1; int np_q;
                if ((l & 1) == 0) {
                    {
                        pg8::StaticOrder S; S.init(T_TOK, 3 * DM, G, c);
                        pg8::Gemm g = pg8::mk_gemm(XB_, (const bf16_t*)WSP(WS_CIN + j * 3 * SZ_SQ), DM);
                        EpiConvIn E{HB_, HB2_, PART_, 16}; pg8::gemm_phase(lds, g, S, E);
                    }
                    GRID_BAR();
                    conv_phase(HB_, HB2_, get_args()->in[9] + (size_t)j * 3 * DM);
                    GRID_BAR();
                    {
                        pg8::StaticOrder S; S.init(T_TOK, DM, G, c);
                        pg8::Gemm g = pg8::mk_gemm(HB2_, (const bf16_t*)WSP(WS_COUT + j * SZ_SQ), DM);
                        EpiResid E{nullptr, XB_, PART_, 1.0f}; pg8::gemm_phase(lds, g, S, E);
                    }
                    GRID_BAR();
                    np_q = 16;
                } else {
#define U2_ HB_
#define PU_ ((float*)WSP(WS_HB + SSM_PU_OFF))
#define Z_ ((bf16_t*)WSP(WS_HB + SSM_PU_OFF))
#define MQ_ ((bf16_t*)WSP(WS_HB + SSM_MQ_OFF))
#define PM_ ((bf16_t*)WSP(WS_HB + SSM_P_OFF))
                    ssm_uprep_phase(XB_, PART_, get_args()->in[2] + (size_t)(l * 5 + 1) * DM, U2_);
                    ssm_build_phase(j, MQ_, PM_, lds);
                    GRID_BAR();
                    {
                        pg8::GroupOrder S{G, c};
                        pg8::Gemm g{U2_, PM_, 256, 384, (size_t)128 * 256 * 2};
                        EpiPU E{PU_}; pg8::gemm_phase(lds, g, S, E);
                    }
                    GRID_BAR();
                    ssm_cscan_phase(j, PU_, U2_);
                    GRID_BAR();
                    {
                        pg8::GroupOrder S{G, c};
                        pg8::Gemm g{U2_, MQ_, 384, 384, (size_t)256 * 384 * 2};
                        EpiY E{U2_, Z_, get_args()->in[18] + (size_t)j * DM}; pg8::gemm_phase(lds, g, S, E);
                    }
                    GRID_BAR();
                    {
                        pg8::StaticOrder S; S.init(T_TOK, 2 * DM, G, c);
                        pg8::Gemm g = pg8::mk_gemm(Z_, (const bf16_t*)WSP(WS_GLU + j * 2 * SZ_SQ), DM);
                        EpiGlu E{XB_, PART_}; pg8::gemm_phase(lds, g, S, E);
                    }
                    GRID_BAR();
                    np_q = 32;
                }
                {
                    pg8::StaticOrder S; S.init(T_TOK, DM, G, c);
                    pg8::Gemm g = pg8::mk_gemm(XB_, (const bf16_t*)WSP(WS_Q + l * SZ_SQ), DM);
                    EpiBf16S E{HB_, DM, PART_, np_q, 0.0625f * 1.44269504089f}; pg8::gemm_phase(lds, g, S, E);
                }
                GRID_BAR();
                attn_phase(HB_, (const bf16_t*)WSP(WS_KALL), (const bf16_t*)WSP(WS_VTALL), HB2_, l, lds);
                GRID_BAR();
                {
                    pg8::StaticOrder S; S.init(T_TOK, DM, G, c);
                    pg8::Gemm g = pg8::mk_gemm(HB2_, (const bf16_t*)WSP(WS_O + l * SZ_SQ), DM);
                    EpiResid E{nullptr, XB_, PART_, 1.0f}; pg8::gemm_phase(lds, g, S, E);
                }
                GRID_BAR();
            }
        }
    }
    final_norm_phase(XB_, OUT_, get_args()->in[3]);
}

extern "C" void kernel_launch(void* const* d_in, const int* in_sizes, int n_in, void* d_out, int out_size, void* d_ws, size_t ws_size, hipStream_t stream) {
    static int grid_blocks = 0;
    if (grid_blocks == 0) {
        if (n_in != 23 || out_size != T_TOK * DM || ws_size < WS_END) { fprintf(stderr, "kernel_launch: unexpected shapes (n_in %d out %d ws %zu need %zu)\n", n_in, out_size, ws_size, (size_t)WS_END); grid_blocks = -1; return; }
        int dev = 0, cus = 0, per_cu = 0;
        hipGetDevice(&dev);
        hipDeviceGetAttribute(&cus, hipDeviceAttributeMultiprocessorCount, dev);
        if (hipFuncSetAttribute((const void*)mega_fwd, hipFuncAttributeMaxDynamicSharedMemorySize, LDS_BYTES) != hipSuccess) { fprintf(stderr, "kernel_launch: hipFuncSetAttribute failed\n"); grid_blocks = -1; return; }
        if (hipOccupancyMaxActiveBlocksPerMultiprocessor(&per_cu, (const void*)mega_fwd, NTHREADS, LDS_BYTES) != hipSuccess || per_cu < 1) { fprintf(stderr, "kernel_launch: occupancy query gave %d\n", per_cu); per_cu = 1; }
        (void)hipGetLastError();
        grid_blocks = cus * 1;
    }
    if (grid_blocks < 0) return;
    Args a{};
    for (int i = 0; i < 23; ++i) a.in[i] = (const float*)d_in[i];
    a.out = (float*)d_out; a.ws = (unsigned char*)d_ws;
    void* args[] = {&a};
    hipError_t e = hipLaunchCooperativeKernel((const void*)mega_fwd, dim3(grid_blocks), dim3(NTHREADS), args, LDS_BYTES, stream);
    if (e != hipSuccess) fprintf(stderr, "cooperative launch failed: %s (grid %d)\n", hipGetErrorString(e), grid_blocks);
}
```

```cpp
#include <hip/hip_runtime.h>
#include <hip/hip_cooperative_groups.h>
#include <cstdio>
namespace cg = cooperative_groups;

#define LAS __attribute__((address_space(3)))
typedef unsigned short bf16_t;
typedef short bf16x8 __attribute__((ext_vector_type(8)));
typedef float f32x4 __attribute__((ext_vector_type(4)));
typedef float f32x16 __attribute__((ext_vector_type(16)));
typedef unsigned u32x4 __attribute__((ext_vector_type(4)));
typedef unsigned u32x2 __attribute__((ext_vector_type(2)));

constexpr int T_TOK = 32768, DM = 1024, DFF = 2816, SEQ = 2048, NB = 16, MEML = 256, NLAYER = 4;
constexpr int NTHREADS = 512;
constexpr int LDS_BYTES = 131072 + 32768;
constexpr float NORM_EPS = 1e-6f;

constexpr size_t SZ_UP = (size_t)2 * DFF * DM * 2, SZ_DN = (size_t)DM * DFF * 2, SZ_SQ = (size_t)DM * DM * 2;
constexpr size_t WS_UP1 = 0;
constexpr size_t WS_DN1 = WS_UP1 + 4 * SZ_UP;
constexpr size_t WS_UP2 = WS_DN1 + 4 * SZ_DN;
constexpr size_t WS_DN2 = WS_UP2 + 4 * SZ_UP;
constexpr size_t WS_CIN = WS_DN2 + 4 * SZ_DN;
constexpr size_t WS_COUT = WS_CIN + 2 * 3 * SZ_SQ;
constexpr size_t WS_GLU = WS_COUT + 2 * SZ_SQ;
constexpr size_t WS_Q = WS_GLU + 2 * 2 * SZ_SQ;
constexpr size_t WS_K = WS_Q + 4 * SZ_SQ;
constexpr size_t WS_VT = WS_K + 4 * SZ_SQ;
constexpr size_t WS_O = WS_VT + 4 * SZ_SQ;
constexpr size_t WS_XB = WS_O + 4 * SZ_SQ;
constexpr size_t WS_HB = WS_XB + (size_t)T_TOK * DM * 2;
constexpr size_t WS_MEMB = WS_HB + (size_t)T_TOK * DFF * 2;
constexpr size_t WS_KALL = WS_MEMB + (size_t)4096 * DM * 2;
constexpr size_t WS_VTALL = WS_KALL + (size_t)4096 * 4096 * 2;
constexpr size_t WS_PART = WS_VTALL + (size_t)4096 * 4096 * 2;
constexpr size_t WS_DISC = WS_PART + (size_t)T_TOK * 32 * 4;
constexpr size_t WS_BAR = WS_DISC + (size_t)2 * 64 * 64 * 8 * 4;
constexpr size_t WS_END = WS_BAR + 256 * 33;

__device__ __forceinline__ unsigned cvt_pk_bf16(float lo, float hi) { unsigned r; asm volatile("v_cvt_pk_bf16_f32 %0, %1, %2" : "=v"(r) : "v"(lo), "v"(hi)); return r; }
__device__ __forceinline__ float bf_lo(unsigned w) { return __uint_as_float(w << 16); }
__device__ __forceinline__ float bf_hi(unsigned w) { return __uint_as_float(w & 0xffff0000u); }
__device__ __forceinline__ float fast_sigmoid(float x) { return __builtin_amdgcn_rcpf(1.0f + __builtin_amdgcn_exp2f(-1.44269504089f * x)); }
__device__ __forceinline__ float gelu_tanh(float x) { const float a = 1.5957691216f * (x + 0.044715f * x * x * x); return x * fast_sigmoid(a); }

__device__ __forceinline__ void grid_barrier(unsigned* bar, unsigned k, unsigned nsub, unsigned per_sub) {
    asm volatile("s_waitcnt vmcnt(0)" ::: "memory");
    __syncthreads();
    if (threadIdx.x == 0) {
        __builtin_amdgcn_fence(__ATOMIC_RELEASE, "agent");
        asm volatile("s_waitcnt vmcnt(0)" ::: "memory");
        const unsigned old = __hip_atomic_fetch_add(bar + 64 * (1 + (blockIdx.x % nsub)), 1u, __ATOMIC_RELAXED, __HIP_MEMORY_SCOPE_AGENT);
        if (old + 1u == k * per_sub) {
            const unsigned oldt = __hip_atomic_fetch_add(bar, 1u, __ATOMIC_RELAXED, __HIP_MEMORY_SCOPE_AGENT);
            if (oldt + 1u == k * nsub)
                for (unsigned i = 0; i < nsub; ++i) __hip_atomic_store(bar + 64 * (17 + i), k, __ATOMIC_RELAXED, __HIP_MEMORY_SCOPE_AGENT);
        }
        while (__hip_atomic_load(bar + 64 * (17 + (blockIdx.x % nsub)), __ATOMIC_RELAXED, __HIP_MEMORY_SCOPE_AGENT) < k) __builtin_amdgcn_s_sleep(1);
        __builtin_amdgcn_fence(__ATOMIC_ACQUIRE, "agent");
        asm volatile("s_waitcnt vmcnt(0)" ::: "memory");
    }
    __syncthreads();
}
__device__ __forceinline__ float shx(float v, int mask) {
    unsigned m = ~0u; asm volatile("" : "+s"(m));
    const int lane = __builtin_amdgcn_mbcnt_hi(m, __builtin_amdgcn_mbcnt_lo(m, 0));
    return __int_as_float(__builtin_amdgcn_ds_bpermute((lane ^ mask) << 2, __float_as_int(v)));
}
template <class T> __device__ __forceinline__ T* launder(T* p) { asm volatile("" : "+s"(p)); return p; }
__device__ __forceinline__ int opaque_tid() { int t = threadIdx.x; asm volatile("" : "+v"(t)); return t; }

namespace pg8 {
constexpr int BM = 256, BK = 64, HALF = 128, HTB = HALF * BK * 2, STAGE_BYTES = 8 * HTB, NXCD = 8, WGM = 4;
__host__ __device__ __forceinline__ int lds_byte(int r, int c) { const int st = (r >> 4) * 2 + (c >> 5), rr = r & 15, cc = c & 31, ob = rr * 64 + cc * 2; return st * 1024 + (ob ^ (((ob >> 9) & 1) << 5)); }
__host__ __device__ __forceinline__ void stage_rc(int b, int& R, int& C) { const int st = b / 1024, sb = b % 1024, swz = sb ^ (((sb >> 9) & 1) << 5); R = (st >> 1) * 16 + swz / 64; C = (st & 1) * 32 + (swz % 64) / 2; }
__host__ __device__ __forceinline__ int perm32(int rho) { const int n = rho >> 4, i = rho & 15; return 8 * (i >> 2) + 4 * n + (i & 3); }

struct Unit { int pm, pn; };
struct Gemm { const bf16_t* A; const bf16_t* Bt; int K, lda; size_t tstepB; };
__device__ __forceinline__ Gemm mk_gemm(const bf16_t* A, const bf16_t* Bt, int K) { return Gemm{A, Bt, K, K, (size_t)512 * K}; }

struct StaticOrder {
    int nM, nN, nwg, G, c;
    __device__ void init(int M, int N, int G_, int c_) { nM = M / BM; nN = N / BM; nwg = nM * nN; G = G_; c = c_; }
    __device__ bool next(int i, Unit& u) const {
        const long L = (long)i * G + c; if (L >= nwg) return false;
        int wgid = (int)L; { const int q = nwg / NXCD, r = nwg % NXCD, xcd = wgid % NXCD, off = wgid / NXCD; wgid = (xcd < r ? xcd * (q + 1) : r * (q + 1) + (xcd - r) * q) + off; }
        const int nig = WGM * nN, gid = wgid / nig, fm = gid * WGM, gsz = (nM - fm) < WGM ? (nM - fm) : WGM;
        u.pm = fm + ((wgid % nig) % gsz); u.pn = (wgid % nig) / gsz; return true;
    }
};

struct GroupOrder {
    int G, c;
    __device__ bool next(int i, Unit& u) const { const int L = i * G + c; if (L >= 512) return false; u.pm = L; u.pn = L >> 3; return true; }
};

template <class Epi, class Sched>
__device__ __forceinline__ void gemm_phase(LAS unsigned char* lds, const Gemm g, const Sched& S, const Epi& E) {
    const int tid = opaque_tid(), wid = __builtin_amdgcn_readfirstlane(tid >> 6), lane = tid & 63, wr = wid >> 2, wc = wid & 3, fr = lane & 15, fq = lane >> 4;
    const int K = g.K, nt = K / BK;
    unsigned voffA[2], voffB[2];
#pragma unroll
    for (int i = 0; i < 2; ++i) { int R, C; stage_rc(tid * 16 + i * 8192, R, C); const int Rb = Epi::PERM ? ((R & ~31) + perm32(R & 31)) : R;
        voffA[i] = (unsigned)(R * g.lda + C) * 2u; voffB[i] = (unsigned)(Rb * K + C) * 2u; }
    const size_t kstep = (size_t)(BK * 2);
    const size_t hstepA = (size_t)HALF * g.lda * 2, hstepB = (size_t)HALF * K * 2;
    const size_t tstepA = 2 * hstepA, tstepB = g.tstepB;
    const unsigned ldsw = (unsigned)wid * 1024u;
    const int aoff = lds_byte(wr * 64 + fr, fq * 8), boff = lds_byte(wc * 32 + fr, fq * 8);
#define PG8_SA(b, h) (((b) * 2 + (h)) * HTB)
#define PG8_SB(b, h) ((4 + (b) * 2 + (h)) * HTB)
#define PG8_STAGE(bufoff, gbase, voff) do { _Pragma("unroll") for (int _i = 0; _i < 2; ++_i) { unsigned vo_ = (voff)[_i]; asm volatile("" : "+v"(vo_));   \
        __builtin_amdgcn_global_load_lds((const unsigned*)((const char*)(gbase) + vo_), (LAS unsigned*)(lds + (bufoff) + ldsw + _i * 8192), 16, 0, 0); } } while (0)
#define PG8_LDA(dst, b, h) do { _Pragma("unroll") for (int m = 0; m < 4; ++m) _Pragma("unroll") for (int k = 0; k < 2; ++k) dst[m][k] = *(const LAS bf16x8*)(lds + PG8_SA(b, h) + aoff + m * 2048 + k * 1024); } while (0)
#define PG8_LDB(dst, b, h) do { _Pragma("unroll") for (int n = 0; n < 2; ++n) _Pragma("unroll") for (int k = 0; k < 2; ++k) dst[n][k] = *(const LAS bf16x8*)(lds + PG8_SB(b, h) + boff + n * 2048 + k * 1024); } while (0)
#define PG8_MMA(ai, bj, At, Bt) do { __builtin_amdgcn_s_setprio(1); _Pragma("unroll") for (int m = 0; m < 4; ++m) _Pragma("unroll") for (int n = 0; n < 2; ++n) _Pragma("unroll") for (int k = 0; k < 2; ++k) \
        acc[ai][bj][m][n] = __builtin_amdgcn_mfma_f32_16x16x32_bf16(Bt[n][k], At[m][k], acc[ai][bj][m][n], 0, 0, 0); __builtin_amdgcn_s_setprio(0); } while (0)
#define PG8_WAIT_V(n) asm volatile("s_waitcnt vmcnt(" #n ")" ::: "memory")
#define PG8_WAIT_L(n) asm volatile("s_waitcnt lgkmcnt(" #n ")" ::: "memory")
#define PG8_BAR __builtin_amdgcn_s_barrier()
#define PG8_SCHED __builtin_amdgcn_sched_barrier(0)
    const bool lp = Epi::LDSPART && E.lds_part();
#define PG8_PART_DMA(unit, buf) do { if constexpr (Epi::LDSPART) { if (lp) { const char* ps_ = (const char*)E.part + ((size_t)(unit).pm * 256 + 32 * wid) * 128; const unsigned pv_ = (unsigned)((lane >> 2) * 128 + (lane & 3) * 16); \
        __builtin_amdgcn_global_load_lds((const unsigned*)(ps_ + pv_), (LAS unsigned*)(lds + STAGE_BYTES + (buf) * 16384 + (32 * wid) * 64), 16, 0, 0); \
        __builtin_amdgcn_global_load_lds((const unsigned*)(ps_ + 2048 + pv_), (LAS unsigned*)(lds + STAGE_BYTES + (buf) * 16384 + (32 * wid + 16) * 64), 16, 0, 0); } } } while (0)
    Unit cur, nxt; int ui = 0;
    if (!S.next(0, cur)) return;
    f32x4 acc[2][2][4][2];
#pragma unroll
    for (int a = 0; a < 2; ++a)
#pragma unroll
        for (int b = 0; b < 2; ++b)
#pragma unroll
            for (int m = 0; m < 4; ++m)
#pragma unroll
                for (int n = 0; n < 2; ++n) acc[a][b][m][n] = (f32x4){0.f, 0.f, 0.f, 0.f};
    bf16x8 At[4][2], B0[2][2], B1[2][2];
    const char* cA = (const char*)g.A + (size_t)cur.pm * tstepA; const char* cB = (const char*)g.Bt + (size_t)cur.pn * tstepB;
    PG8_PART_DMA(cur, 0);
    PG8_STAGE(PG8_SB(0, 0), cB, voffB); PG8_STAGE(PG8_SA(0, 0), cA, voffA); PG8_STAGE(PG8_SB(0, 1), cB + hstepB, voffB); PG8_STAGE(PG8_SA(0, 1), cA + hstepA, voffA);
    if (wr == 1) PG8_BAR;
    PG8_WAIT_V(4); PG8_BAR;
    PG8_STAGE(PG8_SB(1, 0), cB + kstep, voffB); PG8_STAGE(PG8_SA(1, 0), cA + kstep, voffA); PG8_STAGE(PG8_SB(1, 1), cB + hstepB + kstep, voffB);
    PG8_WAIT_V(6); PG8_BAR;
    for (;;) {
        const bool has_next = S.next(ui + 1, nxt);
        const char* nA = has_next ? (const char*)g.A + (size_t)nxt.pm * tstepA : cA; const char* nB = has_next ? (const char*)g.Bt + (size_t)nxt.pn * tstepB : cB;
        for (int t = 0; t < nt; t += 2) {
            const bool last = (t == nt - 2);
            const char* a1 = cA + (size_t)(t + 1) * kstep;
            const char* a2 = last ? nA : cA + (size_t)(t + 2) * kstep; const char* b2 = last ? nB : cB + (size_t)(t + 2) * kstep;
            const char* a3 = a2 + kstep; const char* b3 = b2 + kstep;
            PG8_LDB(B0, 0, 0); PG8_SCHED; PG8_LDA(At, 0, 0); PG8_STAGE(PG8_SA(1, 1), a1 + hstepA, voffA);
            PG8_WAIT_L(8); PG8_BAR; PG8_WAIT_L(0); PG8_MMA(0, 0, At, B0); PG8_BAR; PG8_SCHED;
            PG8_LDB(B1, 0, 1); PG8_STAGE(PG8_SB(0, 0), b2, voffB);
            PG8_BAR; PG8_WAIT_L(0); PG8_MMA(0, 1, At, B1); PG8_BAR;
            PG8_LDA(At, 0, 1); PG8_STAGE(PG8_SA(0, 0), a2, voffA);
            PG8_BAR; PG8_WAIT_L(0); PG8_MMA(1, 0, At, B0); PG8_BAR; PG8_SCHED;
            PG8_STAGE(PG8_SB(0, 1), b2 + hstepB, voffB);
            PG8_WAIT_V(6); PG8_BAR;
            if (last && has_next) PG8_PART_DMA(nxt, (ui + 1) & 1);
            PG8_MMA(1, 1, At, B1); PG8_BAR;
            PG8_LDB(B0, 1, 0); PG8_SCHED; PG8_LDA(At, 1, 0); PG8_STAGE(PG8_SA(0, 1), a2 + hstepA, voffA);
            PG8_WAIT_L(8); PG8_BAR; PG8_WAIT_L(0); PG8_MMA(0, 0, At, B0); PG8_BAR; PG8_SCHED;
            PG8_LDB(B1, 1, 1); PG8_STAGE(PG8_SB(1, 0), b3, voffB);
            PG8_BAR; PG8_WAIT_L(0); PG8_MMA(0, 1, At, B1); PG8_BAR;
            PG8_LDA(At, 1, 1); PG8_STAGE(PG8_SA(1, 0), a3, voffA);
            PG8_BAR; PG8_WAIT_L(0); PG8_MMA(1, 0, At, B0); PG8_BAR; PG8_SCHED;
            PG8_STAGE(PG8_SB(1, 1), b3 + hstepB, voffB);
            PG8_WAIT_V(6); PG8_BAR; PG8_MMA(1, 1, At, B1); PG8_BAR;
        }
        E(acc, cur, wr, wc, fr, fq, lp ? (const LAS unsigned char*)(lds + STAGE_BYTES + (ui & 1) * 16384) : (const LAS unsigned char*)nullptr);
        if (!has_next) break;
#pragma unroll
        for (int a = 0; a < 2; ++a)
#pragma unroll
            for (int b = 0; b < 2; ++b)
#pragma unroll
                for (int m = 0; m < 4; ++m)
#pragma unroll
                    for (int n = 0; n < 2; ++n) acc[a][b][m][n] = (f32x4){0.f, 0.f, 0.f, 0.f};
        cur = nxt; cA = nA; cB = nB; ++ui;
    }
    PG8_WAIT_V(0);
    if (wr == 0) PG8_BAR;
    PG8_BAR;
#undef PG8_PART_DMA
#undef PG8_SA
#undef PG8_SB
#undef PG8_STAGE
#undef PG8_LDA
#undef PG8_LDB
#undef PG8_MMA
#undef PG8_WAIT_V
#undef PG8_WAIT_L
#undef PG8_BAR
#undef PG8_SCHED
}
}
using pg8::Unit;

__device__ __forceinline__ void rows_rstd(const float* part, int row0, int np, int fq, float (&rs)[8]) {
#pragma unroll
    for (int hf = 0; hf < 2; ++hf) {
        f32x4 pa[4], pb[4];
#pragma unroll
        for (int g4 = 0; g4 < 4; ++g4) {
            const float* p = part + (size_t)(row0 + hf * 128 + g4 * 16) * 32;
            if (np == 16) { pa[g4] = *(const f32x4*)(p + 4 * fq); pb[g4] = (f32x4){0.f, 0.f, 0.f, 0.f}; }
            else { pa[g4] = *(const f32x4*)(p + 8 * fq); pb[g4] = *(const f32x4*)(p + 8 * fq + 4); }
        }
#pragma unroll
        for (int g4 = 0; g4 < 4; ++g4) {
            float sm = ((pa[g4][0] + pa[g4][1]) + (pa[g4][2] + pa[g4][3])) + ((pb[g4][0] + pb[g4][1]) + (pb[g4][2] + pb[g4][3]));
            sm += shx(sm, 16); sm += shx(sm, 32);
            rs[hf * 4 + g4] = __builtin_amdgcn_rsqf(sm * (1.0f / 1024.0f) + NORM_EPS);
        }
        if (np != 16) asm volatile("" ::: "memory");
    }
}

__device__ __forceinline__ void rows_rstd_lds(const LAS unsigned char* lp, int rl0, int fq, float (&rs)[8]) {
    f32x4 pa[8];
#pragma unroll
    for (int g = 0; g < 8; ++g) pa[g] = *(const LAS f32x4*)(lp + (rl0 + (g >> 2) * 128 + (g & 3) * 16) * 64 + fq * 16);
#pragma unroll
    for (int g = 0; g < 8; ++g) {
        float sm = (pa[g][0] + pa[g][1]) + (pa[g][2] + pa[g][3]);
        sm += shx(sm, 16); sm += shx(sm, 32);
        rs[g] = __builtin_amdgcn_rsqf(sm * (1.0f / 1024.0f) + NORM_EPS);
    }
}

struct EpiBf16S {
    static constexpr bool PERM = true, LDSPART = true;
    bf16_t* O; int ldc; const float* part; int np; float cscale;
    __device__ __forceinline__ bool lds_part() const { return part != nullptr && np == 16; }
    __device__ __forceinline__ void operator()(const f32x4 (&acc)[2][2][4][2], const Unit& u, int wr, int wc, int fr, int fq, const LAS unsigned char* lp) const {
        { const int ln_ = opaque_tid() & 63; fr = ln_ & 15; fq = ln_ >> 4; }
        const int row0 = u.pm * 256 + wr * 64 + fr, col0 = u.pn * 256 + wc * 32 + 8 * fq;
        float rs[8];
        if (lp) rows_rstd_lds(lp, wr * 64 + fr, fq, rs);
        else if (part) rows_rstd(part, row0, np, fq, rs);
        else {
#pragma unroll
            for (int g = 0; g < 8; ++g) rs[g] = 1.0f; }
#pragma unroll
        for (int ai = 0; ai < 2; ++ai)
#pragma unroll
            for (int m = 0; m < 4; ++m) {
                const int row = row0 + ai * 128 + m * 16;
                const float sc = cscale * rs[ai * 4 + m];
                bf16_t* rowp = O + (size_t)row * ldc + col0;
#pragma unroll
                for (int bj = 0; bj < 2; ++bj) { const f32x4 v0 = acc[ai][bj][m][0] * sc, v1 = acc[ai][bj][m][1] * sc;
                    u32x4 w; w.x = cvt_pk_bf16(v0[0], v0[1]); w.y = cvt_pk_bf16(v0[2], v0[3]); w.z = cvt_pk_bf16(v1[0], v1[1]); w.w = cvt_pk_bf16(v1[2], v1[3]);
                    *(u32x4*)(rowp + bj * 128) = w; }
            }
    }
};
struct EpiSwiglu {
    static constexpr bool PERM = true, LDSPART = true;
    bf16_t* H; const float* part; int np;
    __device__ __forceinline__ bool lds_part() const { return np == 16; }
    __device__ __forceinline__ void operator()(const f32x4 (&acc)[2][2][4][2], const Unit& u, int wr, int wc, int fr, int fq, const LAS unsigned char* lp) const {
        { const int ln_ = opaque_tid() & 63; fr = ln_ & 15; fq = ln_ >> 4; }
        const int row0 = u.pm * 256 + wr * 64 + fr, col0 = u.pn * 128 + wc * 32 + 8 * fq;
        float rsv[8]; if (lp) rows_rstd_lds(lp, wr * 64 + fr, fq, rsv); else rows_rstd(part, row0, np, fq, rsv);
#pragma unroll
        for (int ai = 0; ai < 2; ++ai)
#pragma unroll
            for (int m = 0; m < 4; ++m) {
                const int row = row0 + ai * 128 + m * 16;
                const float rs = rsv[ai * 4 + m], c1 = -1.44269504089f * rs, r2 = rs * rs;
                float o[8];
#pragma unroll
                for (int n = 0; n < 2; ++n) {
                    const f32x4 gv = acc[ai][0][m][n], uv = acc[ai][1][m][n];
                    const f32x4 ev = gv * c1, tv = (gv * uv) * r2;
#pragma unroll
                    for (int j = 0; j < 4; ++j) o[n * 4 + j] = tv[j] * __builtin_amdgcn_rcpf(1.0f + __builtin_amdgcn_exp2f(ev[j]));
                }
                u32x4 w; w.x = cvt_pk_bf16(o[0], o[1]); w.y = cvt_pk_bf16(o[2], o[3]); w.z = cvt_pk_bf16(o[4], o[5]); w.w = cvt_pk_bf16(o[6], o[7]);
                *(u32x4*)(H + (size_t)row * DFF + col0) = w;
            }
    }
};
struct EpiConvIn {
    static constexpr bool PERM = true, LDSPART = true;
    bf16_t* U; bf16_t* Bg; const float* part; int np;
    __device__ __forceinline__ bool lds_part() const { return np == 16; }
    __device__ __forceinline__ void operator()(const f32x4 (&acc)[2][2][4][2], const Unit& u, int wr, int wc, int fr, int fq, const LAS unsigned char* lp) const {
        { const int ln_ = opaque_tid() & 63; fr = ln_ & 15; fq = ln_ >> 4; }
        const int row0 = u.pm * 256 + wr * 64 + fr;
        float rsv[8]; if (lp) rows_rstd_lds(lp, wr * 64 + fr, fq, rsv); else rows_rstd(part, row0, np, fq, rsv);
#pragma unroll
        for (int ai = 0; ai < 2; ++ai)
#pragma unroll
            for (int m = 0; m < 4; ++m) {
                const int row = row0 + ai * 128 + m * 16;
                const float rs = rsv[ai * 4 + m];
                if (u.pn < 8) {
                    const float r2 = rs * rs; float o[8];
#pragma unroll
                    for (int n = 0; n < 2; ++n)
#pragma unroll
                        for (int j = 0; j < 4; ++j) o[n * 4 + j] = acc[ai][0][m][n][j] * acc[ai][1][m][n][j] * r2;
                    u32x4 w; w.x = cvt_pk_bf16(o[0], o[1]); w.y = cvt_pk_bf16(o[2], o[3]); w.z = cvt_pk_bf16(o[4], o[5]); w.w = cvt_pk_bf16(o[6], o[7]);
                    *(u32x4*)(U + (size_t)row * DM + u.pn * 128 + wc * 32 + 8 * fq) = w;
                } else {
#pragma unroll
                    for (int bj = 0; bj < 2; ++bj) { const f32x4 v0 = acc[ai][bj][m][0] * rs, v1 = acc[ai][bj][m][1] * rs;
                        u32x4 w; w.x = cvt_pk_bf16(v0[0], v0[1]); w.y = cvt_pk_bf16(v0[2], v0[3]); w.z = cvt_pk_bf16(v1[0], v1[1]); w.w = cvt_pk_bf16(v1[2], v1[3]);
                        *(u32x4*)(Bg + (size_t)row * DM + (u.pn - 8) * 256 + bj * 128 + wc * 32 + 8 * fq) = w; }
                }
            }
    }
};
struct EpiResid {
    static constexpr bool PERM = true, LDSPART = false;
    __device__ __forceinline__ bool lds_part() const { return false; }
    const float* xin; bf16_t* xb; float* part; float scale;
    __device__ __forceinline__ void operator()(const f32x4 (&acc)[2][2][4][2], const Unit& u, int wr, int wc, int fr, int fq, const LAS unsigned char* lp) const {
        { const int ln_ = opaque_tid() & 63; fr = ln_ & 15; fq = ln_ >> 4; }
        const int row0 = u.pm * 256 + wr * 64 + fr, col0 = u.pn * 256 + wc * 32 + 8 * fq;
        if (xin == nullptr) {
            u32x4 rb[8][2];
#pragma unroll
            for (int g = 0; g < 8; ++g)
#pragma unroll
                for (int bj = 0; bj < 2; ++bj) rb[g][bj] = *(const u32x4*)((const char*)xb + (unsigned)((row0 + (g >> 2) * 128 + (g & 3) * 16) * DM + col0 + bj * 128) * 2u);
#pragma unroll
            for (int ai = 0; ai < 2; ++ai) {
#pragma unroll
                for (int m = 0; m < 4; ++m) {
                    const int row = row0 + ai * 128 + m * 16; float ss = 0.f;
#pragma unroll
                    for (int bj = 0; bj < 2; ++bj) {
                        const u32x4 b4 = rb[ai * 4 + m][bj];
                        f32x4 v0, v1; v0[0] = bf_lo(b4.x); v0[1] = bf_hi(b4.x); v0[2] = bf_lo(b4.y); v0[3] = bf_hi(b4.y); v1[0] = bf_lo(b4.z); v1[1] = bf_hi(b4.z); v1[2] = bf_lo(b4.w); v1[3] = bf_hi(b4.w);
                        v0 = v0 + acc[ai][bj][m][0] * scale; v1 = v1 + acc[ai][bj][m][1] * scale;
                        u32x4 w; w.x = cvt_pk_bf16(v0[0], v0[1]); w.y = cvt_pk_bf16(v0[2], v0[3]); w.z = cvt_pk_bf16(v1[0], v1[1]); w.w = cvt_pk_bf16(v1[2], v1[3]);
                        *(u32x4*)((char*)xb + (unsigned)(row * DM + col0 + bj * 128) * 2u) = w;
                        ss += ((v0[0] * v0[0] + v0[1] * v0[1]) + (v0[2] * v0[2] + v0[3] * v0[3])) + ((v1[0] * v1[0] + v1[1] * v1[1]) + (v1[2] * v1[2] + v1[3] * v1[3]));
                    }
                    ss += shx(ss, 16); ss += shx(ss, 32);
                    if (fq == 0) part[(size_t)row * 32 + u.pn * 4 + wc] = ss;
                }
                asm volatile("" ::: "memory");
            }
        } else {
#pragma unroll
            for (int gp = 0; gp < 4; ++gp) {
                const int ai = gp >> 1;
                f32x4 rb[2][4];
#pragma unroll
                for (int mm = 0; mm < 2; ++mm)
#pragma unroll
                    for (int q = 0; q < 4; ++q) rb[mm][q] = *(const f32x4*)(xin + (size_t)(row0 + ai * 128 + ((gp & 1) * 2 + mm) * 16) * DM + col0 + (q >> 1) * 128 + (q & 1) * 4);
#pragma unroll
                for (int mm = 0; mm < 2; ++mm) {
                    const int m = (gp & 1) * 2 + mm, row = row0 + ai * 128 + m * 16; float ss = 0.f;
#pragma unroll
                    for (int bj = 0; bj < 2; ++bj) {
                        const f32x4 v0 = rb[mm][bj * 2 + 0] + acc[ai][bj][m][0] * scale, v1 = rb[mm][bj * 2 + 1] + acc[ai][bj][m][1] * scale;
                        u32x4 w; w.x = cvt_pk_bf16(v0[0], v0[1]); w.y = cvt_pk_bf16(v0[2], v0[3]); w.z = cvt_pk_bf16(v1[0], v1[1]); w.w = cvt_pk_bf16(v1[2], v1[3]);
                        *(u32x4*)((char*)xb + (unsigned)(row * DM + col0 + bj * 128) * 2u) = w;
                        ss += ((v0[0] * v0[0] + v0[1] * v0[1]) + (v0[2] * v0[2] + v0[3] * v0[3])) + ((v1[0] * v1[0] + v1[1] * v1[1]) + (v1[2] * v1[2] + v1[3] * v1[3]));
                    }
                    ss += shx(ss, 16); ss += shx(ss, 32);
                    if (fq == 0) part[(size_t)row * 32 + u.pn * 4 + wc] = ss;
                }
                asm volatile("" ::: "memory");
            }
        }
    }
};
struct EpiGlu {
    static constexpr bool PERM = true, LDSPART = false;
    __device__ __forceinline__ bool lds_part() const { return false; }
    bf16_t* xb; float* part;
    __device__ __forceinline__ void operator()(const f32x4 (&acc)[2][2][4][2], const Unit& u, int wr, int wc, int fr, int fq, const LAS unsigned char* lp) const {
        { const int ln_ = opaque_tid() & 63; fr = ln_ & 15; fq = ln_ >> 4; }
        const int row0 = u.pm * 256 + wr * 64 + fr, col0 = u.pn * 128 + wc * 32 + 8 * fq;
#pragma unroll
        for (int ai = 0; ai < 2; ++ai) {
            u32x4 rb[4];
#pragma unroll
            for (int m = 0; m < 4; ++m) rb[m] = *(const u32x4*)((const char*)xb + (unsigned)((row0 + ai * 128 + m * 16) * DM + col0) * 2u);
#pragma unroll
            for (int m = 0; m < 4; ++m) {
                const int row = row0 + ai * 128 + m * 16;
                const u32x4 b4 = rb[m];
                f32x4 v0, v1; v0[0] = bf_lo(b4.x); v0[1] = bf_hi(b4.x); v0[2] = bf_lo(b4.y); v0[3] = bf_hi(b4.y); v1[0] = bf_lo(b4.z); v1[1] = bf_hi(b4.z); v1[2] = bf_lo(b4.w); v1[3] = bf_hi(b4.w);
#pragma unroll
                for (int j = 0; j < 4; ++j) { v0[j] += acc[ai][0][m][0][j] * fast_sigmoid(acc[ai][1][m][0][j]); v1[j] += acc[ai][0][m][1][j] * fast_sigmoid(acc[ai][1][m][1][j]); }
                u32x4 w; w.x = cvt_pk_bf16(v0[0], v0[1]); w.y = cvt_pk_bf16(v0[2], v0[3]); w.z = cvt_pk_bf16(v1[0], v1[1]); w.w = cvt_pk_bf16(v1[2], v1[3]);
                *(u32x4*)((char*)xb + (unsigned)(row * DM + col0) * 2u) = w;
                float ss = ((v0[0] * v0[0] + v0[1] * v0[1]) + (v0[2] * v0[2] + v0[3] * v0[3])) + ((v1[0] * v1[0] + v1[1] * v1[1]) + (v1[2] * v1[2] + v1[3] * v1[3]));
                ss += shx(ss, 16); ss += shx(ss, 32);
                if (fq == 0) part[(size_t)row * 32 + u.pn * 4 + wc] = ss;
            }
            asm volatile("" ::: "memory");
        }
    }
};

__device__ __forceinline__ int srccol(int kind, int n0) {
    if (kind == 0) return n0;
    const int pn = n0 >> 8, r = n0 & 255, bj = r >> 7, rr = r & 127;
    if (kind == 1) return bj * DFF + 128 * pn + rr;
    if (kind == 2) return n0 < 2048 ? (bj ? 2048 : 0) + 128 * pn + rr : 1024 + (n0 - 2048);
    return bj * 1024 + 128 * pn + rr;
}
__device__ void transpose_job(LAS float* tile, const float* W, int Nsrc, int K, bf16_t* dst, int Ndst, int kind, const float* gain) {
    const int tid = opaque_tid();
    const int tilesK = K >> 7, ntile = tilesK * (Ndst >> 7);
    for (int t = blockIdx.x; t < ntile; t += gridDim.x) {
        const int tn = t / tilesK, tk = t - tn * tilesK, n0 = tn * 128, k0 = tk * 128;
        const int sc = srccol(kind, n0);
        const int c4 = (tid & 31) * 4, kr = tid >> 5;
        f32x4 v[8];
#pragma unroll
        for (int i = 0; i < 8; ++i) v[i] = *(const f32x4*)(W + (size_t)(k0 + kr + 16 * i) * Nsrc + sc + c4);
#pragma unroll
        for (int i = 0; i < 8; ++i) {
            const int k = kr + 16 * i; const float gk = gain ? gain[k0 + k] : 1.0f;
            tile[k * 129 + c4 + 0] = v[i][0] * gk; tile[k * 129 + c4 + 1] = v[i][1] * gk; tile[k * 129 + c4 + 2] = v[i][2] * gk; tile[k * 129 + c4 + 3] = v[i][3] * gk;
        }
        __syncthreads();
#pragma unroll
        for (int i = 0; i < 4; ++i) {
            const int q = tid + NTHREADS * i, n = q >> 4, kc = (q & 15) * 8;
            float f[8];
#pragma unroll
            for (int e = 0; e < 8; ++e) f[e] = tile[(kc + e) * 129 + n];
            u32x4 w; w.x = cvt_pk_bf16(f[0], f[1]); w.y = cvt_pk_bf16(f[2], f[3]); w.z = cvt_pk_bf16(f[4], f[5]); w.w = cvt_pk_bf16(f[6], f[7]);
            *(u32x4*)(dst + (size_t)(n0 + n) * K + k0 + kc) = w;
        }
        __syncthreads();
    }
}

struct Args { const float* in[23]; float* out; unsigned char* ws; };
typedef const __attribute__((address_space(4))) Args* CArgs;
__device__ __forceinline__ CArgs get_args() { CArgs p = (CArgs)__builtin_amdgcn_kernarg_segment_ptr(); asm volatile("" : "+s"(p)); return p; }

__device__ __forceinline__ void sincos_d(double th, double& s, double& c) {
    const double twopi = 6.283185307179586476925;
    const double k = rint(th / twopi); const double r = th - k * twopi;
    const double q = r * 0.125, q2 = q * q;
    double sq = q * (1.0 + q2 * (-1.0 / 6.0 + q2 * (1.0 / 120.0 + q2 * (-1.0 / 5040.0 + q2 * (1.0 / 362880.0 + q2 * (-1.0 / 39916800.0 + q2 * (1.0 / 6227020800.0)))))));
    double cq = 1.0 + q2 * (-0.5 + q2 * (1.0 / 24.0 + q2 * (-1.0 / 720.0 + q2 * (1.0 / 40320.0 + q2 * (-1.0 / 3628800.0 + q2 * (1.0 / 479001600.0 + q2 * (-1.0 / 87178291200.0)))))));
#pragma unroll
    for (int i = 0; i < 3; ++i) { const double s2 = 2.0 * sq * cq, c2 = cq * cq - sq * sq; sq = s2; cq = c2; }
    s = sq; c = cq;
}
__device__ __forceinline__ double exp_d(double x) {
    const double ln2 = 0.693147180559945309417;
    const double k = rint(x / ln2); const double r = x - k * ln2;
    double p = 1.0 + r * (1.0 + r * (0.5 + r * (1.0 / 6.0 + r * (1.0 / 24.0 + r * (1.0 / 120.0 + r * (1.0 / 720.0 + r * (1.0 / 5040.0 + r * (1.0 / 40320.0 + r * (1.0 / 362880.0 + r * (1.0 / 3628800.0 + r * (1.0 / 39916800.0 + r * (1.0 / 479001600.0))))))))))));
    return ldexp(p, (int)k);
}

__device__ __forceinline__ void ssm_disc(CArgs a, int j, int g, int p, double& abr, double& abi, double& cfr, double& cfi) {
    const size_t gp = ((size_t)j * 64 + g) * 64 + p;
    const double lre = fmin((double)a->in[11][gp], -1e-4), lim = (double)a->in[12][gp];
    const double dt = exp_d((double)a->in[13][j * 64 + g]);
    const double mag = exp_d(lre * dt); double sn, cs; sincos_d(lim * dt, sn, cs);
    abr = mag * cs; abi = mag * sn;
    const double den = lre * lre + lim * lim, nre = abr - 1.0, nim = abi;
    cfr = (nre * lre + nim * lim) / den; cfi = (nim * lre - nre * lim) / den;
}
__device__ void prep_phase(LAS unsigned char* lds) {
    LAS float* tile = (LAS float*)lds;
    CArgs ap = get_args();
    unsigned char* ws = ap->ws;
    const float* norm_g = ap->in[2];
    for (int l = 0; l < NLAYER; ++l) {
        const float* g = norm_g + (size_t)l * 5 * DM;
        transpose_job(tile, ap->in[4] + (size_t)l * DM * 2 * DFF, 2 * DFF, DM, (bf16_t*)(ws + WS_UP1 + l * SZ_UP), 2 * DFF, 1, g + 0 * DM);
        transpose_job(tile, ap->in[5] + (size_t)l * DFF * DM, DM, DFF, (bf16_t*)(ws + WS_DN1 + l * SZ_DN), DM, 0, nullptr);
        transpose_job(tile, ap->in[6] + (size_t)l * DM * 2 * DFF, 2 * DFF, DM, (bf16_t*)(ws + WS_UP2 + l * SZ_UP), 2 * DFF, 1, g + 4 * DM);
        transpose_job(tile, ap->in[7] + (size_t)l * DFF * DM, DM, DFF, (bf16_t*)(ws + WS_DN2 + l * SZ_DN), DM, 0, nullptr);
        transpose_job(tile, ap->in[20] + (size_t)l * DM * DM, DM, DM, (bf16_t*)(ws + WS_Q + l * SZ_SQ), DM, 0, g + 2 * DM);
        transpose_job(tile, ap->in[21] + (size_t)l * DM * 2 * DM, 2 * DM, DM, (bf16_t*)(ws + WS_K + l * SZ_SQ), DM, 0, g + 3 * DM);
        transpose_job(tile, ap->in[21] + (size_t)l * DM * 2 * DM + DM, 2 * DM, DM, (bf16_t*)(ws + WS_VT + l * SZ_SQ), DM, 0, g + 3 * DM);
        transpose_job(tile, ap->in[22] + (size_t)l * DM * DM, DM, DM, (bf16_t*)(ws + WS_O + l * SZ_SQ), DM, 0, nullptr);
        if ((l & 1) == 0) {
            const int j = l >> 1;
            transpose_job(tile, ap->in[8] + (size_t)j * DM * 3 * DM, 3 * DM, DM, (bf16_t*)(ws + WS_CIN + j * 3 * SZ_SQ), 3 * DM, 2, g + 1 * DM);
            transpose_job(tile, ap->in[10] + (size_t)j * DM * DM, DM, DM, (bf16_t*)(ws + WS_COUT + j * SZ_SQ), DM, 0, nullptr);
        } else {
            const int j = l >> 1;
            transpose_job(tile, ap->in[19] + (size_t)j * DM * 2 * DM, 2 * DM, DM, (bf16_t*)(ws + WS_GLU + j * 2 * SZ_SQ), 2 * DM, 3, nullptr);
        }
    }
    const int tid0 = opaque_tid(), lane = tid0 & 63, gw = blockIdx.x * 8 + (tid0 >> 6), nw = gridDim.x * 8;
    const float* x = ap->in[0]; bf16_t* xb = (bf16_t*)(ws + WS_XB); float* part = (float*)(ws + WS_PART);
    for (int row = gw; row < T_TOK; row += 2 * nw) {
        f32x4 v[2][4];
#pragma unroll
        for (int rr = 0; rr < 2; ++rr)
#pragma unroll
            for (int i = 0; i < 4; ++i) v[rr][i] = *(const f32x4*)(x + (size_t)(row + rr * nw) * DM + i * 256 + lane * 4);
#pragma unroll
        for (int rr = 0; rr < 2; ++rr) {
            float ss = 0.f;
#pragma unroll
            for (int i = 0; i < 4; ++i) {
                const f32x4 t = v[rr][i];
                u32x2 w; w.x = cvt_pk_bf16(t[0], t[1]); w.y = cvt_pk_bf16(t[2], t[3]);
                *(u32x2*)(xb + (size_t)(row + rr * nw) * DM + i * 256 + lane * 4) = w;
                ss += (t[0] * t[0] + t[1] * t[1]) + (t[2] * t[2] + t[3] * t[3]);
            }
#pragma unroll
            for (int o = 32; o >= 1; o >>= 1) ss += shx(ss, o);
            if (lane < 16) part[(size_t)(row + rr * nw) * 32 + lane] = lane == 0 ? ss : 0.f;
        }
    }
    const float* mem = ap->in[1]; bf16_t* memb = (bf16_t*)(ws + WS_MEMB);
    for (int row = gw; row < NB * MEML; row += nw) {
        f32x4 v[4]; float ss = 0.f;
#pragma unroll
        for (int i = 0; i < 4; ++i) { v[i] = *(const f32x4*)(mem + (size_t)row * DM + i * 256 + lane * 4); ss += (v[i][0] * v[i][0] + v[i][1] * v[i][1]) + (v[i][2] * v[i][2] + v[i][3] * v[i][3]); }
#pragma unroll
        for (int o = 32; o >= 1; o >>= 1) ss += shx(ss, o);
        const float rs = __builtin_amdgcn_rsqf(ss * (1.0f / 1024.0f) + NORM_EPS);
#pragma unroll
        for (int i = 0; i < 4; ++i) { u32x2 w; w.x = cvt_pk_bf16(v[i][0] * rs, v[i][1] * rs); w.y = cvt_pk_bf16(v[i][2] * rs, v[i][3] * rs);
            *(u32x2*)(memb + (size_t)row * DM + i * 256 + lane * 4) = w; }
    }
    float* disc = (float*)(ws + WS_DISC);
    for (int idx = blockIdx.x * NTHREADS + tid0; idx < 2 * 64 * 64; idx += gridDim.x * NTHREADS) {
        double abr, abi, cfr, cfi; ssm_disc(ap, idx >> 12, (idx >> 6) & 63, idx & 63, abr, abi, cfr, cfi);
        double pr = abr, pi = abi;
#pragma unroll
        for (int q = 0; q < 4; ++q) { const double nr = pr * pr - pi * pi, ni = 2.0 * pr * pi; pr = nr; pi = ni; }
        f32x4 v0, v1; v0[0] = (float)abr; v0[1] = (float)abi; v0[2] = (float)cfr; v0[3] = (float)cfi; v1[0] = (float)pr; v1[1] = (float)pi; v1[2] = 0.f; v1[3] = 0.f;
        *(f32x4*)(disc + (size_t)idx * 8) = v0; *(f32x4*)(disc + (size_t)idx * 8 + 4) = v1;
    }
}

__device__ void conv_phase(const bf16_t* U, bf16_t* Bg, const float* cw) {
    const size_t total = (size_t)T_TOK * 128;
    for (size_t idx = (size_t)blockIdx.x * NTHREADS + opaque_tid(); idx < total; idx += (size_t)gridDim.x * NTHREADS) {
        const int t = (int)(idx >> 7), c8 = (int)(idx & 127) * 8, pos = t & (SEQ - 1);
        const size_t off = (size_t)t * DM + c8;
        const u32x4 u0 = *(const u32x4*)(U + off);
        u32x4 u1 = (u32x4){0u, 0u, 0u, 0u}, u2 = (u32x4){0u, 0u, 0u, 0u};
        if (pos >= 1) u1 = *(const u32x4*)(U + off - DM);
        if (pos >= 2) u2 = *(const u32x4*)(U + off - 2 * DM);
        const u32x4 bb = *(const u32x4*)(Bg + off);
        float o[8];
#pragma unroll
        for (int i = 0; i < 4; ++i) {
            const int c = c8 + 2 * i;
            const float w0a = cw[c], w0b = cw[c + 1], w1a = cw[DM + c], w1b = cw[DM + c + 1], w2a = cw[2 * DM + c], w2b = cw[2 * DM + c + 1];
            o[2 * i] = bf_lo(bb[i]) * (w0a * bf_lo(u2[i]) + w1a * bf_lo(u1[i]) + w2a * bf_lo(u0[i]));
            o[2 * i + 1] = bf_hi(bb[i]) * (w0b * bf_hi(u2[i]) + w1b * bf_hi(u1[i]) + w2b * bf_hi(u0[i]));
        }
        u32x4 w; w.x = cvt_pk_bf16(o[0], o[1]); w.y = cvt_pk_bf16(o[2], o[3]); w.z = cvt_pk_bf16(o[4], o[5]); w.w = cvt_pk_bf16(o[6], o[7]);
        *(u32x4*)(Bg + off) = w;
    }
}

constexpr size_t SSM_PU_OFF = (size_t)64 * 2048 * 384 * 2;
constexpr size_t SSM_MQ_OFF = SSM_PU_OFF + (size_t)64 * 2048 * 128 * 4;
constexpr size_t SSM_P_OFF = SSM_MQ_OFF + (size_t)64 * 256 * 384 * 2;
static_assert(SSM_P_OFF + (size_t)64 * 128 * 256 * 2 <= (size_t)T_TOK * DFF * 2, "ssm scratch must fit the hidden buffer");

__device__ void ssm_uprep_phase(const bf16_t* xb, const float* part, const float* gain, bf16_t* U2) {
    const int tid = opaque_tid(), lane = tid & 63, gw = blockIdx.x * 8 + (tid >> 6), nw = gridDim.x * 8;
    const int s = lane & 15, gq = lane >> 4;
    for (int item0 = gw; item0 < 32768; item0 += 2 * nw) {
        f32x4 pp[2][4]; u32x4 xa[2][2];
#pragma unroll
        for (int rr = 0; rr < 2; ++rr) {
            const int item = item0 + rr * nw, g = (item & 15) * 4 + gq, c = (item >> 4) & 127, b = item >> 11, row = b * SEQ + c * 16 + s;
#pragma unroll
            for (int q = 0; q < 4; ++q) pp[rr][q] = *(const f32x4*)(part + (size_t)row * 32 + 4 * q);
            xa[rr][0] = *(const u32x4*)(xb + (size_t)row * DM + g * 16); xa[rr][1] = *(const u32x4*)(xb + (size_t)row * DM + g * 16 + 8);
        }
#pragma unroll
        for (int rr = 0; rr < 2; ++rr) {
            const int item = item0 + rr * nw, g = (item & 15) * 4 + gq, c = (item >> 4) & 127, b = item >> 11;
            float ssq = 0.f;
#pragma unroll
            for (int q = 0; q < 4; ++q) ssq += (pp[rr][q][0] + pp[rr][q][1]) + (pp[rr][q][2] + pp[rr][q][3]);
            const float rs = __builtin_amdgcn_rsqf(ssq * (1.0f / 1024.0f) + NORM_EPS);
            const unsigned xw[8] = {xa[rr][0].x, xa[rr][0].y, xa[rr][0].z, xa[rr][0].w, xa[rr][1].x, xa[rr][1].y, xa[rr][1].z, xa[rr][1].w};
            unsigned w[8];
#pragma unroll
            for (int q4 = 0; q4 < 4; ++q4) {
                const f32x4 gv = *(const f32x4*)(gain + g * 16 + q4 * 4);
                w[q4 * 2] = cvt_pk_bf16(bf_lo(xw[q4 * 2]) * rs * gv[0], bf_hi(xw[q4 * 2]) * rs * gv[1]); w[q4 * 2 + 1] = cvt_pk_bf16(bf_lo(xw[q4 * 2 + 1]) * rs * gv[2], bf_hi(xw[q4 * 2 + 1]) * rs * gv[3]);
            }
            bf16_t* dst = U2 + ((size_t)g * 2048 + b * 128 + c) * 384 + 16 * s;
            *(u32x4*)dst = (u32x4){w[0], w[1], w[2], w[3]}; *(u32x4*)(dst + 8) = (u32x4){w[4], w[5], w[6], w[7]};
        }
    }
}

__device__ void ssm_build_phase(int j, bf16_t* MQ, bf16_t* P, LAS unsigned char* lds) {
    CArgs a = get_args();
    LAS float* ApR = (LAS float*)lds; LAS float* ApI = ApR + 17 * 64;
    LAS float* BbR = ApI + 17 * 64; LAS float* BbI = BbR + 1024;
    LAS float* CR = BbI + 1024; LAS float* CI = CR + 1024; LAS float* Kt = CI + 1024;
    const int tid = opaque_tid();
    for (int item = blockIdx.x; item < 256; item += gridDim.x) {
        const int g = item >> 2, q4 = item & 3;
        if (tid < 64) {
            const int p = tid; const f32x4 dv = *(const f32x4*)((const float*)(a->ws + WS_DISC) + (((size_t)j * 64 + g) * 64 + p) * 8);
            const float abr = dv[0], abi = dv[1], cfr = dv[2], cfi = dv[3];
            float pr = 1.0f, pi = 0.0f;
            for (int n = 0; n <= 16; ++n) { ApR[n * 64 + p] = pr; ApI[n * 64 + p] = pi; const float nr = pr * abr - pi * abi, ni = pr * abi + pi * abr; pr = nr; pi = ni; }
            const size_t gp = ((size_t)j * 64 + g) * 64 + p;
            for (int h = 0; h < 16; ++h) { const float br = a->in[14][gp * 16 + h], bi = a->in[15][gp * 16 + h]; BbR[p * 16 + h] = cfr * br - cfi * bi; BbI[p * 16 + h] = cfr * bi + cfi * br; }
        }
        for (int i = tid; i < 1024; i += NTHREADS) { const size_t ci = ((size_t)j * 64 + g) * 1024 + i; CR[i] = a->in[16][ci]; CI[i] = a->in[17][ci]; }
        __syncthreads();
        for (int e = tid; e < 1024; e += NTHREADS) {
            const int tau = e >> 6, h = 4 * q4 + ((e >> 4) & 3), hp = e & 15; float acc = 0.f;
            for (int p = 0; p < 64; ++p) { const float cr = CR[h * 64 + p], ci = CI[h * 64 + p], ar = ApR[tau * 64 + p], ai = ApI[tau * 64 + p], br = BbR[p * 16 + hp], bi = BbI[p * 16 + hp];
                acc += (cr * ar - ci * ai) * br - (cr * ai + ci * ar) * bi; }
            Kt[e] = acc;
        }
        __syncthreads();
        bf16_t* mq = MQ + (size_t)g * 256 * 384;
        for (int e = tid; e < 64 * 192; e += NTHREADS) {
            const int rl = e / 192, k = (e - rl * 192) * 2, t = rl >> 2, hl = rl & 3, h = 4 * q4 + hl, n = t * 16 + h; float v[2];
#pragma unroll
            for (int q = 0; q < 2; ++q) { const int kk = k + q;
                if (kk < 256) { const int sidx = kk >> 4, hp = kk & 15; v[q] = (sidx <= t) ? Kt[(t - sidx) * 64 + hl * 16 + hp] : 0.f; }
                else if (kk < 320) { const int p = kk - 256; v[q] = CR[h * 64 + p] * ApR[(t + 1) * 64 + p] - CI[h * 64 + p] * ApI[(t + 1) * 64 + p]; }
                else { const int p = kk - 320; v[q] = -(CR[h * 64 + p] * ApI[(t + 1) * 64 + p] + CI[h * 64 + p] * ApR[(t + 1) * 64 + p]); } }
            *(unsigned*)(mq + (size_t)n * 384 + k) = cvt_pk_bf16(v[0], v[1]);
        }
        bf16_t* pp = P + (size_t)g * 128 * 256;
        for (int e = tid; e < 32 * 128; e += NTHREADS) {
            const int rl = e >> 7, k = (e & 127) * 2, im = rl >> 4, p = 16 * q4 + (rl & 15), r = im * 64 + p, sidx = k >> 4; float v[2];
            const float ar = ApR[(15 - sidx) * 64 + p], ai = ApI[(15 - sidx) * 64 + p];
#pragma unroll
            for (int q = 0; q < 2; ++q) { const int hp = (k + q) & 15; const float br = BbR[p * 16 + hp], bi = BbI[p * 16 + hp]; v[q] = im ? (ar * bi + ai * br) : (ar * br - ai * bi); }
            *(unsigned*)(pp + (size_t)r * 256 + k) = cvt_pk_bf16(v[0], v[1]);
        }
        __syncthreads();
    }
}

__device__ void ssm_cscan_phase(int j, const float* PU, bf16_t* U2) {
    CArgs a = get_args();
    const int tid = opaque_tid(), wave = tid >> 6, lane = tid & 63;
    if (wave >= 4) return;
    for (int item = blockIdx.x * 4 + wave; item < NB * 64; item += gridDim.x * 4) {
        const int b = item >> 6, g = item & 63, p = lane;
        const f32x4 dv = *(const f32x4*)((const float*)(a->ws + WS_DISC) + (((size_t)j * 64 + g) * 64 + p) * 8 + 4);
        const float a16r = dv[0], a16i = dv[1];
        float sr = 0.f, si = 0.f;
        const float* pu = PU + ((size_t)g * 2048 + b * 128) * 128 + p;
        bf16_t* uo = U2 + ((size_t)g * 2048 + b * 128) * 384 + 256 + p;
        for (int c0 = 0; c0 < 128; c0 += 32) {
            float lr[32], li[32];
#pragma unroll
            for (int q = 0; q < 32; ++q) { lr[q] = pu[(size_t)(c0 + q) * 128]; li[q] = pu[(size_t)(c0 + q) * 128 + 64]; }
#pragma unroll
            for (int q = 0; q < 32; ++q) {
                uo[(size_t)(c0 + q) * 384] = (bf16_t)(cvt_pk_bf16(sr, 0.f) & 0xffffu); uo[(size_t)(c0 + q) * 384 + 64] = (bf16_t)(cvt_pk_bf16(si, 0.f) & 0xffffu);
                const float nr = a16r * sr - a16i * si + lr[q], ni = a16r * si + a16i * sr + li[q]; sr = nr; si = ni;
            }
        }
    }
}

struct EpiPU {
    static constexpr bool PERM = false, LDSPART = false;
    __device__ __forceinline__ bool lds_part() const { return false; }
    float* PU;
    __device__ __forceinline__ void operator()(const f32x4 (&acc)[2][2][4][2], const Unit& u, int wr, int wc, int fr, int fq, const LAS unsigned char* lp) const {
        { const int ln_ = opaque_tid() & 63; fr = ln_ & 15; fq = ln_ >> 4; }
        const int row0 = u.pm * 256 + wr * 64 + fr, col0 = wc * 32 + 4 * fq;
#pragma unroll
        for (int ai = 0; ai < 2; ++ai)
#pragma unroll
            for (int m = 0; m < 4; ++m)
#pragma unroll
                for (int n = 0; n < 2; ++n) *(f32x4*)(PU + (size_t)(row0 + ai * 128 + m * 16) * 128 + col0 + n * 16) = acc[ai][0][m][n];
    }
};
struct EpiY {
    static constexpr bool PERM = true, LDSPART = false;
    __device__ __forceinline__ bool lds_part() const { return false; }
    const bf16_t* U2; bf16_t* Z; const float* dsk;
    __device__ __forceinline__ void operator()(const f32x4 (&acc)[2][2][4][2], const Unit& u, int wr, int wc, int fr, int fq, const LAS unsigned char* lp) const {
        { const int ln_ = opaque_tid() & 63; fr = ln_ & 15; fq = ln_ >> 4; }
        const int g = u.pm >> 3, rg0 = (u.pm & 7) * 256 + wr * 64 + fr, h0 = 8 * (fq & 1), tq = 2 * wc + (fq >> 1);
        const f32x4 d0 = *(const f32x4*)(dsk + g * 16 + h0), d1 = *(const f32x4*)(dsk + g * 16 + h0 + 4);
#pragma unroll
        for (int gp = 0; gp < 4; ++gp) {
            const int ai = gp >> 1;
            u32x4 uw[2][2];
#pragma unroll
            for (int mm = 0; mm < 2; ++mm)
#pragma unroll
                for (int bj = 0; bj < 2; ++bj) uw[mm][bj] = *(const u32x4*)(U2 + ((size_t)g * 2048 + rg0 + ai * 128 + ((gp & 1) * 2 + mm) * 16) * 384 + 16 * (8 * bj + tq) + h0);
#pragma unroll
            for (int mm = 0; mm < 2; ++mm) {
                const int m = (gp & 1) * 2 + mm;
                const int rg = rg0 + ai * 128 + m * 16, b = rg >> 7, cc = rg & 127;
                bf16_t* zrow = Z + (size_t)(b * SEQ + 16 * cc) * DM + g * 16 + h0;
#pragma unroll
                for (int bj = 0; bj < 2; ++bj) {
                    const u32x4 uv = uw[mm][bj];
                    const f32x4 y0 = acc[ai][bj][m][0], y1 = acc[ai][bj][m][1];
                    u32x4 w;
                    w.x = cvt_pk_bf16(gelu_tanh(y0[0] + d0[0] * bf_lo(uv.x)), gelu_tanh(y0[1] + d0[1] * bf_hi(uv.x)));
                    w.y = cvt_pk_bf16(gelu_tanh(y0[2] + d0[2] * bf_lo(uv.y)), gelu_tanh(y0[3] + d0[3] * bf_hi(uv.y)));
                    w.z = cvt_pk_bf16(gelu_tanh(y1[0] + d1[0] * bf_lo(uv.z)), gelu_tanh(y1[1] + d1[1] * bf_hi(uv.z)));
                    w.w = cvt_pk_bf16(gelu_tanh(y1[2] + d1[2] * bf_lo(uv.w)), gelu_tanh(y1[3] + d1[3] * bf_hi(uv.w)));
                    *(u32x4*)(zrow + (size_t)(8 * bj + tq) * DM) = w;
                }
            }
            asm volatile("" ::: "memory");
        }
    }
};

__device__ void attn_phase(const bf16_t* Q, const bf16_t* Kall, const bf16_t* VT, bf16_t* O, int layer, LAS unsigned char* lds) {
    const int tid0 = opaque_tid(), wave = __builtin_amdgcn_readfirstlane(tid0 >> 6);
    for (int unit = blockIdx.x; unit < NB * 4 * 8; unit += gridDim.x) {
        int lane = tid0 & 63; asm volatile("" : "+v"(lane));
        const int r = lane & 31, h = lane >> 5;
#define ATT_VOFF() int ln_ = tid0 & 63; asm volatile("" : "+v"(ln_)); const int rb = 2 * wave + (ln_ >> 5), cc0 = (ln_ & 31) ^ rb; \
        const unsigned voff_e = (unsigned)(rb * 4096 + cc0 * 8) * 2u, voff_o = (unsigned)(rb * 4096 + (cc0 ^ 16) * 8) * 2u
        const int b = unit >> 5, hd = (unit >> 3) & 3, qt = unit & 7;
        const int t0 = b * SEQ + qt * 256 + wave * 32;
        const bf16_t* qp = Q + (size_t)(t0 + r) * DM + hd * 256 + 8 * h;
        bf16x8 qf[16];
#pragma unroll
        for (int kk = 0; kk < 16; ++kk) qf[kk] = *(const bf16x8*)(qp + 16 * kk);
        __syncthreads();
        {
            ATT_VOFF();
            const char* kb = (const char*)(Kall + (size_t)(b * MEML) * 4096 + layer * 1024 + hd * 256);
#pragma unroll
            for (int it = 0; it < 16; ++it)
                __builtin_amdgcn_global_load_lds((const unsigned*)(kb + (size_t)it * 16 * 4096 * 2 + ((it & 1) ? voff_o : voff_e)), (LAS unsigned*)(lds + (it * 8 + wave) * 1024), 16, 0, 0);
        }
        asm volatile("s_waitcnt vmcnt(0)" ::: "memory");
        __syncthreads();
        bf16x8 pf[8][2]; float mh[4], mrun = -3.0e38f, drun = 0.f;
#pragma unroll
        for (int hf = 0; hf < 4; ++hf) {
            int r = lane & 31, h = lane >> 5; asm volatile("" : "+v"(r), "+v"(h));
            f32x16 s[2];
#pragma unroll
            for (int k4 = 0; k4 < 2; ++k4) {
                const int kt = hf * 2 + k4;
                f32x16 acc;
#pragma unroll
                for (int e = 0; e < 16; ++e) acc[e] = 0.f;
#pragma unroll
                for (int k8 = 0; k8 < 4; ++k8) {
                    bf16x8 af[4];
#pragma unroll
                    for (int i = 0; i < 4; ++i) af[i] = *(const LAS bf16x8*)(lds + (32 * kt + r) * 512 + (((2 * (4 * k8 + i) + h) ^ r) << 4));
                    __builtin_amdgcn_sched_group_barrier(0x100, 4, 0);
                    __builtin_amdgcn_sched_group_barrier(0x008, 4, 0);
#pragma unroll
                    for (int i = 0; i < 4; ++i) acc = __builtin_amdgcn_mfma_f32_32x32x16_bf16(af[i], qf[4 * k8 + i], acc, 0, 0, 0);
                }
                s[k4] = acc;
            }
            float mx = -3.0e38f;
#pragma unroll
            for (int k4 = 0; k4 < 2; ++k4)
#pragma unroll
                for (int e = 0; e < 16; ++e) mx = fmaxf(mx, s[k4][e]);
            mx = fmaxf(mx, shx(mx, 32));
            float sum = 0.f;
#pragma unroll
            for (int k4 = 0; k4 < 2; ++k4)
#pragma unroll
                for (int e = 0; e < 16; ++e) { const float pv = __builtin_amdgcn_exp2f(s[k4][e] - mx); s[k4][e] = pv; sum += pv; }
            sum += shx(sum, 32);
            { const float mnew = fmaxf(mrun, mx); drun = drun * __builtin_amdgcn_exp2f(mrun - mnew) + sum * __builtin_amdgcn_exp2f(mx - mnew); mrun = mnew; mh[hf] = mx; }
#pragma unroll
            for (int k4 = 0; k4 < 2; ++k4)
#pragma unroll
                for (int s2 = 0; s2 < 2; ++s2) {
                    u32x4 w;
                    w.x = cvt_pk_bf16(s[k4][8 * s2 + 0], s[k4][8 * s2 + 1]); w.y = cvt_pk_bf16(s[k4][8 * s2 + 2], s[k4][8 * s2 + 3]);
                    w.z = cvt_pk_bf16(s[k4][8 * s2 + 4], s[k4][8 * s2 + 5]); w.w = cvt_pk_bf16(s[k4][8 * s2 + 6], s[k4][8 * s2 + 7]);
                    pf[hf * 2 + k4][s2] = __builtin_bit_cast(bf16x8, w);
                }
        }
        asm volatile("s_waitcnt lgkmcnt(0)" ::: "memory");
        __syncthreads();
        {
            ATT_VOFF();
            const char* vb = (const char*)(VT + (size_t)(layer * 1024 + hd * 256) * 4096 + b * MEML);
#pragma unroll
            for (int it = 0; it < 16; ++it)
                __builtin_amdgcn_global_load_lds((const unsigned*)(vb + (size_t)it * 16 * 4096 * 2 + ((it & 1) ? voff_o : voff_e)), (LAS unsigned*)(lds + (it * 8 + wave) * 1024), 16, 0, 0);
        }
        float fq[4];
        const float inv = 1.0f / drun;
#pragma unroll
        for (int q = 0; q < 4; ++q) fq[q] = __builtin_amdgcn_exp2f(mh[q] - mrun) * inv;
        asm volatile("s_waitcnt vmcnt(0)" ::: "memory");
        __syncthreads();
        bf16_t* op = O + (size_t)(t0 + r) * DM + hd * 256 + 4 * h;
        int rv = lane & 31, hv = lane >> 5; asm volatile("" : "+v"(rv), "+v"(hv));
#pragma unroll
        for (int dt = 0; dt < 8; ++dt) {
            f32x16 ac[4];
#pragma unroll
            for (int q = 0; q < 4; ++q)
#pragma unroll
                for (int e = 0; e < 16; ++e) ac[q][e] = 0.f;
            const LAS unsigned char* rowp = lds + (32 * dt + rv) * 512 + 8 * hv;
#pragma unroll
            for (int kt = 0; kt < 8; ++kt) {
                u32x4 vf[2];
#pragma unroll
                for (int s2 = 0; s2 < 2; ++s2) {
                    const u32x2 lo = *(const LAS u32x2*)(rowp + (((4 * kt + 2 * s2) ^ rv) << 4)), hi = *(const LAS u32x2*)(rowp + (((4 * kt + 2 * s2 + 1) ^ rv) << 4));
                    vf[s2].x = lo.x; vf[s2].y = lo.y; vf[s2].z = hi.x; vf[s2].w = hi.y;
                }
                __builtin_amdgcn_sched_group_barrier(0x100, 4, 0);
                __builtin_amdgcn_sched_group_barrier(0x008, 2, 0);
#pragma unroll
                for (int s2 = 0; s2 < 2; ++s2) ac[kt >> 1] = __builtin_amdgcn_mfma_f32_32x32x16_bf16(__builtin_bit_cast(bf16x8, vf[s2]), pf[kt][s2], ac[kt >> 1], 0, 0, 0);
            }
#pragma unroll
            for (int g4 = 0; g4 < 4; ++g4) {
                float o[4];
#pragma unroll
                for (int e = 0; e < 4; ++e) o[e] = (ac[0][4 * g4 + e] * fq[0] + ac[1][4 * g4 + e] * fq[1]) + (ac[2][4 * g4 + e] * fq[2] + ac[3][4 * g4 + e] * fq[3]);
                u32x2 w; w.x = cvt_pk_bf16(o[0], o[1]); w.y = cvt_pk_bf16(o[2], o[3]);
                *(u32x2*)(op + dt * 32 + 8 * g4) = w;
            }
        }
        asm volatile("s_waitcnt lgkmcnt(0)" ::: "memory");
    }
    __syncthreads();
}

__device__ void final_norm_phase(const bf16_t* xb, float* out, const float* g) {
    const int tid0 = opaque_tid(), lane = tid0 & 63, gw = blockIdx.x * 8 + (tid0 >> 6), nw = gridDim.x * 8;
    f32x4 gg[4];
#pragma unroll
    for (int i = 0; i < 4; ++i) gg[i] = *(const f32x4*)(g + i * 256 + lane * 4);
    for (int row = gw; row < T_TOK; row += 2 * nw) {
        u32x2 b2[2][4];
#pragma unroll
        for (int rr = 0; rr < 2; ++rr)
#pragma unroll
            for (int i = 0; i < 4; ++i) b2[rr][i] = *(const u32x2*)(xb + (size_t)(row + rr * nw) * DM + i * 256 + lane * 4);
#pragma unroll
        for (int rr = 0; rr < 2; ++rr) {
            f32x4 v[4]; float ss = 0.f;
#pragma unroll
            for (int i = 0; i < 4; ++i) {
                v[i][0] = bf_lo(b2[rr][i].x); v[i][1] = bf_hi(b2[rr][i].x); v[i][2] = bf_lo(b2[rr][i].y); v[i][3] = bf_hi(b2[rr][i].y);
                ss += (v[i][0] * v[i][0] + v[i][1] * v[i][1]) + (v[i][2] * v[i][2] + v[i][3] * v[i][3]);
            }
#pragma unroll
            for (int o = 32; o >= 1; o >>= 1) ss += shx(ss, o);
            const float rs = 1.0f / sqrtf(ss * (1.0f / 1024.0f) + NORM_EPS);
#pragma unroll
            for (int i = 0; i < 4; ++i) *(f32x4*)(out + (size_t)(row + rr * nw) * DM + i * 256 + lane * 4) = v[i] * rs * gg[i];
        }
    }
}

__global__ void __launch_bounds__(NTHREADS, 2) mega_fwd(Args a_unused) {
    extern __shared__ __attribute__((aligned(16))) unsigned char lds_raw[];
    LAS unsigned char* lds = (LAS unsigned char*)lds_raw;
    cg::grid_group grid = cg::this_grid();
    const int G = gridDim.x, c = blockIdx.x;
#define WSP(off) (get_args()->ws + (off))
#define XB_ ((bf16_t*)WSP(WS_XB))
#define HB_ ((bf16_t*)WSP(WS_HB))
#define HB2_ ((bf16_t*)WSP(WS_HB + (size_t)T_TOK * DM * 2))
#define PART_ ((float*)WSP(WS_PART))
#define OUT_ (get_args()->out)

    { unsigned* bar0 = (unsigned*)WSP(WS_BAR); if (blockIdx.x == 0 && threadIdx.x < 33) __hip_atomic_store(bar0 + 64 * threadIdx.x, 0u, __ATOMIC_RELAXED, __HIP_MEMORY_SCOPE_AGENT); }
    unsigned bar_k = 0;
#define GRID_BAR() do { bar_k += 1u; grid_barrier((unsigned*)WSP(WS_BAR), bar_k, 16u, (unsigned)G / 16u); } while (0)
    prep_phase(lds);
    grid.sync();
    {
        pg8::StaticOrder S; S.init(4096, 4096, G, c);
        { pg8::Gemm g = pg8::mk_gemm((const bf16_t*)WSP(WS_MEMB), (const bf16_t*)WSP(WS_K), DM); EpiBf16S E{(bf16_t*)WSP(WS_KALL), 4096, nullptr, 0, 1.0f}; pg8::gemm_phase(lds, g, S, E); }
        { pg8::Gemm g = pg8::mk_gemm((const bf16_t*)WSP(WS_VT), (const bf16_t*)WSP(WS_MEMB), DM); EpiBf16S E{(bf16_t*)WSP(WS_VTALL), 4096, nullptr, 0, 1.0f}; pg8::gemm_phase(lds, g, S, E); }
    }
#pragma unroll 1
    for (int l = 0; l < NLAYER; ++l) {
#pragma unroll 1
        for (int pass = 0; pass < 2; ++pass) {
            {
                pg8::StaticOrder S; S.init(T_TOK, 2 * DFF, G, c);
                pg8::Gemm g = pg8::mk_gemm(XB_, (const bf16_t*)WSP((pass ? WS_UP2 : WS_UP1) + l * SZ_UP), DM);
                EpiSwiglu E{HB_, PART_, 16}; pg8::gemm_phase(lds, g, S, E);
            }
            GRID_BAR();
            {
                pg8::StaticOrder S; S.init(T_TOK, DM, G, c);
                pg8::Gemm g = pg8::mk_gemm(HB_, (const bf16_t*)WSP((pass ? WS_DN2 : WS_DN1) + l * SZ_DN), DFF);
                EpiResid E{(l == 0 && pass == 0) ? get_args()->in[0] : (const float*)nullptr, XB_, PART_, 0.5f}; pg8::gemm_phase(lds, g, S, E);
            }
            GRID_BAR();
            if (pass == 0) {
                const int j = l >> 1; int np_q;
                if ((l & 1) == 0) {
                    {
                        pg8::StaticOrder S; S.init(T_TOK, 3 * DM, G, c);
                        pg8::Gemm g = pg8::mk_gemm(XB_, (const bf16_t*)WSP(WS_CIN + j * 3 * SZ_SQ), DM);
                        EpiConvIn E{HB_, HB2_, PART_, 16}; pg8::gemm_phase(lds, g, S, E);
                    }
                    GRID_BAR();
                    conv_phase(HB_, HB2_, get_args()->in[9] + (size_t)j * 3 * DM);
                    GRID_BAR();
                    {
                        pg8::StaticOrder S; S.init(T_TOK, DM, G, c);
                        pg8::Gemm g = pg8::mk_gemm(HB2_, (const bf16_t*)WSP(WS_COUT + j * SZ_SQ), DM);
                        EpiResid E{nullptr, XB_, PART_, 1.0f}; pg8::gemm_phase(lds, g, S, E);
                    }
                    GRID_BAR();
                    np_q = 16;
                } else {
#define U2_ HB_
#define PU_ ((float*)WSP(WS_HB + SSM_PU_OFF))
#define Z_ ((bf16_t*)WSP(WS_HB + SSM_PU_OFF))
#define MQ_ ((bf16_t*)WSP(WS_HB + SSM_MQ_OFF))
#define PM_ ((bf16_t*)WSP(WS_HB + SSM_P_OFF))
                    ssm_uprep_phase(XB_, PART_, get_args()->in[2] + (size_t)(l * 5 + 1) * DM, U2_);
                    ssm_build_phase(j, MQ_, PM_, lds);
                    GRID_BAR();
                    {
                        pg8::GroupOrder S{G, c};
                        pg8::Gemm g{U2_, PM_, 256, 384, (size_t)128 * 256 * 2};
                        EpiPU E{PU_}; pg8::gemm_phase(lds, g, S, E);
                    }
                    GRID_BAR();
                    ssm_cscan_phase(j, PU_, U2_);
                    GRID_BAR();
                    {
                        pg8::GroupOrder S{G, c};
                        pg8::Gemm g{U2_, MQ_, 384, 384, (size_t)256 * 384 * 2};
                        EpiY E{U2_, Z_, get_args()->in[18] + (size_t)j * DM}; pg8::gemm_phase(lds, g, S, E);
                    }
                    GRID_BAR();
                    {
                        pg8::StaticOrder S; S.init(T_TOK, 2 * DM, G, c);
                        pg8::Gemm g = pg8::mk_gemm(Z_, (const bf16_t*)WSP(WS_GLU + j * 2 * SZ_SQ), DM);
                        EpiGlu E{XB_, PART_}; pg8::gemm_phase(lds, g, S, E);
                    }
                    GRID_BAR();
                    np_q = 32;
                }
                {
                    pg8::StaticOrder S; S.init(T_TOK, DM, G, c);
                    pg8::Gemm g = pg8::mk_gemm(XB_, (const bf16_t*)WSP(WS_Q + l * SZ_SQ), DM);
                    EpiBf16S E{HB_, DM, PART_, np_q, 0.0625f * 1.44269504089f}; pg8::gemm_phase(lds, g, S, E);
                }
                GRID_BAR();
                attn_phase(HB_, (const bf16_t*)WSP(WS_KALL), (const bf16_t*)WSP(WS_VTALL), HB2_, l, lds);
                GRID_BAR();
                {
                    pg8::StaticOrder S; S.init(T_TOK, DM, G, c);
                    pg8::Gemm g = pg8::mk_gemm(HB2_, (const bf16_t*)WSP(WS_O + l * SZ_SQ), DM);
                    EpiResid E{nullptr, XB_, PART_, 1.0f}; pg8::gemm_phase(lds, g, S, E);
                }
                GRID_BAR();
            }
        }
    }
    final_norm_phase(XB_, OUT_, get_args()->in[3]);
}

extern "C" void kernel_launch(void* const* d_in, const int* in_sizes, int n_in, void* d_out, int out_size, void* d_ws, size_t ws_size, hipStream_t stream) {
    static int grid_blocks = 0;
    if (grid_blocks == 0) {
        if (n_in != 23 || out_size != T_TOK * DM || ws_size < WS_END) { fprintf(stderr, "kernel_launch: unexpected shapes (n_in %d out %d ws %zu need %zu)\n", n_in, out_size, ws_size, (size_t)WS_END); grid_blocks = -1; return; }
        int dev = 0, cus = 0, per_cu = 0;
        hipGetDevice(&dev);
        hipDeviceGetAttribute(&cus, hipDeviceAttributeMultiprocessorCount, dev);
        if (hipFuncSetAttribute((const void*)mega_fwd, hipFuncAttributeMaxDynamicSharedMemorySize, LDS_BYTES) != hipSuccess) { fprintf(stderr, "kernel_launch: hipFuncSetAttribute failed\n"); grid_blocks = -1; return; }
        if (hipOccupancyMaxActiveBlocksPerMultiprocessor(&per_cu, (const void*)mega_fwd, NTHREADS, LDS_BYTES) != hipSuccess || per_cu < 1) { fprintf(stderr, "kernel_launch: occupancy query gave %d\n", per_cu); per_cu = 1; }
        (void)hipGetLastError();
        grid_blocks = cus * 1;
    }
    if (grid_blocks < 0) return;
    Args a{};
    for (int i = 0; i < 23; ++i) a.in[i] = (const float*)d_in[i];
    a.out = (float*)d_out; a.ws = (unsigned char*)d_ws;
    void* args[] = {&a};
    hipError_t e = hipLaunchCooperativeKernel((const void*)mega_fwd, dim3(grid_blocks), dim3(NTHREADS), args, LDS_BYTES, stream);
    if (e != hipSuccess) fprintf(stderr, "cooperative launch failed: %s (grid %d)\n", hipGetErrorString(e), grid_blocks);
}
```

```cpp
#include <hip/hip_runtime.h>
#include <hip/hip_cooperative_groups.h>
#include <cstdio>
namespace cg = cooperative_groups;

#define LAS __attribute__((address_space(3)))
typedef unsigned short bf16_t;
typedef short bf16x8 __attribute__((ext_vector_type(8)));
typedef float f32x4 __attribute__((ext_vector_type(4)));
typedef float f32x16 __attribute__((ext_vector_type(16)));
typedef unsigned u32x4 __attribute__((ext_vector_type(4)));
typedef unsigned u32x2 __attribute__((ext_vector_type(2)));

constexpr int T_TOK = 32768, DM = 1024, DFF = 2816, SEQ = 2048, NB = 16, MEML = 256, NLAYER = 4;
constexpr int NTHREADS = 512;
constexpr int LDS_BYTES = 131072 + 32768;
constexpr float NORM_EPS = 1e-6f;

constexpr size_t SZ_UP = (size_t)2 * DFF * DM * 2, SZ_DN = (size_t)DM * DFF * 2, SZ_SQ = (size_t)DM * DM * 2;
constexpr size_t WS_UP1 = 0;
constexpr size_t WS_DN1 = WS_UP1 + 4 * SZ_UP;
constexpr size_t WS_UP2 = WS_DN1 + 4 * SZ_DN;
constexpr size_t WS_DN2 = WS_UP2 + 4 * SZ_UP;
constexpr size_t WS_CIN = WS_DN2 + 4 * SZ_DN;
constexpr size_t WS_COUT = WS_CIN + 2 * 3 * SZ_SQ;
constexpr size_t WS_GLU = WS_COUT + 2 * SZ_SQ;
constexpr size_t WS_Q = WS_GLU + 2 * 2 * SZ_SQ;
constexpr size_t WS_K = WS_Q + 4 * SZ_SQ;
constexpr size_t WS_VT = WS_K + 4 * SZ_SQ;
constexpr size_t WS_O = WS_VT + 4 * SZ_SQ;
constexpr size_t WS_XB = WS_O + 4 * SZ_SQ;
constexpr size_t WS_HB = WS_XB + (size_t)T_TOK * DM * 2;
constexpr size_t WS_MEMB = WS_HB + (size_t)T_TOK * DFF * 2;
constexpr size_t WS_KALL = WS_MEMB + (size_t)4096 * DM * 2;
constexpr size_t WS_VTALL = WS_KALL + (size_t)4096 * 4096 * 2;
constexpr size_t WS_PART = WS_VTALL + (size_t)4096 * 4096 * 2;
constexpr size_t WS_DISC = WS_PART + (size_t)T_TOK * 32 * 4;
constexpr size_t WS_BAR = WS_DISC + (size_t)2 * 64 * 64 * 8 * 4;
constexpr size_t WS_END = WS_BAR + 256 * 65;

__device__ __forceinline__ unsigned cvt_pk_bf16(float lo, float hi) { unsigned r; asm volatile("v_cvt_pk_bf16_f32 %0, %1, %2" : "=v"(r) : "v"(lo), "v"(hi)); return r; }
__device__ __forceinline__ float bf_lo(unsigned w) { return __uint_as_float(w << 16); }
__device__ __forceinline__ float bf_hi(unsigned w) { return __uint_as_float(w & 0xffff0000u); }
__device__ __forceinline__ float fast_sigmoid(float x) { return __builtin_amdgcn_rcpf(1.0f + __builtin_amdgcn_exp2f(-1.44269504089f * x)); }
__device__ __forceinline__ float gelu_tanh(float x) { const float a = 1.5957691216f * (x + 0.044715f * x * x * x); return x * fast_sigmoid(a); }

__device__ __forceinline__ void grid_barrier(unsigned* bar, unsigned k, unsigned nsub, unsigned per_sub) {
    asm volatile("s_waitcnt vmcnt(0)" ::: "memory");
    __syncthreads();
    if (threadIdx.x == 0) {
        __builtin_amdgcn_fence(__ATOMIC_RELEASE, "agent");
        asm volatile("s_waitcnt vmcnt(0)" ::: "memory");
        const unsigned old = __hip_atomic_fetch_add(bar + 64 * (1 + (blockIdx.x % nsub)), 1u, __ATOMIC_RELAXED, __HIP_MEMORY_SCOPE_AGENT);
        if (old + 1u == k * per_sub) {
            const unsigned oldt = __hip_atomic_fetch_add(bar, 1u, __ATOMIC_RELAXED, __HIP_MEMORY_SCOPE_AGENT);
            if (oldt + 1u == k * nsub)
                for (unsigned i = 0; i < nsub; ++i) __hip_atomic_store(bar + 64 * (33 + i), k, __ATOMIC_RELAXED, __HIP_MEMORY_SCOPE_AGENT);
        }
        while (__hip_atomic_load(bar + 64 * (33 + (blockIdx.x % nsub)), __ATOMIC_RELAXED, __HIP_MEMORY_SCOPE_AGENT) < k) __builtin_amdgcn_s_sleep(1);
        __builtin_amdgcn_fence(__ATOMIC_ACQUIRE, "agent");
        asm volatile("s_waitcnt vmcnt(0)" ::: "memory");
    }
    __syncthreads();
}
__device__ __forceinline__ float shx(float v, int mask) {
    unsigned m = ~0u; asm volatile("" : "+s"(m));
    const int lane = __builtin_amdgcn_mbcnt_hi(m, __builtin_amdgcn_mbcnt_lo(m, 0));
    return __int_as_float(__builtin_amdgcn_ds_bpermute((lane ^ mask) << 2, __float_as_int(v)));
}
template <class T> __device__ __forceinline__ T* launder(T* p) { asm volatile("" : "+s"(p)); return p; }
__device__ __forceinline__ int opaque_tid() { int t = threadIdx.x; asm volatile("" : "+v"(t)); return t; }

namespace pg8 {
constexpr int BM = 256, BK = 64, HALF = 128, HTB = HALF * BK * 2, STAGE_BYTES = 8 * HTB, NXCD = 8, WGM = 4;
__host__ __device__ __forceinline__ int lds_byte(int r, int c) { const int st = (r >> 4) * 2 + (c >> 5), rr = r & 15, cc = c & 31, ob = rr * 64 + cc * 2; return st * 1024 + (ob ^ (((ob >> 9) & 1) << 5)); }
__host__ __device__ __forceinline__ void stage_rc(int b, int& R, int& C) { const int st = b / 1024, sb = b % 1024, swz = sb ^ (((sb >> 9) & 1) << 5); R = (st >> 1) * 16 + swz / 64; C = (st & 1) * 32 + (swz % 64) / 2; }
__host__ __device__ __forceinline__ int perm32(int rho) { const int n = rho >> 4, i = rho & 15; return 8 * (i >> 2) + 4 * n + (i & 3); }

struct Unit { int pm, pn; };
struct Gemm { const bf16_t* A; const bf16_t* Bt; int K, lda; size_t tstepB; };
__device__ __forceinline__ Gemm mk_gemm(const bf16_t* A, const bf16_t* Bt, int K) { return Gemm{A, Bt, K, K, (size_t)512 * K}; }

struct StaticOrder {
    int nM, nN, nwg, G, c;
    __device__ void init(int M, int N, int G_, int c_) { nM = M / BM; nN = N / BM; nwg = nM * nN; G = G_; c = c_; }
    __device__ bool next(int i, Unit& u) const {
        const long L = (long)i * G + c; if (L >= nwg) return false;
        int wgid = (int)L; { const int q = nwg / NXCD, r = nwg % NXCD, xcd = wgid % NXCD, off = wgid / NXCD; wgid = (xcd < r ? xcd * (q + 1) : r * (q + 1) + (xcd - r) * q) + off; }
        const int nig = WGM * nN, gid = wgid / nig, fm = gid * WGM, gsz = (nM - fm) < WGM ? (nM - fm) : WGM;
        u.pm = fm + ((wgid % nig) % gsz); u.pn = (wgid % nig) / gsz; return true;
    }
};

struct GroupOrder {
    int G, c;
    __device__ bool next(int i, Unit& u) const { const int L = i * G + c; if (L >= 512) return false; u.pm = L; u.pn = L >> 3; return true; }
};

template <class Epi, class Sched>
__device__ __forceinline__ void gemm_phase(LAS unsigned char* lds, const Gemm g, const Sched& S, const Epi& E) {
    const int tid = opaque_tid(), wid = __builtin_amdgcn_readfirstlane(tid >> 6), lane = tid & 63, wr = wid >> 2, wc = wid & 3, fr = lane & 15, fq = lane >> 4;
    const int K = g.K, nt = K / BK;
    unsigned voffA[2], voffB[2];
#pragma unroll
    for (int i = 0; i < 2; ++i) { int R, C; stage_rc(tid * 16 + i * 8192, R, C); const int Rb = Epi::PERM ? ((R & ~31) + perm32(R & 31)) : R;
        voffA[i] = (unsigned)(R * g.lda + C) * 2u; voffB[i] = (unsigned)(Rb * K + C) * 2u; }
    const size_t kstep = (size_t)(BK * 2);
    const size_t hstepA = (size_t)HALF * g.lda * 2, hstepB = (size_t)HALF * K * 2;
    const size_t tstepA = 2 * hstepA, tstepB = g.tstepB;
    const unsigned ldsw = (unsigned)wid * 1024u;
    const int aoff = lds_byte(wr * 64 + fr, fq * 8), boff = lds_byte(wc * 32 + fr, fq * 8);
#define PG8_SA(b, h) (((b) * 2 + (h)) * HTB)
#define PG8_SB(b, h) ((4 + (b) * 2 + (h)) * HTB)
#define PG8_STAGE(bufoff, gbase, voff) do { _Pragma("unroll") for (int _i = 0; _i < 2; ++_i) \
        __builtin_amdgcn_global_load_lds((const unsigned*)((const char*)(gbase) + (voff)[_i]), (LAS unsigned*)(lds + (bufoff) + ldsw + _i * 8192), 16, 0, 0); } while (0)
#define PG8_LDA(dst, b, h) do { _Pragma("unroll") for (int m = 0; m < 4; ++m) _Pragma("unroll") for (int k = 0; k < 2; ++k) dst[m][k] = *(const LAS bf16x8*)(lds + PG8_SA(b, h) + aoff + m * 2048 + k * 1024); } while (0)
#define PG8_LDB(dst, b, h) do { _Pragma("unroll") for (int n = 0; n < 2; ++n) _Pragma("unroll") for (int k = 0; k < 2; ++k) dst[n][k] = *(const LAS bf16x8*)(lds + PG8_SB(b, h) + boff + n * 2048 + k * 1024); } while (0)
#define PG8_MMA(ai, bj, At, Bt) do { __builtin_amdgcn_s_setprio(1); _Pragma("unroll") for (int m = 0; m < 4; ++m) _Pragma("unroll") for (int n = 0; n < 2; ++n) _Pragma("unroll") for (int k = 0; k < 2; ++k) \
        acc[ai][bj][m][n] = __builtin_amdgcn_mfma_f32_16x16x32_bf16(Bt[n][k], At[m][k], acc[ai][bj][m][n], 0, 0, 0); __builtin_amdgcn_s_setprio(0); } while (0)
#define PG8_WAIT_V(n) asm volatile("s_waitcnt vmcnt(" #n ")" ::: "memory")
#define PG8_WAIT_L(n) asm volatile("s_waitcnt lgkmcnt(" #n ")" ::: "memory")
#define PG8_BAR __builtin_amdgcn_s_barrier()
#define PG8_SCHED __builtin_amdgcn_sched_barrier(0)
    const bool lp = Epi::LDSPART && E.lds_part();
#define PG8_PART_DMA(unit, buf) do { if constexpr (Epi::LDSPART) { if (lp) { const char* ps_ = (const char*)E.part + ((size_t)(unit).pm * 256 + 32 * wid) * 128; const unsigned pv_ = (unsigned)((lane >> 2) * 128 + (lane & 3) * 16); \
        __builtin_amdgcn_global_load_lds((const unsigned*)(ps_ + pv_), (LAS unsigned*)(lds + STAGE_BYTES + (buf) * 16384 + (32 * wid) * 64), 16, 0, 0); \
        __builtin_amdgcn_global_load_lds((const unsigned*)(ps_ + 2048 + pv_), (LAS unsigned*)(lds + STAGE_BYTES + (buf) * 16384 + (32 * wid + 16) * 64), 16, 0, 0); } } } while (0)
    Unit cur, nxt; int ui = 0;
    if (!S.next(0, cur)) return;
    f32x4 acc[2][2][4][2];
#pragma unroll
    for (int a = 0; a < 2; ++a)
#pragma unroll
        for (int b = 0; b < 2; ++b)
#pragma unroll
            for (int m = 0; m < 4; ++m)
#pragma unroll
                for (int n = 0; n < 2; ++n) acc[a][b][m][n] = (f32x4){0.f, 0.f, 0.f, 0.f};
    bf16x8 At[4][2], B0[2][2], B1[2][2];
    const char* cA = (const char*)g.A + (size_t)cur.pm * tstepA; const char* cB = (const char*)g.Bt + (size_t)cur.pn * tstepB;
    PG8_PART_DMA(cur, 0);
    PG8_STAGE(PG8_SB(0, 0), cB, voffB); PG8_STAGE(PG8_SA(0, 0), cA, voffA); PG8_STAGE(PG8_SB(0, 1), cB + hstepB, voffB); PG8_STAGE(PG8_SA(0, 1), cA + hstepA, voffA);
    if (wr == 1) PG8_BAR;
    PG8_WAIT_V(4); PG8_BAR;
    PG8_STAGE(PG8_SB(1, 0), cB + kstep, voffB); PG8_STAGE(PG8_SA(1, 0), cA + kstep, voffA); PG8_STAGE(PG8_SB(1, 1), cB + hstepB + kstep, voffB);
    PG8_WAIT_V(6); PG8_BAR;
    for (;;) {
        const bool has_next = S.next(ui + 1, nxt);
        const char* nA = has_next ? (const char*)g.A + (size_t)nxt.pm * tstepA : cA; const char* nB = has_next ? (const char*)g.Bt + (size_t)nxt.pn * tstepB : cB;
        for (int t = 0; t < nt; t += 2) {
            const bool last = (t == nt - 2);
            const char* a1 = cA + (size_t)(t + 1) * kstep;
            const char* a2 = last ? nA : cA + (size_t)(t + 2) * kstep; const char* b2 = last ? nB : cB + (size_t)(t + 2) * kstep;
            const char* a3 = a2 + kstep; const char* b3 = b2 + kstep;
            PG8_LDB(B0, 0, 0); PG8_SCHED; PG8_LDA(At, 0, 0); PG8_STAGE(PG8_SA(1, 1), a1 + hstepA, voffA);
            PG8_WAIT_L(8); PG8_BAR; PG8_WAIT_L(0); PG8_MMA(0, 0, At, B0); PG8_BAR; PG8_SCHED;
            PG8_LDB(B1, 0, 1); PG8_STAGE(PG8_SB(0, 0), b2, voffB);
            PG8_BAR; PG8_WAIT_L(0); PG8_MMA(0, 1, At, B1); PG8_BAR;
            PG8_LDA(At, 0, 1); PG8_STAGE(PG8_SA(0, 0), a2, voffA);
            PG8_BAR; PG8_WAIT_L(0); PG8_MMA(1, 0, At, B0); PG8_BAR; PG8_SCHED;
            PG8_STAGE(PG8_SB(0, 1), b2 + hstepB, voffB);
            PG8_WAIT_V(6); PG8_BAR;
            if (last && has_next) PG8_PART_DMA(nxt, (ui + 1) & 1);
            PG8_MMA(1, 1, At, B1); PG8_BAR;
            PG8_LDB(B0, 1, 0); PG8_SCHED; PG8_LDA(At, 1, 0); PG8_STAGE(PG8_SA(0, 1), a2 + hstepA, voffA);
            PG8_WAIT_L(8); PG8_BAR; PG8_WAIT_L(0); PG8_MMA(0, 0, At, B0); PG8_BAR; PG8_SCHED;
            PG8_LDB(B1, 1, 1); PG8_STAGE(PG8_SB(1, 0), b3, voffB);
            PG8_BAR; PG8_WAIT_L(0); PG8_MMA(0, 1, At, B1); PG8_BAR;
            PG8_LDA(At, 1, 1); PG8_STAGE(PG8_SA(1, 0), a3, voffA);
            PG8_BAR; PG8_WAIT_L(0); PG8_MMA(1, 0, At, B0); PG8_BAR; PG8_SCHED;
            PG8_STAGE(PG8_SB(1, 1), b3 + hstepB, voffB);
            PG8_WAIT_V(6); PG8_BAR; PG8_MMA(1, 1, At, B1); PG8_BAR;
        }
        E(acc, cur, wr, wc, fr, fq, lp ? (const LAS unsigned char*)(lds + STAGE_BYTES + (ui & 1) * 16384) : (const LAS unsigned char*)nullptr);
        if (!has_next) break;
#pragma unroll
        for (int a = 0; a < 2; ++a)
#pragma unroll
            for (int b = 0; b < 2; ++b)
#pragma unroll
                for (int m = 0; m < 4; ++m)
#pragma unroll
                    for (int n = 0; n < 2; ++n) acc[a][b][m][n] = (f32x4){0.f, 0.f, 0.f, 0.f};
        cur = nxt; cA = nA; cB = nB; ++ui;
    }
    PG8_WAIT_V(0);
    if (wr == 0) PG8_BAR;
    PG8_BAR;
#undef PG8_PART_DMA
#undef PG8_SA
#undef PG8_SB
#undef PG8_STAGE
#undef PG8_LDA
#undef PG8_LDB
#undef PG8_MMA
#undef PG8_WAIT_V
#undef PG8_WAIT_L
#undef PG8_BAR
#undef PG8_SCHED
}
}
using pg8::Unit;

__device__ __forceinline__ void rows_rstd(const float* part, int row0, int np, int fq, float (&rs)[8]) {
#pragma unroll
    for (int hf = 0; hf < 2; ++hf) {
        f32x4 pa[4], pb[4];
#pragma unroll
        for (int g4 = 0; g4 < 4; ++g4) {
            const float* p = part + (size_t)(row0 + hf * 128 + g4 * 16) * 32;
            if (np == 16) { pa[g4] = *(const f32x4*)(p + 4 * fq); pb[g4] = (f32x4){0.f, 0.f, 0.f, 0.f}; }
            else { pa[g4] = *(const f32x4*)(p + 8 * fq); pb[g4] = *(const f32x4*)(p + 8 * fq + 4); }
        }
#pragma unroll
        for (int g4 = 0; g4 < 4; ++g4) {
            float sm = ((pa[g4][0] + pa[g4][1]) + (pa[g4][2] + pa[g4][3])) + ((pb[g4][0] + pb[g4][1]) + (pb[g4][2] + pb[g4][3]));
            sm += shx(sm, 16); sm += shx(sm, 32);
            rs[hf * 4 + g4] = __builtin_amdgcn_rsqf(sm * (1.0f / 1024.0f) + NORM_EPS);
        }
        if (np != 16) asm volatile("" ::: "memory");
    }
}

__device__ __forceinline__ void rows_rstd_lds(const LAS unsigned char* lp, int rl0, int fq, float (&rs)[8]) {
    f32x4 pa[8];
#pragma unroll
    for (int g = 0; g < 8; ++g) pa[g] = *(const LAS f32x4*)(lp + (rl0 + (g >> 2) * 128 + (g & 3) * 16) * 64 + fq * 16);
#pragma unroll
    for (int g = 0; g < 8; ++g) {
        float sm = (pa[g][0] + pa[g][1]) + (pa[g][2] + pa[g][3]);
        sm += shx(sm, 16); sm += shx(sm, 32);
        rs[g] = __builtin_amdgcn_rsqf(sm * (1.0f / 1024.0f) + NORM_EPS);
    }
}

struct EpiBf16S {
    static constexpr bool PERM = true, LDSPART = true;
    bf16_t* O; int ldc; const float* part; int np; float cscale;
    __device__ __forceinline__ bool lds_part() const { return part != nullptr && np == 16; }
    __device__ __forceinline__ void operator()(const f32x4 (&acc)[2][2][4][2], const Unit& u, int wr, int wc, int fr, int fq, const LAS unsigned char* lp) const {
        { const int ln_ = opaque_tid() & 63; fr = ln_ & 15; fq = ln_ >> 4; }
        const int row0 = u.pm * 256 + wr * 64 + fr, col0 = u.pn * 256 + wc * 32 + 8 * fq;
        float rs[8];
        if (lp) rows_rstd_lds(lp, wr * 64 + fr, fq, rs);
        else if (part) rows_rstd(part, row0, np, fq, rs);
        else {
#pragma unroll
            for (int g = 0; g < 8; ++g) rs[g] = 1.0f; }
#pragma unroll
        for (int ai = 0; ai < 2; ++ai)
#pragma unroll
            for (int m = 0; m < 4; ++m) {
                const int row = row0 + ai * 128 + m * 16;
                const float sc = cscale * rs[ai * 4 + m];
                bf16_t* rowp = O + (size_t)row * ldc + col0;
#pragma unroll
                for (int bj = 0; bj < 2; ++bj) { const f32x4 v0 = acc[ai][bj][m][0] * sc, v1 = acc[ai][bj][m][1] * sc;
                    u32x4 w; w.x = cvt_pk_bf16(v0[0], v0[1]); w.y = cvt_pk_bf16(v0[2], v0[3]); w.z = cvt_pk_bf16(v1[0], v1[1]); w.w = cvt_pk_bf16(v1[2], v1[3]);
                    *(u32x4*)(rowp + bj * 128) = w; }
            }
    }
};
struct EpiSwiglu {
    static constexpr bool PERM = true, LDSPART = true;
    bf16_t* H; const float* part; int np;
    __device__ __forceinline__ bool lds_part() const { return np == 16; }
    __device__ __forceinline__ void operator()(const f32x4 (&acc)[2][2][4][2], const Unit& u, int wr, int wc, int fr, int fq, const LAS unsigned char* lp) const {
        { const int ln_ = opaque_tid() & 63; fr = ln_ & 15; fq = ln_ >> 4; }
        const int row0 = u.pm * 256 + wr * 64 + fr, col0 = u.pn * 128 + wc * 32 + 8 * fq;
        float rsv[8]; if (lp) rows_rstd_lds(lp, wr * 64 + fr, fq, rsv); else rows_rstd(part, row0, np, fq, rsv);
#pragma unroll
        for (int ai = 0; ai < 2; ++ai)
#pragma unroll
            for (int m = 0; m < 4; ++m) {
                const int row = row0 + ai * 128 + m * 16;
                const float rs = rsv[ai * 4 + m], c1 = -1.44269504089f * rs, r2 = rs * rs;
                float o[8];
#pragma unroll
                for (int n = 0; n < 2; ++n) {
                    const f32x4 gv = acc[ai][0][m][n], uv = acc[ai][1][m][n];
                    const f32x4 ev = gv * c1, tv = (gv * uv) * r2;
#pragma unroll
                    for (int j = 0; j < 4; ++j) o[n * 4 + j] = tv[j] * __builtin_amdgcn_rcpf(1.0f + __builtin_amdgcn_exp2f(ev[j]));
                }
                u32x4 w; w.x = cvt_pk_bf16(o[0], o[1]); w.y = cvt_pk_bf16(o[2], o[3]); w.z = cvt_pk_bf16(o[4], o[5]); w.w = cvt_pk_bf16(o[6], o[7]);
                *(u32x4*)(H + (size_t)row * DFF + col0) = w;
            }
    }
};
struct EpiConvIn {
    static constexpr bool PERM = true, LDSPART = true;
    bf16_t* U; bf16_t* Bg; const float* part; int np;
    __device__ __forceinline__ bool lds_part() const { return np == 16; }
    __device__ __forceinline__ void operator()(const f32x4 (&acc)[2][2][4][2], const Unit& u, int wr, int wc, int fr, int fq, const LAS unsigned char* lp) const {
        { const int ln_ = opaque_tid() & 63; fr = ln_ & 15; fq = ln_ >> 4; }
        const int row0 = u.pm * 256 + wr * 64 + fr;
        float rsv[8]; if (lp) rows_rstd_lds(lp, wr * 64 + fr, fq, rsv); else rows_rstd(part, row0, np, fq, rsv);
#pragma unroll
        for (int ai = 0; ai < 2; ++ai)
#pragma unroll
            for (int m = 0; m < 4; ++m) {
                const int row = row0 + ai * 128 + m * 16;
                const float rs = rsv[ai * 4 + m];
                if (u.pn < 8) {
                    const float r2 = rs * rs; float o[8];
#pragma unroll
                    for (int n = 0; n < 2; ++n)
#pragma unroll
                        for (int j = 0; j < 4; ++j) o[n * 4 + j] = acc[ai][0][m][n][j] * acc[ai][1][m][n][j] * r2;
                    u32x4 w; w.x = cvt_pk_bf16(o[0], o[1]); w.y = cvt_pk_bf16(o[2], o[3]); w.z = cvt_pk_bf16(o[4], o[5]); w.w = cvt_pk_bf16(o[6], o[7]);
                    *(u32x4*)(U + (size_t)row * DM + u.pn * 128 + wc * 32 + 8 * fq) = w;
                } else {
#pragma unroll
                    for (int bj = 0; bj < 2; ++bj) { const f32x4 v0 = acc[ai][bj][m][0] * rs, v1 = acc[ai][bj][m][1] * rs;
                        u32x4 w; w.x = cvt_pk_bf16(v0[0], v0[1]); w.y = cvt_pk_bf16(v0[2], v0[3]); w.z = cvt_pk_bf16(v1[0], v1[1]); w.w = cvt_pk_bf16(v1[2], v1[3]);
                        *(u32x4*)(Bg + (size_t)row * DM + (u.pn - 8) * 256 + bj * 128 + wc * 32 + 8 * fq) = w; }
                }
            }
    }
};
struct EpiResid {
    static constexpr bool PERM = true, LDSPART = false;
    __device__ __forceinline__ bool lds_part() const { return false; }
    const float* xin; bf16_t* xb; float* part; float scale;
    __device__ __forceinline__ void operator()(const f32x4 (&acc)[2][2][4][2], const Unit& u, int wr, int wc, int fr, int fq, const LAS unsigned char* lp) const {
        { const int ln_ = opaque_tid() & 63; fr = ln_ & 15; fq = ln_ >> 4; }
        const int row0 = u.pm * 256 + wr * 64 + fr, col0 = u.pn * 256 + wc * 32 + 8 * fq;
        if (xin == nullptr) {
#pragma unroll
            for (int ai = 0; ai < 2; ++ai) {
                u32x4 rb[4][2];
#pragma unroll
                for (int m = 0; m < 4; ++m)
#pragma unroll
                    for (int bj = 0; bj < 2; ++bj) rb[m][bj] = *(const u32x4*)((const char*)xb + (unsigned)((row0 + ai * 128 + m * 16) * DM + col0 + bj * 128) * 2u);
#pragma unroll
                for (int m = 0; m < 4; ++m) {
                    const int row = row0 + ai * 128 + m * 16; float ss = 0.f;
#pragma unroll
                    for (int bj = 0; bj < 2; ++bj) {
                        const u32x4 b4 = rb[m][bj];
                        f32x4 v0, v1; v0[0] = bf_lo(b4.x); v0[1] = bf_hi(b4.x); v0[2] = bf_lo(b4.y); v0[3] = bf_hi(b4.y); v1[0] = bf_lo(b4.z); v1[1] = bf_hi(b4.z); v1[2] = bf_lo(b4.w); v1[3] = bf_hi(b4.w);
                        v0 = v0 + acc[ai][bj][m][0] * scale; v1 = v1 + acc[ai][bj][m][1] * scale;
                        u32x4 w; w.x = cvt_pk_bf16(v0[0], v0[1]); w.y = cvt_pk_bf16(v0[2], v0[3]); w.z = cvt_pk_bf16(v1[0], v1[1]); w.w = cvt_pk_bf16(v1[2], v1[3]);
                        *(u32x4*)((char*)xb + (unsigned)(row * DM + col0 + bj * 128) * 2u) = w;
                        ss += ((v0[0] * v0[0] + v0[1] * v0[1]) + (v0[2] * v0[2] + v0[3] * v0[3])) + ((v1[0] * v1[0] + v1[1] * v1[1]) + (v1[2] * v1[2] + v1[3] * v1[3]));
                    }
                    ss += shx(ss, 16); ss += shx(ss, 32);
                    if (fq == 0) part[(size_t)row * 32 + u.pn * 4 + wc] = ss;
                }
                asm volatile("" ::: "memory");
            }
        } else {
#pragma unroll
            for (int gp = 0; gp < 4; ++gp) {
                const int ai = gp >> 1;
                f32x4 rb[2][4];
#pragma unroll
                for (int mm = 0; mm < 2; ++mm)
#pragma unroll
                    for (int q = 0; q < 4; ++q) rb[mm][q] = *(const f32x4*)(xin + (size_t)(row0 + ai * 128 + ((gp & 1) * 2 + mm) * 16) * DM + col0 + (q >> 1) * 128 + (q & 1) * 4);
#pragma unroll
                for (int mm = 0; mm < 2; ++mm) {
                    const int m = (gp & 1) * 2 + mm, row = row0 + ai * 128 + m * 16; float ss = 0.f;
#pragma unroll
                    for (int bj = 0; bj < 2; ++bj) {
                        const f32x4 v0 = rb[mm][bj * 2 + 0] + acc[ai][bj][m][0] * scale, v1 = rb[mm][bj * 2 + 1] + acc[ai][bj][m][1] * scale;
                        u32x4 w; w.x = cvt_pk_bf16(v0[0], v0[1]); w.y = cvt_pk_bf16(v0[2], v0[3]); w.z = cvt_pk_bf16(v1[0], v1[1]); w.w = cvt_pk_bf16(v1[2], v1[3]);
                        *(u32x4*)((char*)xb + (unsigned)(row * DM + col0 + bj * 128) * 2u) = w;
                        ss += ((v0[0] * v0[0] + v0[1] * v0[1]) + (v0[2] * v0[2] + v0[3] * v0[3])) + ((v1[0] * v1[0] + v1[1] * v1[1]) + (v1[2] * v1[2] + v1[3] * v1[3]));
                    }
                    ss += shx(ss, 16); ss += shx(ss, 32);
                    if (fq == 0) part[(size_t)row * 32 + u.pn * 4 + wc] = ss;
                }
                asm volatile("" ::: "memory");
            }
        }
    }
};
struct EpiGlu {
    static constexpr bool PERM = true, LDSPART = false;
    __device__ __forceinline__ bool lds_part() const { return false; }
    bf16_t* xb; float* part;
    __device__ __forceinline__ void operator()(const f32x4 (&acc)[2][2][4][2], const Unit& u, int wr, int wc, int fr, int fq, const LAS unsigned char* lp) const {
        { const int ln_ = opaque_tid() & 63; fr = ln_ & 15; fq = ln_ >> 4; }
        const int row0 = u.pm * 256 + wr * 64 + fr, col0 = u.pn * 128 + wc * 32 + 8 * fq;
#pragma unroll
        for (int ai = 0; ai < 2; ++ai) {
            u32x4 rb[4];
#pragma unroll
            for (int m = 0; m < 4; ++m) rb[m] = *(const u32x4*)((const char*)xb + (unsigned)((row0 + ai * 128 + m * 16) * DM + col0) * 2u);
#pragma unroll
            for (int m = 0; m < 4; ++m) {
                const int row = row0 + ai * 128 + m * 16;
                const u32x4 b4 = rb[m];
                f32x4 v0, v1; v0[0] = bf_lo(b4.x); v0[1] = bf_hi(b4.x); v0[2] = bf_lo(b4.y); v0[3] = bf_hi(b4.y); v1[0] = bf_lo(b4.z); v1[1] = bf_hi(b4.z); v1[2] = bf_lo(b4.w); v1[3] = bf_hi(b4.w);
#pragma unroll
                for (int j = 0; j < 4; ++j) { v0[j] += acc[ai][0][m][0][j] * fast_sigmoid(acc[ai][1][m][0][j]); v1[j] += acc[ai][0][m][1][j] * fast_sigmoid(acc[ai][1][m][1][j]); }
                u32x4 w; w.x = cvt_pk_bf16(v0[0], v0[1]); w.y = cvt_pk_bf16(v0[2], v0[3]); w.z = cvt_pk_bf16(v1[0], v1[1]); w.w = cvt_pk_bf16(v1[2], v1[3]);
                *(u32x4*)((char*)xb + (unsigned)(row * DM + col0) * 2u) = w;
                float ss = ((v0[0] * v0[0] + v0[1] * v0[1]) + (v0[2] * v0[2] + v0[3] * v0[3])) + ((v1[0] * v1[0] + v1[1] * v1[1]) + (v1[2] * v1[2] + v1[3] * v1[3]));
                ss += shx(ss, 16); ss += shx(ss, 32);
                if (fq == 0) part[(size_t)row * 32 + u.pn * 4 + wc] = ss;
            }
            asm volatile("" ::: "memory");
        }
    }
};

__device__ __forceinline__ int srccol(int kind, int n0) {
    if (kind == 0) return n0;
    const int pn = n0 >> 8, r = n0 & 255, bj = r >> 7, rr = r & 127;
    if (kind == 1) return bj * DFF + 128 * pn + rr;
    if (kind == 2) return n0 < 2048 ? (bj ? 2048 : 0) + 128 * pn + rr : 1024 + (n0 - 2048);
    return bj * 1024 + 128 * pn + rr;
}
__device__ void transpose_job(LAS float* tile, const float* W, int Nsrc, int K, bf16_t* dst, int Ndst, int kind, const float* gain) {
    const int tid = opaque_tid();
    const int tilesK = K >> 7, ntile = tilesK * (Ndst >> 7);
    for (int t = blockIdx.x; t < ntile; t += gridDim.x) {
        const int tn = t / tilesK, tk = t - tn * tilesK, n0 = tn * 128, k0 = tk * 128;
        const int sc = srccol(kind, n0);
        const int c4 = (tid & 31) * 4, kr = tid >> 5;
        f32x4 v[8];
#pragma unroll
        for (int i = 0; i < 8; ++i) v[i] = *(const f32x4*)(W + (size_t)(k0 + kr + 16 * i) * Nsrc + sc + c4);
#pragma unroll
        for (int i = 0; i < 8; ++i) {
            const int k = kr + 16 * i; const float gk = gain ? gain[k0 + k] : 1.0f;
            tile[k * 129 + c4 + 0] = v[i][0] * gk; tile[k * 129 + c4 + 1] = v[i][1] * gk; tile[k * 129 + c4 + 2] = v[i][2] * gk; tile[k * 129 + c4 + 3] = v[i][3] * gk;
        }
        __syncthreads();
#pragma unroll
        for (int i = 0; i < 4; ++i) {
            const int q = tid + NTHREADS * i, n = q >> 4, kc = (q & 15) * 8;
            float f[8];
#pragma unroll
            for (int e = 0; e < 8; ++e) f[e] = tile[(kc + e) * 129 + n];
            u32x4 w; w.x = cvt_pk_bf16(f[0], f[1]); w.y = cvt_pk_bf16(f[2], f[3]); w.z = cvt_pk_bf16(f[4], f[5]); w.w = cvt_pk_bf16(f[6], f[7]);
            *(u32x4*)(dst + (size_t)(n0 + n) * K + k0 + kc) = w;
        }
        __syncthreads();
    }
}

struct Args { const float* in[23]; float* out; unsigned char* ws; };
typedef const __attribute__((address_space(4))) Args* CArgs;
__device__ __forceinline__ CArgs get_args() { CArgs p = (CArgs)__builtin_amdgcn_kernarg_segment_ptr(); asm volatile("" : "+s"(p)); return p; }

__device__ __forceinline__ void sincos_d(double th, double& s, double& c) {
    const double twopi = 6.283185307179586476925;
    const double k = rint(th / twopi); const double r = th - k * twopi;
    const double q = r * 0.125, q2 = q * q;
    double sq = q * (1.0 + q2 * (-1.0 / 6.0 + q2 * (1.0 / 120.0 + q2 * (-1.0 / 5040.0 + q2 * (1.0 / 362880.0 + q2 * (-1.0 / 39916800.0 + q2 * (1.0 / 6227020800.0)))))));
    double cq = 1.0 + q2 * (-0.5 + q2 * (1.0 / 24.0 + q2 * (-1.0 / 720.0 + q2 * (1.0 / 40320.0 + q2 * (-1.0 / 3628800.0 + q2 * (1.0 / 479001600.0 + q2 * (-1.0 / 87178291200.0)))))));
#pragma unroll
    for (int i = 0; i < 3; ++i) { const double s2 = 2.0 * sq * cq, c2 = cq * cq - sq * sq; sq = s2; cq = c2; }
    s = sq; c = cq;
}
__device__ __forceinline__ double exp_d(double x) {
    const double ln2 = 0.693147180559945309417;
    const double k = rint(x / ln2); const double r = x - k * ln2;
    double p = 1.0 + r * (1.0 + r * (0.5 + r * (1.0 / 6.0 + r * (1.0 / 24.0 + r * (1.0 / 120.0 + r * (1.0 / 720.0 + r * (1.0 / 5040.0 + r * (1.0 / 40320.0 + r * (1.0 / 362880.0 + r * (1.0 / 3628800.0 + r * (1.0 / 39916800.0 + r * (1.0 / 479001600.0))))))))))));
    return ldexp(p, (int)k);
}

__device__ __forceinline__ void ssm_disc(CArgs a, int j, int g, int p, double& abr, double& abi, double& cfr, double& cfi) {
    const size_t gp = ((size_t)j * 64 + g) * 64 + p;
    const double lre = fmin((double)a->in[11][gp], -1e-4), lim = (double)a->in[12][gp];
    const double dt = exp_d((double)a->in[13][j * 64 + g]);
    const double mag = exp_d(lre * dt); double sn, cs; sincos_d(lim * dt, sn, cs);
    abr = mag * cs; abi = mag * sn;
    const double den = lre * lre + lim * lim, nre = abr - 1.0, nim = abi;
    cfr = (nre * lre + nim * lim) / den; cfi = (nim * lre - nre * lim) / den;
}
__device__ void prep_phase(LAS unsigned char* lds) {
    LAS float* tile = (LAS float*)lds;
    CArgs ap = get_args();
    unsigned char* ws = ap->ws;
    const float* norm_g = ap->in[2];
    for (int l = 0; l < NLAYER; ++l) {
        const float* g = norm_g + (size_t)l * 5 * DM;
        transpose_job(tile, ap->in[4] + (size_t)l * DM * 2 * DFF, 2 * DFF, DM, (bf16_t*)(ws + WS_UP1 + l * SZ_UP), 2 * DFF, 1, g + 0 * DM);
        transpose_job(tile, ap->in[5] + (size_t)l * DFF * DM, DM, DFF, (bf16_t*)(ws + WS_DN1 + l * SZ_DN), DM, 0, nullptr);
        transpose_job(tile, ap->in[6] + (size_t)l * DM * 2 * DFF, 2 * DFF, DM, (bf16_t*)(ws + WS_UP2 + l * SZ_UP), 2 * DFF, 1, g + 4 * DM);
        transpose_job(tile, ap->in[7] + (size_t)l * DFF * DM, DM, DFF, (bf16_t*)(ws + WS_DN2 + l * SZ_DN), DM, 0, nullptr);
        transpose_job(tile, ap->in[20] + (size_t)l * DM * DM, DM, DM, (bf16_t*)(ws + WS_Q + l * SZ_SQ), DM, 0, g + 2 * DM);
        transpose_job(tile, ap->in[21] + (size_t)l * DM * 2 * DM, 2 * DM, DM, (bf16_t*)(ws + WS_K + l * SZ_SQ), DM, 0, g + 3 * DM);
        transpose_job(tile, ap->in[21] + (size_t)l * DM * 2 * DM + DM, 2 * DM, DM, (bf16_t*)(ws + WS_VT + l * SZ_SQ), DM, 0, g + 3 * DM);
        transpose_job(tile, ap->in[22] + (size_t)l * DM * DM, DM, DM, (bf16_t*)(ws + WS_O + l * SZ_SQ), DM, 0, nullptr);
        if ((l & 1) == 0) {
            const int j = l >> 1;
            transpose_job(tile, ap->in[8] + (size_t)j * DM * 3 * DM, 3 * DM, DM, (bf16_t*)(ws + WS_CIN + j * 3 * SZ_SQ), 3 * DM, 2, g + 1 * DM);
            transpose_job(tile, ap->in[10] + (size_t)j * DM * DM, DM, DM, (bf16_t*)(ws + WS_COUT + j * SZ_SQ), DM, 0, nullptr);
        } else {
            const int j = l >> 1;
            transpose_job(tile, ap->in[19] + (size_t)j * DM * 2 * DM, 2 * DM, DM, (bf16_t*)(ws + WS_GLU + j * 2 * SZ_SQ), 2 * DM, 3, nullptr);
        }
    }
    const int tid0 = opaque_tid(), lane = tid0 & 63, gw = blockIdx.x * 8 + (tid0 >> 6), nw = gridDim.x * 8;
    const float* x = ap->in[0]; bf16_t* xb = (bf16_t*)(ws + WS_XB); float* part = (float*)(ws + WS_PART);
    for (int row = gw; row < T_TOK; row += 2 * nw) {
        f32x4 v[2][4];
#pragma unroll
        for (int rr = 0; rr < 2; ++rr)
#pragma unroll
            for (int i = 0; i < 4; ++i) v[rr][i] = *(const f32x4*)(x + (size_t)(row + rr * nw) * DM + i * 256 + lane * 4);
#pragma unroll
        for (int rr = 0; rr < 2; ++rr) {
            float ss = 0.f;
#pragma unroll
            for (int i = 0; i < 4; ++i) {
                const f32x4 t = v[rr][i];
                u32x2 w; w.x = cvt_pk_bf16(t[0], t[1]); w.y = cvt_pk_bf16(t[2], t[3]);
                *(u32x2*)(xb + (size_t)(row + rr * nw) * DM + i * 256 + lane * 4) = w;
                ss += (t[0] * t[0] + t[1] * t[1]) + (t[2] * t[2] + t[3] * t[3]);
            }
#pragma unroll
            for (int o = 32; o >= 1; o >>= 1) ss += shx(ss, o);
            if (lane < 16) part[(size_t)(row + rr * nw) * 32 + lane] = lane == 0 ? ss : 0.f;
        }
    }
    const float* mem = ap->in[1]; bf16_t* memb = (bf16_t*)(ws + WS_MEMB);
    for (int row = gw; row < NB * MEML; row += nw) {
        f32x4 v[4]; float ss = 0.f;
#pragma unroll
        for (int i = 0; i < 4; ++i) { v[i] = *(const f32x4*)(mem + (size_t)row * DM + i * 256 + lane * 4); ss += (v[i][0] * v[i][0] + v[i][1] * v[i][1]) + (v[i][2] * v[i][2] + v[i][3] * v[i][3]); }
#pragma unroll
        for (int o = 32; o >= 1; o >>= 1) ss += shx(ss, o);
        const float rs = __builtin_amdgcn_rsqf(ss * (1.0f / 1024.0f) + NORM_EPS);
#pragma unroll
        for (int i = 0; i < 4; ++i) { u32x2 w; w.x = cvt_pk_bf16(v[i][0] * rs, v[i][1] * rs); w.y = cvt_pk_bf16(v[i][2] * rs, v[i][3] * rs);
            *(u32x2*)(memb + (size_t)row * DM + i * 256 + lane * 4) = w; }
    }
    float* disc = (float*)(ws + WS_DISC);
    for (int idx = blockIdx.x * NTHREADS + tid0; idx < 2 * 64 * 64; idx += gridDim.x * NTHREADS) {
        double abr, abi, cfr, cfi; ssm_disc(ap, idx >> 12, (idx >> 6) & 63, idx & 63, abr, abi, cfr, cfi);
        double pr = abr, pi = abi;
#pragma unroll
        for (int q = 0; q < 4; ++q) { const double nr = pr * pr - pi * pi, ni = 2.0 * pr * pi; pr = nr; pi = ni; }
        f32x4 v0, v1; v0[0] = (float)abr; v0[1] = (float)abi; v0[2] = (float)cfr; v0[3] = (float)cfi; v1[0] = (float)pr; v1[1] = (float)pi; v1[2] = 0.f; v1[3] = 0.f;
        *(f32x4*)(disc + (size_t)idx * 8) = v0; *(f32x4*)(disc + (size_t)idx * 8 + 4) = v1;
    }
}

__device__ void conv_phase(const bf16_t* U, bf16_t* Bg, const float* cw) {
    const size_t total = (size_t)T_TOK * 128;
    for (size_t idx = (size_t)blockIdx.x * NTHREADS + opaque_tid(); idx < total; idx += (size_t)gridDim.x * NTHREADS) {
        const int t = (int)(idx >> 7), c8 = (int)(idx & 127) * 8, pos = t & (SEQ - 1);
        const size_t off = (size_t)t * DM + c8;
        const u32x4 u0 = *(const u32x4*)(U + off);
        u32x4 u1 = (u32x4){0u, 0u, 0u, 0u}, u2 = (u32x4){0u, 0u, 0u, 0u};
        if (pos >= 1) u1 = *(const u32x4*)(U + off - DM);
        if (pos >= 2) u2 = *(const u32x4*)(U + off - 2 * DM);
        const u32x4 bb = *(const u32x4*)(Bg + off);
        float o[8];
#pragma unroll
        for (int i = 0; i < 4; ++i) {
            const int c = c8 + 2 * i;
            const float w0a = cw[c], w0b = cw[c + 1], w1a = cw[DM + c], w1b = cw[DM + c + 1], w2a = cw[2 * DM + c], w2b = cw[2 * DM + c + 1];
            o[2 * i] = bf_lo(bb[i]) * (w0a * bf_lo(u2[i]) + w1a * bf_lo(u1[i]) + w2a * bf_lo(u0[i]));
            o[2 * i + 1] = bf_hi(bb[i]) * (w0b * bf_hi(u2[i]) + w1b * bf_hi(u1[i]) + w2b * bf_hi(u0[i]));
        }
        u32x4 w; w.x = cvt_pk_bf16(o[0], o[1]); w.y = cvt_pk_bf16(o[2], o[3]); w.z = cvt_pk_bf16(o[4], o[5]); w.w = cvt_pk_bf16(o[6], o[7]);
        *(u32x4*)(Bg + off) = w;
    }
}

constexpr size_t SSM_PU_OFF = (size_t)64 * 2048 * 384 * 2;
constexpr size_t SSM_MQ_OFF = SSM_PU_OFF + (size_t)64 * 2048 * 128 * 4;
constexpr size_t SSM_P_OFF = SSM_MQ_OFF + (size_t)64 * 256 * 384 * 2;
static_assert(SSM_P_OFF + (size_t)64 * 128 * 256 * 2 <= (size_t)T_TOK * DFF * 2, "ssm scratch must fit the hidden buffer");

__device__ void ssm_uprep_phase(const bf16_t* xb, const float* part, const float* gain, bf16_t* U2) {
    const int tid = opaque_tid(), lane = tid & 63, gw = blockIdx.x * 8 + (tid >> 6), nw = gridDim.x * 8;
    const int s = lane & 15, gq = lane >> 4;
    for (int item0 = gw; item0 < 32768; item0 += 2 * nw) {
        f32x4 pp[2][4]; u32x4 xa[2][2];
#pragma unroll
        for (int rr = 0; rr < 2; ++rr) {
            const int item = item0 + rr * nw, g = (item & 15) * 4 + gq, c = (item >> 4) & 127, b = item >> 11, row = b * SEQ + c * 16 + s;
#pragma unroll
            for (int q = 0; q < 4; ++q) pp[rr][q] = *(const f32x4*)(part + (size_t)row * 32 + 4 * q);
            xa[rr][0] = *(const u32x4*)(xb + (size_t)row * DM + g * 16); xa[rr][1] = *(const u32x4*)(xb + (size_t)row * DM + g * 16 + 8);
        }
#pragma unroll
        for (int rr = 0; rr < 2; ++rr) {
            const int item = item0 + rr * nw, g = (item & 15) * 4 + gq, c = (item >> 4) & 127, b = item >> 11;
            float ssq = 0.f;
#pragma unroll
            for (int q = 0; q < 4; ++q) ssq += (pp[rr][q][0] + pp[rr][q][1]) + (pp[rr][q][2] + pp[rr][q][3]);
            const float rs = __builtin_amdgcn_rsqf(ssq * (1.0f / 1024.0f) + NORM_EPS);
            const unsigned xw[8] = {xa[rr][0].x, xa[rr][0].y, xa[rr][0].z, xa[rr][0].w, xa[rr][1].x, xa[rr][1].y, xa[rr][1].z, xa[rr][1].w};
            unsigned w[8];
#pragma unroll
            for (int q4 = 0; q4 < 4; ++q4) {
                const f32x4 gv = *(const f32x4*)(gain + g * 16 + q4 * 4);
                w[q4 * 2] = cvt_pk_bf16(bf_lo(xw[q4 * 2]) * rs * gv[0], bf_hi(xw[q4 * 2]) * rs * gv[1]); w[q4 * 2 + 1] = cvt_pk_bf16(bf_lo(xw[q4 * 2 + 1]) * rs * gv[2], bf_hi(xw[q4 * 2 + 1]) * rs * gv[3]);
            }
            bf16_t* dst = U2 + ((size_t)g * 2048 + b * 128 + c) * 384 + 16 * s;
            *(u32x4*)dst = (u32x4){w[0], w[1], w[2], w[3]}; *(u32x4*)(dst + 8) = (u32x4){w[4], w[5], w[6], w[7]};
        }
    }
}

__device__ void ssm_build_phase(int j, bf16_t* MQ, bf16_t* P, LAS unsigned char* lds) {
    CArgs a = get_args();
    LAS float* ApR = (LAS float*)lds; LAS float* ApI = ApR + 17 * 64;
    LAS float* BbR = ApI + 17 * 64; LAS float* BbI = BbR + 1024;
    LAS float* CR = BbI + 1024; LAS float* CI = CR + 1024; LAS float* Kt = CI + 1024;
    const int tid = opaque_tid();
    for (int item = blockIdx.x; item < 256; item += gridDim.x) {
        const int g = item >> 2, q4 = item & 3;
        if (tid < 64) {
            const int p = tid; const f32x4 dv = *(const f32x4*)((const float*)(a->ws + WS_DISC) + (((size_t)j * 64 + g) * 64 + p) * 8);
            const float abr = dv[0], abi = dv[1], cfr = dv[2], cfi = dv[3];
            float pr = 1.0f, pi = 0.0f;
            for (int n = 0; n <= 16; ++n) { ApR[n * 64 + p] = pr; ApI[n * 64 + p] = pi; const float nr = pr * abr - pi * abi, ni = pr * abi + pi * abr; pr = nr; pi = ni; }
            const size_t gp = ((size_t)j * 64 + g) * 64 + p;
            for (int h = 0; h < 16; ++h) { const float br = a->in[14][gp * 16 + h], bi = a->in[15][gp * 16 + h]; BbR[p * 16 + h] = cfr * br - cfi * bi; BbI[p * 16 + h] = cfr * bi + cfi * br; }
        }
        for (int i = tid; i < 1024; i += NTHREADS) { const size_t ci = ((size_t)j * 64 + g) * 1024 + i; CR[i] = a->in[16][ci]; CI[i] = a->in[17][ci]; }
        __syncthreads();
        for (int e = tid; e < 1024; e += NTHREADS) {
            const int tau = e >> 6, h = 4 * q4 + ((e >> 4) & 3), hp = e & 15; float acc = 0.f;
            for (int p = 0; p < 64; ++p) { const float cr = CR[h * 64 + p], ci = CI[h * 64 + p], ar = ApR[tau * 64 + p], ai = ApI[tau * 64 + p], br = BbR[p * 16 + hp], bi = BbI[p * 16 + hp];
                acc += (cr * ar - ci * ai) * br - (cr * ai + ci * ar) * bi; }
            Kt[e] = acc;
        }
        __syncthreads();
        bf16_t* mq = MQ + (size_t)g * 256 * 384;
        for (int e = tid; e < 64 * 192; e += NTHREADS) {
            const int rl = e / 192, k = (e - rl * 192) * 2, t = rl >> 2, hl = rl & 3, h = 4 * q4 + hl, n = t * 16 + h; float v[2];
#pragma unroll
            for (int q = 0; q < 2; ++q) { const int kk = k + q;
                if (kk < 256) { const int sidx = kk >> 4, hp = kk & 15; v[q] = (sidx <= t) ? Kt[(t - sidx) * 64 + hl * 16 + hp] : 0.f; }
                else if (kk < 320) { const int p = kk - 256; v[q] = CR[h * 64 + p] * ApR[(t + 1) * 64 + p] - CI[h * 64 + p] * ApI[(t + 1) * 64 + p]; }
                else { const int p = kk - 320; v[q] = -(CR[h * 64 + p] * ApI[(t + 1) * 64 + p] + CI[h * 64 + p] * ApR[(t + 1) * 64 + p]); } }
            *(unsigned*)(mq + (size_t)n * 384 + k) = cvt_pk_bf16(v[0], v[1]);
        }
        bf16_t* pp = P + (size_t)g * 128 * 256;
        for (int e = tid; e < 32 * 128; e += NTHREADS) {
            const int rl = e >> 7, k = (e & 127) * 2, im = rl >> 4, p = 16 * q4 + (rl & 15), r = im * 64 + p, sidx = k >> 4; float v[2];
            const float ar = ApR[(15 - sidx) * 64 + p], ai = ApI[(15 - sidx) * 64 + p];
#pragma unroll
            for (int q = 0; q < 2; ++q) { const int hp = (k + q) & 15; const float br = BbR[p * 16 + hp], bi = BbI[p * 16 + hp]; v[q] = im ? (ar * bi + ai * br) : (ar * br - ai * bi); }
            *(unsigned*)(pp + (size_t)r * 256 + k) = cvt_pk_bf16(v[0], v[1]);
        }
        __syncthreads();
    }
}

__device__ void ssm_cscan_phase(int j, const float* PU, bf16_t* U2) {
    CArgs a = get_args();
    const int tid = opaque_tid(), wave = tid >> 6, lane = tid & 63;
    if (wave >= 4) return;
    for (int item = blockIdx.x * 4 + wave; item < NB * 64; item += gridDim.x * 4) {
        const int b = item >> 6, g = item & 63, p = lane;
        const f32x4 dv = *(const f32x4*)((const float*)(a->ws + WS_DISC) + (((size_t)j * 64 + g) * 64 + p) * 8 + 4);
        const float a16r = dv[0], a16i = dv[1];
        float sr = 0.f, si = 0.f;
        const float* pu = PU + ((size_t)g * 2048 + b * 128) * 128 + p;
        bf16_t* uo = U2 + ((size_t)g * 2048 + b * 128) * 384 + 256 + p;
        for (int c0 = 0; c0 < 128; c0 += 32) {
            float lr[32], li[32];
#pragma unroll
            for (int q = 0; q < 32; ++q) { lr[q] = pu[(size_t)(c0 + q) * 128]; li[q] = pu[(size_t)(c0 + q) * 128 + 64]; }
#pragma unroll
            for (int q = 0; q < 32; ++q) {
                uo[(size_t)(c0 + q) * 384] = (bf16_t)(cvt_pk_bf16(sr, 0.f) & 0xffffu); uo[(size_t)(c0 + q) * 384 + 64] = (bf16_t)(cvt_pk_bf16(si, 0.f) & 0xffffu);
                const float nr = a16r * sr - a16i * si + lr[q], ni = a16r * si + a16i * sr + li[q]; sr = nr; si = ni;
            }
        }
    }
}

struct EpiPU {
    static constexpr bool PERM = false, LDSPART = false;
    __device__ __forceinline__ bool lds_part() const { return false; }
    float* PU;
    __device__ __forceinline__ void operator()(const f32x4 (&acc)[2][2][4][2], const Unit& u, int wr, int wc, int fr, int fq, const LAS unsigned char* lp) const {
        { const int ln_ = opaque_tid() & 63; fr = ln_ & 15; fq = ln_ >> 4; }
        const int row0 = u.pm * 256 + wr * 64 + fr, col0 = wc * 32 + 4 * fq;
#pragma unroll
        for (int ai = 0; ai < 2; ++ai)
#pragma unroll
            for (int m = 0; m < 4; ++m)
#pragma unroll
                for (int n = 0; n < 2; ++n) *(f32x4*)(PU + (size_t)(row0 + ai * 128 + m * 16) * 128 + col0 + n * 16) = acc[ai][0][m][n];
    }
};
struct EpiY {
    static constexpr bool PERM = true, LDSPART = false;
    __device__ __forceinline__ bool lds_part() const { return false; }
    const bf16_t* U2; bf16_t* Z; const float* dsk;
    __device__ __forceinline__ void operator()(const f32x4 (&acc)[2][2][4][2], const Unit& u, int wr, int wc, int fr, int fq, const LAS unsigned char* lp) const {
        { const int ln_ = opaque_tid() & 63; fr = ln_ & 15; fq = ln_ >> 4; }
        const int g = u.pm >> 3, rg0 = (u.pm & 7) * 256 + wr * 64 + fr, h0 = 8 * (fq & 1), tq = 2 * wc + (fq >> 1);
        const f32x4 d0 = *(const f32x4*)(dsk + g * 16 + h0), d1 = *(const f32x4*)(dsk + g * 16 + h0 + 4);
#pragma unroll
        for (int gp = 0; gp < 4; ++gp) {
            const int ai = gp >> 1;
            u32x4 uw[2][2];
#pragma unroll
            for (int mm = 0; mm < 2; ++mm)
#pragma unroll
                for (int bj = 0; bj < 2; ++bj) uw[mm][bj] = *(const u32x4*)(U2 + ((size_t)g * 2048 + rg0 + ai * 128 + ((gp & 1) * 2 + mm) * 16) * 384 + 16 * (8 * bj + tq) + h0);
#pragma unroll
            for (int mm = 0; mm < 2; ++mm) {
                const int m = (gp & 1) * 2 + mm;
                const int rg = rg0 + ai * 128 + m * 16, b = rg >> 7, cc = rg & 127;
                bf16_t* zrow = Z + (size_t)(b * SEQ + 16 * cc) * DM + g * 16 + h0;
#pragma unroll
                for (int bj = 0; bj < 2; ++bj) {
                    const u32x4 uv = uw[mm][bj];
                    const f32x4 y0 = acc[ai][bj][m][0], y1 = acc[ai][bj][m][1];
                    u32x4 w;
                    w.x = cvt_pk_bf16(gelu_tanh(y0[0] + d0[0] * bf_lo(uv.x)), gelu_tanh(y0[1] + d0[1] * bf_hi(uv.x)));
                    w.y = cvt_pk_bf16(gelu_tanh(y0[2] + d0[2] * bf_lo(uv.y)), gelu_tanh(y0[3] + d0[3] * bf_hi(uv.y)));
                    w.z = cvt_pk_bf16(gelu_tanh(y1[0] + d1[0] * bf_lo(uv.z)), gelu_tanh(y1[1] + d1[1] * bf_hi(uv.z)));
                    w.w = cvt_pk_bf16(gelu_tanh(y1[2] + d1[2] * bf_lo(uv.w)), gelu_tanh(y1[3] + d1[3] * bf_hi(uv.w)));
                    *(u32x4*)(zrow + (size_t)(8 * bj + tq) * DM) = w;
                }
            }
            asm volatile("" ::: "memory");
        }
    }
};

__device__ void attn_phase(const bf16_t* Q, const bf16_t* Kall, const bf16_t* VT, bf16_t* O, int layer, LAS unsigned char* lds) {
    const int tid0 = opaque_tid(), wave = __builtin_amdgcn_readfirstlane(tid0 >> 6);
    for (int unit = blockIdx.x; unit < NB * 4 * 8; unit += gridDim.x) {
        int lane = tid0 & 63; asm volatile("" : "+v"(lane));
        const int r = lane & 31, h = lane >> 5;
#define ATT_VOFF() int ln_ = tid0 & 63; asm volatile("" : "+v"(ln_)); const int rb = 2 * wave + (ln_ >> 5), cc0 = (ln_ & 31) ^ rb; \
        const unsigned voff_e = (unsigned)(rb * 4096 + cc0 * 8) * 2u, voff_o = (unsigned)(rb * 4096 + (cc0 ^ 16) * 8) * 2u
        const int b = unit >> 5, hd = (unit >> 3) & 3, qt = unit & 7;
        const int t0 = b * SEQ + qt * 256 + wave * 32;
        const bf16_t* qp = Q + (size_t)(t0 + r) * DM + hd * 256 + 8 * h;
        bf16x8 qf[16];
#pragma unroll
        for (int kk = 0; kk < 16; ++kk) qf[kk] = *(const bf16x8*)(qp + 16 * kk);
        __syncthreads();
        {
            ATT_VOFF();
            const char* kb = (const char*)(Kall + (size_t)(b * MEML) * 4096 + layer * 1024 + hd * 256);
#pragma unroll
            for (int it = 0; it < 16; ++it)
                __builtin_amdgcn_global_load_lds((const unsigned*)(kb + (size_t)it * 16 * 4096 * 2 + ((it & 1) ? voff_o : voff_e)), (LAS unsigned*)(lds + (it * 8 + wave) * 1024), 16, 0, 0);
        }
        asm volatile("s_waitcnt vmcnt(0)" ::: "memory");
        __syncthreads();
        bf16x8 pf[8][2]; float mh[4], mrun = -3.0e38f, drun = 0.f;
#pragma unroll
        for (int hf = 0; hf < 4; ++hf) {
            int r = lane & 31, h = lane >> 5; asm volatile("" : "+v"(r), "+v"(h));
            f32x16 s[2];
#pragma unroll
            for (int k4 = 0; k4 < 2; ++k4) {
                const int kt = hf * 2 + k4;
                f32x16 acc;
#pragma unroll
                for (int e = 0; e < 16; ++e) acc[e] = 0.f;
#pragma unroll
                for (int k8 = 0; k8 < 4; ++k8) {
                    bf16x8 af[4];
#pragma unroll
                    for (int i = 0; i < 4; ++i) af[i] = *(const LAS bf16x8*)(lds + (32 * kt + r) * 512 + (((2 * (4 * k8 + i) + h) ^ r) << 4));
                    __builtin_amdgcn_sched_group_barrier(0x100, 4, 0);
                    __builtin_amdgcn_sched_group_barrier(0x008, 4, 0);
#pragma unroll
                    for (int i = 0; i < 4; ++i) acc = __builtin_amdgcn_mfma_f32_32x32x16_bf16(af[i], qf[4 * k8 + i], acc, 0, 0, 0);
                }
                s[k4] = acc;
            }
            float mx = -3.0e38f;
#pragma unroll
            for (int k4 = 0; k4 < 2; ++k4)
#pragma unroll
                for (int e = 0; e < 16; ++e) mx = fmaxf(mx, s[k4][e]);
            mx = fmaxf(mx, shx(mx, 32));
            float sum = 0.f;
#pragma unroll
            for (int k4 = 0; k4 < 2; ++k4)
#pragma unroll
                for (int e = 0; e < 16; ++e) { const float pv = __builtin_amdgcn_exp2f(s[k4][e] - mx); s[k4][e] = pv; sum += pv; }
            sum += shx(sum, 32);
            { const float mnew = fmaxf(mrun, mx); drun = drun * __builtin_amdgcn_exp2f(mrun - mnew) + sum * __builtin_amdgcn_exp2f(mx - mnew); mrun = mnew; mh[hf] = mx; }
#pragma unroll
            for (int k4 = 0; k4 < 2; ++k4)
#pragma unroll
                for (int s2 = 0; s2 < 2; ++s2) {
                    u32x4 w;
                    w.x = cvt_pk_bf16(s[k4][8 * s2 + 0], s[k4][8 * s2 + 1]); w.y = cvt_pk_bf16(s[k4][8 * s2 + 2], s[k4][8 * s2 + 3]);
                    w.z = cvt_pk_bf16(s[k4][8 * s2 + 4], s[k4][8 * s2 + 5]); w.w = cvt_pk_bf16(s[k4][8 * s2 + 6], s[k4][8 * s2 + 7]);
                    pf[hf * 2 + k4][s2] = __builtin_bit_cast(bf16x8, w);
                }
        }
        asm volatile("s_waitcnt lgkmcnt(0)" ::: "memory");
        __syncthreads();
        {
            ATT_VOFF();
            const char* vb = (const char*)(VT + (size_t)(layer * 1024 + hd * 256) * 4096 + b * MEML);
#pragma unroll
            for (int it = 0; it < 16; ++it)
                __builtin_amdgcn_global_load_lds((const unsigned*)(vb + (size_t)it * 16 * 4096 * 2 + ((it & 1) ? voff_o : voff_e)), (LAS unsigned*)(lds + (it * 8 + wave) * 1024), 16, 0, 0);
        }
        float fq[4];
        const float inv = 1.0f / drun;
#pragma unroll
        for (int q = 0; q < 4; ++q) fq[q] = __builtin_amdgcn_exp2f(mh[q] - mrun) * inv;
        asm volatile("s_waitcnt vmcnt(0)" ::: "memory");
        __syncthreads();
        bf16_t* op = O + (size_t)(t0 + r) * DM + hd * 256 + 4 * h;
        int rv = lane & 31, hv = lane >> 5; asm volatile("" : "+v"(rv), "+v"(hv));
#pragma unroll
        for (int dt = 0; dt < 8; ++dt) {
            f32x16 ac[4];
#pragma unroll
            for (int q = 0; q < 4; ++q)
#pragma unroll
                for (int e = 0; e < 16; ++e) ac[q][e] = 0.f;
            const LAS unsigned char* rowp = lds + (32 * dt + rv) * 512 + 8 * hv;
#pragma unroll
            for (int kt = 0; kt < 8; ++kt) {
                u32x4 vf[2];
#pragma unroll
                for (int s2 = 0; s2 < 2; ++s2) {
                    const u32x2 lo = *(const LAS u32x2*)(rowp + (((4 * kt + 2 * s2) ^ rv) << 4)), hi = *(const LAS u32x2*)(rowp + (((4 * kt + 2 * s2 + 1) ^ rv) << 4));
                    vf[s2].x = lo.x; vf[s2].y = lo.y; vf[s2].z = hi.x; vf[s2].w = hi.y;
                }
                __builtin_amdgcn_sched_group_barrier(0x100, 4, 0);
                __builtin_amdgcn_sched_group_barrier(0x008, 2, 0);
#pragma unroll
                for (int s2 = 0; s2 < 2; ++s2) ac[kt >> 1] = __builtin_amdgcn_mfma_f32_32x32x16_bf16(__builtin_bit_cast(bf16x8, vf[s2]), pf[kt][s2], ac[kt >> 1], 0, 0, 0);
            }
#pragma unroll
            for (int g4 = 0; g4 < 4; ++g4) {
                float o[4];
#pragma unroll
                for (int e = 0; e < 4; ++e) o[e] = (ac[0][4 * g4 + e] * fq[0] + ac[1][4 * g4 + e] * fq[1]) + (ac[2][4 * g4 + e] * fq[2] + ac[3][4 * g4 + e] * fq[3]);
                u32x2 w; w.x = cvt_pk_bf16(o[0], o[1]); w.y = cvt_pk_bf16(o[2], o[3]);
                *(u32x2*)(op + dt * 32 + 8 * g4) = w;
            }
        }
        asm volatile("s_waitcnt lgkmcnt(0)" ::: "memory");
    }
    __syncthreads();
}

__device__ void final_norm_phase(const bf16_t* xb, float* out, const float* g) {
    const int tid0 = opaque_tid(), lane = tid0 & 63, gw = blockIdx.x * 8 + (tid0 >> 6), nw = gridDim.x * 8;
    f32x4 gg[4];
#pragma unroll
    for (int i = 0; i < 4; ++i) gg[i] = *(const f32x4*)(g + i * 256 + lane * 4);
    for (int row = gw; row < T_TOK; row += 2 * nw) {
        u32x2 b2[2][4];
#pragma unroll
        for (int rr = 0; rr < 2; ++rr)
#pragma unroll
            for (int i = 0; i < 4; ++i) b2[rr][i] = *(const u32x2*)(xb + (size_t)(row + rr * nw) * DM + i * 256 + lane * 4);
#pragma unroll
        for (int rr = 0; rr < 2; ++rr) {
            f32x4 v[4]; float ss = 0.f;
#pragma unroll
            for (int i = 0; i < 4; ++i) {
                v[i][0] = bf_lo(b2[rr][i].x); v[i][1] = bf_hi(b2[rr][i].x); v[i][2] = bf_lo(b2[rr][i].y); v[i][3] = bf_hi(b2[rr][i].y);
                ss += (v[i][0] * v[i][0] + v[i][1] * v[i][1]) + (v[i][2] * v[i][2] + v[i][3] * v[i][3]);
            }
#pragma unroll
            for (int o = 32; o >= 1; o >>= 1) ss += shx(ss, o);
            const float rs = 1.0f / sqrtf(ss * (1.0f / 1024.0f) + NORM_EPS);
#pragma unroll
            for (int i = 0; i < 4; ++i) *(f32x4*)(out + (size_t)(row + rr * nw) * DM + i * 256 + lane * 4) = v[i] * rs * gg[i];
        }
    }
}

__global__ void __launch_bounds__(NTHREADS, 2) mega_fwd(Args a_unused) {
    extern __shared__ __attribute__((aligned(16))) unsigned char lds_raw[];
    LAS unsigned char* lds = (LAS unsigned char*)lds_raw;
    cg::grid_group grid = cg::this_grid();
    const int G = gridDim.x, c = blockIdx.x;
#define WSP(off) (get_args()->ws + (off))
#define XB_ ((bf16_t*)WSP(WS_XB))
#define HB_ ((bf16_t*)WSP(WS_HB))
#define HB2_ ((bf16_t*)WSP(WS_HB + (size_t)T_TOK * DM * 2))
#define PART_ ((float*)WSP(WS_PART))
#define OUT_ (get_args()->out)

    { unsigned* bar0 = (unsigned*)WSP(WS_BAR); if (blockIdx.x == 0 && threadIdx.x < 65) __hip_atomic_store(bar0 + 64 * threadIdx.x, 0u, __ATOMIC_RELAXED, __HIP_MEMORY_SCOPE_AGENT); }
    unsigned bar_k = 0;
#define GRID_BAR() do { bar_k += 1u; grid_barrier((unsigned*)WSP(WS_BAR), bar_k, 32u, (unsigned)G / 32u); } while (0)
    prep_phase(lds);
    grid.sync();
    {
        pg8::StaticOrder S; S.init(4096, 4096, G, c);
        { pg8::Gemm g = pg8::mk_gemm((const bf16_t*)WSP(WS_MEMB), (const bf16_t*)WSP(WS_K), DM); EpiBf16S E{(bf16_t*)WSP(WS_KALL), 4096, nullptr, 0, 1.0f}; pg8::gemm_phase(lds, g, S, E); }
        { pg8::Gemm g = pg8::mk_gemm((const bf16_t*)WSP(WS_VT), (const bf16_t*)WSP(WS_MEMB), DM); EpiBf16S E{(bf16_t*)WSP(WS_VTALL), 4096, nullptr, 0, 1.0f}; pg8::gemm_phase(lds, g, S, E); }
    }
#pragma unroll 1
    for (int l = 0; l < NLAYER; ++l) {
#pragma unroll 1
        for (int pass = 0; pass < 2; ++pass) {
            {
                pg8::StaticOrder S; S.init(T_TOK, 2 * DFF, G, c);
                pg8::Gemm g = pg8::mk_gemm(XB_, (const bf16_t*)WSP((pass ? WS_UP2 : WS_UP1) + l * SZ_UP), DM);
                EpiSwiglu E{HB_, PART_, 16}; pg8::gemm_phase(lds, g, S, E);
            }
            GRID_BAR();
            {
                pg8::StaticOrder S; S.init(T_TOK, DM, G, c);
                pg8::Gemm g = pg8::mk_gemm(HB_, (const bf16_t*)WSP((pass ? WS_DN2 : WS_DN1) + l * SZ_DN), DFF);
                EpiResid E{(l == 0 && pass == 0) ? get_args()->in[0] : (const float*)nullptr, XB_, PART_, 0.5f}; pg8::gemm_phase(lds, g, S, E);
            }
            GRID_BAR();
            if (pass == 0) {
                const int j = l >> 1; int np_q;
                if ((l & 1) == 0) {
                    {
                        pg8::StaticOrder S; S.init(T_TOK, 3 * DM, G, c);
                        pg8::Gemm g = pg8::mk_gemm(XB_, (const bf16_t*)WSP(WS_CIN + j * 3 * SZ_SQ), DM);
                        EpiConvIn E{HB_, HB2_, PART_, 16}; pg8::gemm_phase(lds, g, S, E);
                    }
                    GRID_BAR();
                    conv_phase(HB_, HB2_, get_args()->in[9] + (size_t)j * 3 * DM);
                    GRID_BAR();
                    {
                        pg8::StaticOrder S; S.init(T_TOK, DM, G, c);
                        pg8::Gemm g = pg8::mk_gemm(HB2_, (const bf16_t*)WSP(WS_COUT + j * SZ_SQ), DM);
                        EpiResid E{nullptr, XB_, PART_, 1.0f}; pg8::gemm_phase(lds, g, S, E);
                    }
                    GRID_BAR();
                    np_q = 16;
                } else {
#define U2_ HB_
#define PU_ ((float*)WSP(WS_HB + SSM_PU_OFF))
#define Z_ ((bf16_t*)WSP(WS_HB + SSM_PU_OFF))
#define MQ_ ((bf16_t*)WSP(WS_HB + SSM_MQ_OFF))
#define PM_ ((bf16_t*)WSP(WS_HB + SSM_P_OFF))
                    ssm_uprep_phase(XB_, PART_, get_args()->in[2] + (size_t)(l * 5 + 1) * DM, U2_);
                    ssm_build_phase(j, MQ_, PM_, lds);
                    GRID_BAR();
                    {
                        pg8::GroupOrder S{G, c};
                        pg8::Gemm g{U2_, PM_, 256, 384, (size_t)128 * 256 * 2};
                        EpiPU E{PU_}; pg8::gemm_phase(lds, g, S, E);
                    }
                    GRID_BAR();
                    ssm_cscan_phase(j, PU_, U2_);
                    GRID_BAR();
                    {
                        pg8::GroupOrder S{G, c};
                        pg8::Gemm g{U2_, MQ_, 384, 384, (size_t)256 * 384 * 2};
                        EpiY E{U2_, Z_, get_args()->in[18] + (size_t)j * DM}; pg8::gemm_phase(lds, g, S, E);
                    }
                    GRID_BAR();
                    {
                        pg8::StaticOrder S; S.init(T_TOK, 2 * DM, G, c);
                        pg8::Gemm g = pg8::mk_gemm(Z_, (const bf16_t*)WSP(WS_GLU + j * 2 * SZ_SQ), DM);
                        EpiGlu E{XB_, PART_}; pg8::gemm_phase(lds, g, S, E);
                    }
                    GRID_BAR();
                    np_q = 32;
                }
                {
                    pg8::StaticOrder S; S.init(T_TOK, DM, G, c);
                    pg8::Gemm g = pg8::mk_gemm(XB_, (const bf16_t*)WSP(WS_Q + l * SZ_SQ), DM);
                    EpiBf16S E{HB_, DM, PART_, np_q, 0.0625f * 1.44269504089f}; pg8::gemm_phase(lds, g, S, E);
                }
                GRID_BAR();
                attn_phase(HB_, (const bf16_t*)WSP(WS_KALL), (const bf16_t*)WSP(WS_VTALL), HB2_, l, lds);
                GRID_BAR();
                {
                    pg8::StaticOrder S; S.init(T_TOK, DM, G, c);
                    pg8::Gemm g = pg8::mk_gemm(HB2_, (const bf16_t*)WSP(WS_O + l * SZ_SQ), DM);
                    EpiResid E{nullptr, XB_, PART_, 1.0f}; pg8::gemm_phase(lds, g, S, E);
                }
                GRID_BAR();
            }
        }
    }
    final_norm_phase(XB_, OUT_, get_args()->in[3]);
}

extern "C" void kernel_launch(void* const* d_in, const int* in_sizes, int n_in, void* d_out, int out_size, void* d_ws, size_t ws_size, hipStream_t stream) {
    static int grid_blocks = 0;
    if (grid_blocks == 0) {
        if (n_in != 23 || out_size != T_TOK * DM || ws_size < WS_END) { fprintf(stderr, "kernel_launch: unexpected shapes (n_in %d out %d ws %zu need %zu)\n", n_in, out_size, ws_size, (size_t)WS_END); grid_blocks = -1; return; }
        int dev = 0, cus = 0, per_cu = 0;
        hipGetDevice(&dev);
        hipDeviceGetAttribute(&cus, hipDeviceAttributeMultiprocessorCount, dev);
        if (hipFuncSetAttribute((const void*)mega_fwd, hipFuncAttributeMaxDynamicSharedMemorySize, LDS_BYTES) != hipSuccess) { fprintf(stderr, "kernel_launch: hipFuncSetAttribute failed\n"); grid_blocks = -1; return; }
        if (hipOccupancyMaxActiveBlocksPerMultiprocessor(&per_cu, (const void*)mega_fwd, NTHREADS, LDS_BYTES) != hipSuccess || per_cu < 1) { fprintf(stderr, "kernel_launch: occupancy query gave %d\n", per_cu); per_cu = 1; }
        (void)hipGetLastError();
        grid_blocks = cus * 1;
    }
    if (grid_blocks < 0) return;
    Args a{};
    for (int i = 0; i < 23; ++i) a.in[i] = (const float*)d_in[i];
    a.out = (float*)d_out; a.ws = (unsigned char*)d_ws;
    void* args[] = {&a};
    hipError_t e = hipLaunchCooperativeKernel((const void*)mega_fwd, dim3(grid_blocks), dim3(NTHREADS), args, LDS_BYTES, stream);
    if (e != hipSuccess) fprintf(stderr, "cooperative launch failed: %s (grid %d)\n", hipGetErrorString(e), grid_blocks);
}
```

```cpp
#include <hip/hip_runtime.h>
#include <hip/hip_cooperative_groups.h>
#include <cstdio>
namespace cg = cooperative_groups;

#define LAS __attribute__((address_space(3)))
typedef unsigned short bf16_t;
typedef short bf16x8 __attribute__((ext_vector_type(8)));
typedef float f32x4 __attribute__((ext_vector_type(4)));
typedef float f32x16 __attribute__((ext_vector_type(16)));
typedef unsigned u32x4 __attribute__((ext_vector_type(4)));
typedef unsigned u32x2 __attribute__((ext_vector_type(2)));

constexpr int T_TOK = 32768, DM = 1024, DFF = 2816, SEQ = 2048, NB = 16, MEML = 256, NLAYER = 4;
constexpr int NTHREADS = 512;
constexpr int LDS_BYTES = 131072 + 32768;
constexpr float NORM_EPS = 1e-6f;

constexpr size_t SZ_UP = (size_t)2 * DFF * DM * 2, SZ_DN = (size_t)DM * DFF * 2, SZ_SQ = (size_t)DM * DM * 2;
constexpr size_t WS_UP1 = 0;
constexpr size_t WS_DN1 = WS_UP1 + 4 * SZ_UP;
constexpr size_t WS_UP2 = WS_DN1 + 4 * SZ_DN;
constexpr size_t WS_DN2 = WS_UP2 + 4 * SZ_UP;
constexpr size_t WS_CIN = WS_DN2 + 4 * SZ_DN;
constexpr size_t WS_COUT = WS_CIN + 2 * 3 * SZ_SQ;
constexpr size_t WS_GLU = WS_COUT + 2 * SZ_SQ;
constexpr size_t WS_Q = WS_GLU + 2 * 2 * SZ_SQ;
constexpr size_t WS_K = WS_Q + 4 * SZ_SQ;
constexpr size_t WS_VT = WS_K + 4 * SZ_SQ;
constexpr size_t WS_O = WS_VT + 4 * SZ_SQ;
constexpr size_t WS_XB = WS_O + 4 * SZ_SQ;
constexpr size_t WS_HB = WS_XB + (size_t)T_TOK * DM * 2;
constexpr size_t WS_MEMB = WS_HB + (size_t)T_TOK * DFF * 2;
constexpr size_t WS_KALL = WS_MEMB + (size_t)4096 * DM * 2;
constexpr size_t WS_VTALL = WS_KALL + (size_t)4096 * 4096 * 2;
constexpr size_t WS_PART = WS_VTALL + (size_t)4096 * 4096 * 2;
constexpr size_t WS_DISC = WS_PART + (size_t)T_TOK * 32 * 4;
constexpr size_t WS_BAR = WS_DISC + (size_t)2 * 64 * 64 * 8 * 4;
constexpr size_t WS_END = WS_BAR + 256 * 33;

__device__ __forceinline__ unsigned cvt_pk_bf16(float lo, float hi) { unsigned r; asm volatile("v_cvt_pk_bf16_f32 %0, %1, %2" : "=v"(r) : "v"(lo), "v"(hi)); return r; }
__device__ __forceinline__ float bf_lo(unsigned w) { return __uint_as_float(w << 16); }
__device__ __forceinline__ float bf_hi(unsigned w) { return __uint_as_float(w & 0xffff0000u); }
__device__ __forceinline__ float fast_sigmoid(float x) { return __builtin_amdgcn_rcpf(1.0f + __builtin_amdgcn_exp2f(-1.44269504089f * x)); }
__device__ __forceinline__ float gelu_tanh(float x) { const float a = 1.5957691216f * (x + 0.044715f * x * x * x); return x * fast_sigmoid(a); }

__device__ __forceinline__ void grid_barrier(unsigned* bar, unsigned k, unsigned nsub, unsigned per_sub) {
    asm volatile("s_waitcnt vmcnt(0)" ::: "memory");
    __syncthreads();
    if (threadIdx.x == 0) {
        __builtin_amdgcn_fence(__ATOMIC_RELEASE, "agent");
        asm volatile("s_waitcnt vmcnt(0)" ::: "memory");
        const unsigned old = __hip_atomic_fetch_add(bar + 64 * (1 + (blockIdx.x % nsub)), 1u, __ATOMIC_RELAXED, __HIP_MEMORY_SCOPE_AGENT);
        if (old + 1u == k * per_sub) {
            const unsigned oldt = __hip_atomic_fetch_add(bar, 1u, __ATOMIC_RELAXED, __HIP_MEMORY_SCOPE_AGENT);
            if (oldt + 1u == k * nsub)
                for (unsigned i = 0; i < nsub; ++i) __hip_atomic_store(bar + 64 * (17 + i), k, __ATOMIC_RELAXED, __HIP_MEMORY_SCOPE_AGENT);
        }
        while (__hip_atomic_load(bar + 64 * (17 + (blockIdx.x % nsub)), __ATOMIC_RELAXED, __HIP_MEMORY_SCOPE_AGENT) < k) __builtin_amdgcn_s_sleep(1);
        __builtin_amdgcn_fence(__ATOMIC_ACQUIRE, "agent");
        asm volatile("s_waitcnt vmcnt(0)" ::: "memory");
    }
    __syncthreads();
}
__device__ __forceinline__ float shx(float v, int mask) {
    unsigned m = ~0u; asm volatile("" : "+s"(m));
    const int lane = __builtin_amdgcn_mbcnt_hi(m, __builtin_amdgcn_mbcnt_lo(m, 0));
    return __int_as_float(__builtin_amdgcn_ds_bpermute((lane ^ mask) << 2, __float_as_int(v)));
}
typedef unsigned u32x2s __attribute__((ext_vector_type(2)));
__device__ __forceinline__ float add_x16(float v) { const u32x2s a = __builtin_amdgcn_permlane16_swap(__float_as_uint(v), __float_as_uint(v), false, false); return __uint_as_float(a.x) + __uint_as_float(a.y); }
__device__ __forceinline__ float add_x32(float v) { const u32x2s a = __builtin_amdgcn_permlane32_swap(__float_as_uint(v), __float_as_uint(v), false, false); return __uint_as_float(a.x) + __uint_as_float(a.y); }
__device__ __forceinline__ float max_x32(float v) { const u32x2s a = __builtin_amdgcn_permlane32_swap(__float_as_uint(v), __float_as_uint(v), false, false); return fmaxf(__uint_as_float(a.x), __uint_as_float(a.y)); }
template <class T> __device__ __forceinline__ T* launder(T* p) { asm volatile("" : "+s"(p)); return p; }
__device__ __forceinline__ int opaque_tid() { int t = threadIdx.x; asm volatile("" : "+v"(t)); return t; }

namespace pg8 {
constexpr int BM = 256, BK = 64, HALF = 128, HTB = HALF * BK * 2, STAGE_BYTES = 8 * HTB, NXCD = 8, WGM = 4;
__host__ __device__ __forceinline__ int lds_byte(int r, int c) { const int st = (r >> 4) * 2 + (c >> 5), rr = r & 15, cc = c & 31, ob = rr * 64 + cc * 2; return st * 1024 + (ob ^ (((ob >> 9) & 1) << 5)); }
__host__ __device__ __forceinline__ void stage_rc(int b, int& R, int& C) { const int st = b / 1024, sb = b % 1024, swz = sb ^ (((sb >> 9) & 1) << 5); R = (st >> 1) * 16 + swz / 64; C = (st & 1) * 32 + (swz % 64) / 2; }
__host__ __device__ __forceinline__ int perm32(int rho) { const int n = rho >> 4, i = rho & 15; return 8 * (i >> 2) + 4 * n + (i & 3); }

struct Unit { int pm, pn; };
struct Gemm { const bf16_t* A; const bf16_t* Bt; int K, lda; size_t tstepB; };
__device__ __forceinline__ Gemm mk_gemm(const bf16_t* A, const bf16_t* Bt, int K) { return Gemm{A, Bt, K, K, (size_t)512 * K}; }

struct StaticOrder {
    int nM, nN, nwg, G, c;
    __device__ void init(int M, int N, int G_, int c_) { nM = M / BM; nN = N / BM; nwg = nM * nN; G = G_; c = c_; }
    __device__ bool next(int i, Unit& u) const {
        const long L = (long)i * G + c; if (L >= nwg) return false;
        int wgid = (int)L; { const int q = nwg / NXCD, r = nwg % NXCD, xcd = wgid % NXCD, off = wgid / NXCD; wgid = (xcd < r ? xcd * (q + 1) : r * (q + 1) + (xcd - r) * q) + off; }
        const int nig = WGM * nN, gid = wgid / nig, fm = gid * WGM, gsz = (nM - fm) < WGM ? (nM - fm) : WGM;
        u.pm = fm + ((wgid % nig) % gsz); u.pn = (wgid % nig) / gsz; return true;
    }
};

struct GroupOrder {
    int G, c;
    __device__ bool next(int i, Unit& u) const { const int L = i * G + c; if (L >= 512) return false; u.pm = L; u.pn = L >> 3; return true; }
};

template <class Epi, class Sched>
__device__ __forceinline__ void gemm_phase(LAS unsigned char* lds, const Gemm g, const Sched& S, const Epi& E) {
    const int tid = opaque_tid(), wid = __builtin_amdgcn_readfirstlane(tid >> 6), lane = tid & 63, wr = wid >> 2, wc = wid & 3, fr = lane & 15, fq = lane >> 4;
    const int K = g.K, nt = K / BK;
    unsigned voffA[2], voffB[2];
#pragma unroll
    for (int i = 0; i < 2; ++i) { int R, C; stage_rc(tid * 16 + i * 8192, R, C); const int Rb = Epi::PERM ? ((R & ~31) + perm32(R & 31)) : R;
        voffA[i] = (unsigned)(R * g.lda + C) * 2u; voffB[i] = (unsigned)(Rb * K + C) * 2u; }
    const size_t kstep = (size_t)(BK * 2);
    const size_t hstepA = (size_t)HALF * g.lda * 2, hstepB = (size_t)HALF * K * 2;
    const size_t tstepA = 2 * hstepA, tstepB = g.tstepB;
    const unsigned ldsw = (unsigned)wid * 1024u;
    const int aoff = lds_byte(wr * 64 + fr, fq * 8), boff = lds_byte(wc * 32 + fr, fq * 8);
#define PG8_SA(b, h) (((b) * 2 + (h)) * HTB)
#define PG8_SB(b, h) ((4 + (b) * 2 + (h)) * HTB)
#define PG8_STAGE(bufoff, gbase, voff) do { _Pragma("unroll") for (int _i = 0; _i < 2; ++_i) \
        __builtin_amdgcn_global_load_lds((const unsigned*)((const char*)(gbase) + (voff)[_i]), (LAS unsigned*)(lds + (bufoff) + ldsw + _i * 8192), 16, 0, 0); } while (0)
#define PG8_LDA(dst, b, h) do { _Pragma("unroll") for (int m = 0; m < 4; ++m) _Pragma("unroll") for (int k = 0; k < 2; ++k) dst[m][k] = *(const LAS bf16x8*)(lds + PG8_SA(b, h) + aoff + m * 2048 + k * 1024); } while (0)
#define PG8_LDB(dst, b, h) do { _Pragma("unroll") for (int n = 0; n < 2; ++n) _Pragma("unroll") for (int k = 0; k < 2; ++k) dst[n][k] = *(const LAS bf16x8*)(lds + PG8_SB(b, h) + boff + n * 2048 + k * 1024); } while (0)
#define PG8_MMA(ai, bj, At, Bt) do { __builtin_amdgcn_s_setprio(1); _Pragma("unroll") for (int m = 0; m < 4; ++m) _Pragma("unroll") for (int n = 0; n < 2; ++n) _Pragma("unroll") for (int k = 0; k < 2; ++k) \
        acc[ai][bj][m][n] = __builtin_amdgcn_mfma_f32_16x16x32_bf16(Bt[n][k], At[m][k], acc[ai][bj][m][n], 0, 0, 0); __builtin_amdgcn_s_setprio(0); } while (0)
#define PG8_WAIT_V(n) asm volatile("s_waitcnt vmcnt(" #n ")" ::: "memory")
#define PG8_WAIT_L(n) asm volatile("s_waitcnt lgkmcnt(" #n ")" ::: "memory")
#define PG8_BAR __builtin_amdgcn_s_barrier()
#define PG8_SCHED __builtin_amdgcn_sched_barrier(0)
    const bool lp = Epi::LDSPART && E.lds_part();
#define PG8_PART_DMA(unit, buf) do { if constexpr (Epi::LDSPART) { if (lp) { const char* ps_ = (const char*)E.part + ((size_t)(unit).pm * 256 + 32 * wid) * 128; const unsigned pv_ = (unsigned)((lane >> 2) * 128 + (lane & 3) * 16); \
        __builtin_amdgcn_global_load_lds((const unsigned*)(ps_ + pv_), (LAS unsigned*)(lds + STAGE_BYTES + (buf) * 16384 + (32 * wid) * 64), 16, 0, 0); \
        __builtin_amdgcn_global_load_lds((const unsigned*)(ps_ + 2048 + pv_), (LAS unsigned*)(lds + STAGE_BYTES + (buf) * 16384 + (32 * wid + 16) * 64), 16, 0, 0); } } } while (0)
    Unit cur, nxt; int ui = 0;
    if (!S.next(0, cur)) return;
    f32x4 acc[2][2][4][2];
#pragma unroll
    for (int a = 0; a < 2; ++a)
#pragma unroll
        for (int b = 0; b < 2; ++b)
#pragma unroll
            for (int m = 0; m < 4; ++m)
#pragma unroll
                for (int n = 0; n < 2; ++n) acc[a][b][m][n] = (f32x4){0.f, 0.f, 0.f, 0.f};
    bf16x8 At[4][2], B0[2][2], B1[2][2];
    const char* cA = (const char*)g.A + (size_t)cur.pm * tstepA; const char* cB = (const char*)g.Bt + (size_t)cur.pn * tstepB;
    PG8_PART_DMA(cur, 0);
    PG8_STAGE(PG8_SB(0, 0), cB, voffB); PG8_STAGE(PG8_SA(0, 0), cA, voffA); PG8_STAGE(PG8_SB(0, 1), cB + hstepB, voffB); PG8_STAGE(PG8_SA(0, 1), cA + hstepA, voffA);
    if (wr == 1) PG8_BAR;
    PG8_WAIT_V(4); PG8_BAR;
    PG8_STAGE(PG8_SB(1, 0), cB + kstep, voffB); PG8_STAGE(PG8_SA(1, 0), cA + kstep, voffA); PG8_STAGE(PG8_SB(1, 1), cB + hstepB + kstep, voffB);
    PG8_WAIT_V(6); PG8_BAR;
    for (;;) {
        const bool has_next = S.next(ui + 1, nxt);
        const char* nA = has_next ? (const char*)g.A + (size_t)nxt.pm * tstepA : cA; const char* nB = has_next ? (const char*)g.Bt + (size_t)nxt.pn * tstepB : cB;
        for (int t = 0; t < nt; t += 2) {
            const bool last = (t == nt - 2);
            const char* a1 = cA + (size_t)(t + 1) * kstep;
            const char* a2 = last ? nA : cA + (size_t)(t + 2) * kstep; const char* b2 = last ? nB : cB + (size_t)(t + 2) * kstep;
            const char* a3 = a2 + kstep; const char* b3 = b2 + kstep;
            PG8_LDB(B0, 0, 0); PG8_SCHED; PG8_LDA(At, 0, 0); PG8_STAGE(PG8_SA(1, 1), a1 + hstepA, voffA);
            PG8_WAIT_L(8); PG8_BAR; PG8_WAIT_L(0); PG8_MMA(0, 0, At, B0); PG8_BAR; PG8_SCHED;
            PG8_LDB(B1, 0, 1); PG8_STAGE(PG8_SB(0, 0), b2, voffB);
            PG8_BAR; PG8_WAIT_L(0); PG8_MMA(0, 1, At, B1); PG8_BAR;
            PG8_LDA(At, 0, 1); PG8_STAGE(PG8_SA(0, 0), a2, voffA);
            PG8_BAR; PG8_WAIT_L(0); PG8_MMA(1, 0, At, B0); PG8_BAR; PG8_SCHED;
            PG8_STAGE(PG8_SB(0, 1), b2 + hstepB, voffB);
            PG8_WAIT_V(6); PG8_BAR;
            if (last && has_next) PG8_PART_DMA(nxt, (ui + 1) & 1);
            PG8_MMA(1, 1, At, B1); PG8_BAR;
            PG8_LDB(B0, 1, 0); PG8_SCHED; PG8_LDA(At, 1, 0); PG8_STAGE(PG8_SA(0, 1), a2 + hstepA, voffA);
            PG8_WAIT_L(8); PG8_BAR; PG8_WAIT_L(0); PG8_MMA(0, 0, At, B0); PG8_BAR; PG8_SCHED;
            PG8_LDB(B1, 1, 1); PG8_STAGE(PG8_SB(1, 0), b3, voffB);
            PG8_BAR; PG8_WAIT_L(0); PG8_MMA(0, 1, At, B1); PG8_BAR;
            PG8_LDA(At, 1, 1); PG8_STAGE(PG8_SA(1, 0), a3, voffA);
            PG8_BAR; PG8_WAIT_L(0); PG8_MMA(1, 0, At, B0); PG8_BAR; PG8_SCHED;
            PG8_STAGE(PG8_SB(1, 1), b3 + hstepB, voffB);
            PG8_WAIT_V(6); PG8_BAR; PG8_MMA(1, 1, At, B1); PG8_BAR;
        }
        E(acc, cur, wr, wc, fr, fq, lp ? (const LAS unsigned char*)(lds + STAGE_BYTES + (ui & 1) * 16384) : (const LAS unsigned char*)nullptr);
        if (!has_next) break;
#pragma unroll
        for (int a = 0; a < 2; ++a)
#pragma unroll
            for (int b = 0; b < 2; ++b)
#pragma unroll
                for (int m = 0; m < 4; ++m)
#pragma unroll
                    for (int n = 0; n < 2; ++n) acc[a][b][m][n] = (f32x4){0.f, 0.f, 0.f, 0.f};
        cur = nxt; cA = nA; cB = nB; ++ui;
    }
    PG8_WAIT_V(0);
    if (wr == 0) PG8_BAR;
    PG8_BAR;
#undef PG8_PART_DMA
#undef PG8_SA
#undef PG8_SB
#undef PG8_STAGE
#undef PG8_LDA
#undef PG8_LDB
#undef PG8_MMA
#undef PG8_WAIT_V
#undef PG8_WAIT_L
#undef PG8_BAR
#undef PG8_SCHED
}
}
using pg8::Unit;

__device__ __forceinline__ void rows_rstd(const float* part, int row0, int np, int fq, float (&rs)[8]) {
#pragma unroll
    for (int hf = 0; hf < 2; ++hf) {
        f32x4 pa[4], pb[4];
#pragma unroll
        for (int g4 = 0; g4 < 4; ++g4) {
            const float* p = part + (size_t)(row0 + hf * 128 + g4 * 16) * 32;
            if (np == 16) { pa[g4] = *(const f32x4*)(p + 4 * fq); pb[g4] = (f32x4){0.f, 0.f, 0.f, 0.f}; }
            else { pa[g4] = *(const f32x4*)(p + 8 * fq); pb[g4] = *(const f32x4*)(p + 8 * fq + 4); }
        }
#pragma unroll
        for (int g4 = 0; g4 < 4; ++g4) {
            float sm = ((pa[g4][0] + pa[g4][1]) + (pa[g4][2] + pa[g4][3])) + ((pb[g4][0] + pb[g4][1]) + (pb[g4][2] + pb[g4][3]));
            sm = add_x16(sm); sm = add_x32(sm);
            rs[hf * 4 + g4] = __builtin_amdgcn_rsqf(sm * (1.0f / 1024.0f) + NORM_EPS);
        }
        if (np != 16) asm volatile("" ::: "memory");
    }
}

__device__ __forceinline__ void rows_rstd_lds(const LAS unsigned char* lp, int rl0, int fq, float (&rs)[8]) {
    f32x4 pa[8];
#pragma unroll
    for (int g = 0; g < 8; ++g) pa[g] = *(const LAS f32x4*)(lp + (rl0 + (g >> 2) * 128 + (g & 3) * 16) * 64 + fq * 16);
#pragma unroll
    for (int g = 0; g < 8; ++g) {
        float sm = (pa[g][0] + pa[g][1]) + (pa[g][2] + pa[g][3]);
        sm = add_x16(sm); sm = add_x32(sm);
        rs[g] = __builtin_amdgcn_rsqf(sm * (1.0f / 1024.0f) + NORM_EPS);
    }
}

struct EpiBf16S {
    static constexpr bool PERM = true, LDSPART = true;
    bf16_t* O; int ldc; const float* part; int np; float cscale;
    __device__ __forceinline__ bool lds_part() const { return part != nullptr && np == 16; }
    __device__ __forceinline__ void operator()(const f32x4 (&acc)[2][2][4][2], const Unit& u, int wr, int wc, int fr, int fq, const LAS unsigned char* lp) const {
        { const int ln_ = opaque_tid() & 63; fr = ln_ & 15; fq = ln_ >> 4; }
        const int row0 = u.pm * 256 + wr * 64 + fr, col0 = u.pn * 256 + wc * 32 + 8 * fq;
        float rs[8];
        if (lp) rows_rstd_lds(lp, wr * 64 + fr, fq, rs);
        else if (part) rows_rstd(part, row0, np, fq, rs);
        else {
#pragma unroll
            for (int g = 0; g < 8; ++g) rs[g] = 1.0f; }
#pragma unroll
        for (int ai = 0; ai < 2; ++ai)
#pragma unroll
            for (int m = 0; m < 4; ++m) {
                const int row = row0 + ai * 128 + m * 16;
                const float sc = cscale * rs[ai * 4 + m];
                bf16_t* rowp = O + (size_t)row * ldc + col0;
#pragma unroll
                for (int bj = 0; bj < 2; ++bj) { const f32x4 v0 = acc[ai][bj][m][0] * sc, v1 = acc[ai][bj][m][1] * sc;
                    u32x4 w; w.x = cvt_pk_bf16(v0[0], v0[1]); w.y = cvt_pk_bf16(v0[2], v0[3]); w.z = cvt_pk_bf16(v1[0], v1[1]); w.w = cvt_pk_bf16(v1[2], v1[3]);
                    *(u32x4*)(rowp + bj * 128) = w; }
            }
    }
};
struct EpiSwiglu {
    static constexpr bool PERM = true, LDSPART = true;
    bf16_t* H; const float* part; int np;
    __device__ __forceinline__ bool lds_part() const { return np == 16; }
    __device__ __forceinline__ void operator()(const f32x4 (&acc)[2][2][4][2], const Unit& u, int wr, int wc, int fr, int fq, const LAS unsigned char* lp) const {
        { const int ln_ = opaque_tid() & 63; fr = ln_ & 15; fq = ln_ >> 4; }
        const int row0 = u.pm * 256 + wr * 64 + fr, col0 = u.pn * 128 + wc * 32 + 8 * fq;
        float rsv[8]; if (lp) rows_rstd_lds(lp, wr * 64 + fr, fq, rsv); else rows_rstd(part, row0, np, fq, rsv);
#pragma unroll
        for (int ai = 0; ai < 2; ++ai)
#pragma unroll
            for (int m = 0; m < 4; ++m) {
                const int row = row0 + ai * 128 + m * 16;
                const float rs = rsv[ai * 4 + m], c1 = -1.44269504089f * rs, r2 = rs * rs;
                float o[8];
#pragma unroll
                for (int n = 0; n < 2; ++n) {
                    const f32x4 gv = acc[ai][0][m][n], uv = acc[ai][1][m][n];
                    const f32x4 ev = gv * c1, tv = (gv * uv) * r2;
#pragma unroll
                    for (int j = 0; j < 4; ++j) o[n * 4 + j] = tv[j] * __builtin_amdgcn_rcpf(1.0f + __builtin_amdgcn_exp2f(ev[j]));
                }
                u32x4 w; w.x = cvt_pk_bf16(o[0], o[1]); w.y = cvt_pk_bf16(o[2], o[3]); w.z = cvt_pk_bf16(o[4], o[5]); w.w = cvt_pk_bf16(o[6], o[7]);
                *(u32x4*)(H + (size_t)row * DFF + col0) = w;
            }
    }
};
struct EpiConvIn {
    static constexpr bool PERM = true, LDSPART = true;
    bf16_t* U; bf16_t* Bg; const float* part; int np;
    __device__ __forceinline__ bool lds_part() const { return np == 16; }
    __device__ __forceinline__ void operator()(const f32x4 (&acc)[2][2][4][2], const Unit& u, int wr, int wc, int fr, int fq, const LAS unsigned char* lp) const {
        { const int ln_ = opaque_tid() & 63; fr = ln_ & 15; fq = ln_ >> 4; }
        const int row0 = u.pm * 256 + wr * 64 + fr;
        float rsv[8]; if (lp) rows_rstd_lds(lp, wr * 64 + fr, fq, rsv); else rows_rstd(part, row0, np, fq, rsv);
#pragma unroll
        for (int ai = 0; ai < 2; ++ai)
#pragma unroll
            for (int m = 0; m < 4; ++m) {
                const int row = row0 + ai * 128 + m * 16;
                const float rs = rsv[ai * 4 + m];
                if (u.pn < 8) {
                    const float r2 = rs * rs; float o[8];
#pragma unroll
                    for (int n = 0; n < 2; ++n)
#pragma unroll
                        for (int j = 0; j < 4; ++j) o[n * 4 + j] = acc[ai][0][m][n][j] * acc[ai][1][m][n][j] * r2;
                    u32x4 w; w.x = cvt_pk_bf16(o[0], o[1]); w.y = cvt_pk_bf16(o[2], o[3]); w.z = cvt_pk_bf16(o[4], o[5]); w.w = cvt_pk_bf16(o[6], o[7]);
                    *(u32x4*)(U + (size_t)row * DM + u.pn * 128 + wc * 32 + 8 * fq) = w;
                } else {
#pragma unroll
                    for (int bj = 0; bj < 2; ++bj) { const f32x4 v0 = acc[ai][bj][m][0] * rs, v1 = acc[ai][bj][m][1] * rs;
                        u32x4 w; w.x = cvt_pk_bf16(v0[0], v0[1]); w.y = cvt_pk_bf16(v0[2], v0[3]); w.z = cvt_pk_bf16(v1[0], v1[1]); w.w = cvt_pk_bf16(v1[2], v1[3]);
                        *(u32x4*)(Bg + (size_t)row * DM + (u.pn - 8) * 256 + bj * 128 + wc * 32 + 8 * fq) = w; }
                }
            }
    }
};
struct EpiResid {
    static constexpr bool PERM = true, LDSPART = false;
    __device__ __forceinline__ bool lds_part() const { return false; }
    const float* xin; bf16_t* xb; float* part; float scale;
    __device__ __forceinline__ void operator()(const f32x4 (&acc)[2][2][4][2], const Unit& u, int wr, int wc, int fr, int fq, const LAS unsigned char* lp) const {
        { const int ln_ = opaque_tid() & 63; fr = ln_ & 15; fq = ln_ >> 4; }
        const int row0 = u.pm * 256 + wr * 64 + fr, col0 = u.pn * 256 + wc * 32 + 8 * fq;
        if (xin == nullptr) {
#pragma unroll
            for (int ai = 0; ai < 2; ++ai) {
                u32x4 rb[4][2];
#pragma unroll
                for (int m = 0; m < 4; ++m)
#pragma unroll
                    for (int bj = 0; bj < 2; ++bj) rb[m][bj] = *(const u32x4*)((const char*)xb + (unsigned)((row0 + ai * 128 + m * 16) * DM + col0 + bj * 128) * 2u);
#pragma unroll
                for (int m = 0; m < 4; ++m) {
                    const int row = row0 + ai * 128 + m * 16; float ss = 0.f;
#pragma unroll
                    for (int bj = 0; bj < 2; ++bj) {
                        const u32x4 b4 = rb[m][bj];
                        f32x4 v0, v1; v0[0] = bf_lo(b4.x); v0[1] = bf_hi(b4.x); v0[2] = bf_lo(b4.y); v0[3] = bf_hi(b4.y); v1[0] = bf_lo(b4.z); v1[1] = bf_hi(b4.z); v1[2] = bf_lo(b4.w); v1[3] = bf_hi(b4.w);
                        v0 = v0 + acc[ai][bj][m][0] * scale; v1 = v1 + acc[ai][bj][m][1] * scale;
                        u32x4 w; w.x = cvt_pk_bf16(v0[0], v0[1]); w.y = cvt_pk_bf16(v0[2], v0[3]); w.z = cvt_pk_bf16(v1[0], v1[1]); w.w = cvt_pk_bf16(v1[2], v1[3]);
                        *(u32x4*)((char*)xb + (unsigned)(row * DM + col0 + bj * 128) * 2u) = w;
                        ss += ((v0[0] * v0[0] + v0[1] * v0[1]) + (v0[2] * v0[2] + v0[3] * v0[3])) + ((v1[0] * v1[0] + v1[1] * v1[1]) + (v1[2] * v1[2] + v1[3] * v1[3]));
                    }
                    ss = add_x16(ss); ss = add_x32(ss);
                    if (fq == 0) part[(size_t)row * 32 + u.pn * 4 + wc] = ss;
                }
                asm volatile("" ::: "memory");
            }
        } else {
#pragma unroll
            for (int gp = 0; gp < 4; ++gp) {
                const int ai = gp >> 1;
                f32x4 rb[2][4];
#pragma unroll
                for (int mm = 0; mm < 2; ++mm)
#pragma unroll
                    for (int q = 0; q < 4; ++q) rb[mm][q] = *(const f32x4*)(xin + (size_t)(row0 + ai * 128 + ((gp & 1) * 2 + mm) * 16) * DM + col0 + (q >> 1) * 128 + (q & 1) * 4);
#pragma unroll
                for (int mm = 0; mm < 2; ++mm) {
                    const int m = (gp & 1) * 2 + mm, row = row0 + ai * 128 + m * 16; float ss = 0.f;
#pragma unroll
                    for (int bj = 0; bj < 2; ++bj) {
                        const f32x4 v0 = rb[mm][bj * 2 + 0] + acc[ai][bj][m][0] * scale, v1 = rb[mm][bj * 2 + 1] + acc[ai][bj][m][1] * scale;
                        u32x4 w; w.x = cvt_pk_bf16(v0[0], v0[1]); w.y = cvt_pk_bf16(v0[2], v0[3]); w.z = cvt_pk_bf16(v1[0], v1[1]); w.w = cvt_pk_bf16(v1[2], v1[3]);
                        *(u32x4*)((char*)xb + (unsigned)(row * DM + col0 + bj * 128) * 2u) = w;
                        ss += ((v0[0] * v0[0] + v0[1] * v0[1]) + (v0[2] * v0[2] + v0[3] * v0[3])) + ((v1[0] * v1[0] + v1[1] * v1[1]) + (v1[2] * v1[2] + v1[3] * v1[3]));
                    }
                    ss = add_x16(ss); ss = add_x32(ss);
                    if (fq == 0) part[(size_t)row * 32 + u.pn * 4 + wc] = ss;
                }
                asm volatile("" ::: "memory");
            }
        }
    }
};
struct EpiGlu {
    static constexpr bool PERM = true, LDSPART = false;
    __device__ __forceinline__ bool lds_part() const { return false; }
    bf16_t* xb; float* part;
    __device__ __forceinline__ void operator()(const f32x4 (&acc)[2][2][4][2], const Unit& u, int wr, int wc, int fr, int fq, const LAS unsigned char* lp) const {
        { const int ln_ = opaque_tid() & 63; fr = ln_ & 15; fq = ln_ >> 4; }
        const int row0 = u.pm * 256 + wr * 64 + fr, col0 = u.pn * 128 + wc * 32 + 8 * fq;
#pragma unroll
        for (int ai = 0; ai < 2; ++ai) {
            u32x4 rb[4];
#pragma unroll
            for (int m = 0; m < 4; ++m) rb[m] = *(const u32x4*)((const char*)xb + (unsigned)((row0 + ai * 128 + m * 16) * DM + col0) * 2u);
#pragma unroll
            for (int m = 0; m < 4; ++m) {
                const int row = row0 + ai * 128 + m * 16;
                const u32x4 b4 = rb[m];
                f32x4 v0, v1; v0[0] = bf_lo(b4.x); v0[1] = bf_hi(b4.x); v0[2] = bf_lo(b4.y); v0[3] = bf_hi(b4.y); v1[0] = bf_lo(b4.z); v1[1] = bf_hi(b4.z); v1[2] = bf_lo(b4.w); v1[3] = bf_hi(b4.w);
#pragma unroll
                for (int j = 0; j < 4; ++j) { v0[j] += acc[ai][0][m][0][j] * fast_sigmoid(acc[ai][1][m][0][j]); v1[j] += acc[ai][0][m][1][j] * fast_sigmoid(acc[ai][1][m][1][j]); }
                u32x4 w; w.x = cvt_pk_bf16(v0[0], v0[1]); w.y = cvt_pk_bf16(v0[2], v0[3]); w.z = cvt_pk_bf16(v1[0], v1[1]); w.w = cvt_pk_bf16(v1[2], v1[3]);
                *(u32x4*)((char*)xb + (unsigned)(row * DM + col0) * 2u) = w;
                float ss = ((v0[0] * v0[0] + v0[1] * v0[1]) + (v0[2] * v0[2] + v0[3] * v0[3])) + ((v1[0] * v1[0] + v1[1] * v1[1]) + (v1[2] * v1[2] + v1[3] * v1[3]));
                ss = add_x16(ss); ss = add_x32(ss);
                if (fq == 0) part[(size_t)row * 32 + u.pn * 4 + wc] = ss;
            }
            asm volatile("" ::: "memory");
        }
    }
};

__device__ __forceinline__ int srccol(int kind, int n0) {
    if (kind == 0) return n0;
    const int pn = n0 >> 8, r = n0 & 255, bj = r >> 7, rr = r & 127;
    if (kind == 1) return bj * DFF + 128 * pn + rr;
    if (kind == 2) return n0 < 2048 ? (bj ? 2048 : 0) + 128 * pn + rr : 1024 + (n0 - 2048);
    return bj * 1024 + 128 * pn + rr;
}
__device__ void transpose_job(LAS float* tile, const float* W, int Nsrc, int K, bf16_t* dst, int Ndst, int kind, const float* gain) {
    const int tid = opaque_tid();
    const int tilesK = K >> 7, ntile = tilesK * (Ndst >> 7);
    for (int t = blockIdx.x; t < ntile; t += gridDim.x) {
        const int tn = t / tilesK, tk = t - tn * tilesK, n0 = tn * 128, k0 = tk * 128;
        const int sc = srccol(kind, n0);
        const int c4 = (tid & 31) * 4, kr = tid >> 5;
        f32x4 v[8];
#pragma unroll
        for (int i = 0; i < 8; ++i) v[i] = *(const f32x4*)(W + (size_t)(k0 + kr + 16 * i) * Nsrc + sc + c4);
#pragma unroll
        for (int i = 0; i < 8; ++i) {
            const int k = kr + 16 * i; const float gk = gain ? gain[k0 + k] : 1.0f;
            tile[k * 129 + c4 + 0] = v[i][0] * gk; tile[k * 129 + c4 + 1] = v[i][1] * gk; tile[k * 129 + c4 + 2] = v[i][2] * gk; tile[k * 129 + c4 + 3] = v[i][3] * gk;
        }
        __syncthreads();
#pragma unroll
        for (int i = 0; i < 4; ++i) {
            const int q = tid + NTHREADS * i, n = q >> 4, kc = (q & 15) * 8;
            float f[8];
#pragma unroll
            for (int e = 0; e < 8; ++e) f[e] = tile[(kc + e) * 129 + n];
            u32x4 w; w.x = cvt_pk_bf16(f[0], f[1]); w.y = cvt_pk_bf16(f[2], f[3]); w.z = cvt_pk_bf16(f[4], f[5]); w.w = cvt_pk_bf16(f[6], f[7]);
            *(u32x4*)(dst + (size_t)(n0 + n) * K + k0 + kc) = w;
        }
        __syncthreads();
    }
}

struct Args { const float* in[23]; float* out; unsigned char* ws; };
typedef const __attribute__((address_space(4))) Args* CArgs;
__device__ __forceinline__ CArgs get_args() { CArgs p = (CArgs)__builtin_amdgcn_kernarg_segment_ptr(); asm volatile("" : "+s"(p)); return p; }

__device__ __forceinline__ void sincos_d(double th, double& s, double& c) {
    const double twopi = 6.283185307179586476925;
    const double k = rint(th / twopi); const double r = th - k * twopi;
    const double q = r * 0.125, q2 = q * q;
    double sq = q * (1.0 + q2 * (-1.0 / 6.0 + q2 * (1.0 / 120.0 + q2 * (-1.0 / 5040.0 + q2 * (1.0 / 362880.0 + q2 * (-1.0 / 39916800.0 + q2 * (1.0 / 6227020800.0)))))));
    double cq = 1.0 + q2 * (-0.5 + q2 * (1.0 / 24.0 + q2 * (-1.0 / 720.0 + q2 * (1.0 / 40320.0 + q2 * (-1.0 / 3628800.0 + q2 * (1.0 / 479001600.0 + q2 * (-1.0 / 87178291200.0)))))));
#pragma unroll
    for (int i = 0; i < 3; ++i) { const double s2 = 2.0 * sq * cq, c2 = cq * cq - sq * sq; sq = s2; cq = c2; }
    s = sq; c = cq;
}
__device__ __forceinline__ double exp_d(double x) {
    const double ln2 = 0.693147180559945309417;
    const double k = rint(x / ln2); const double r = x - k * ln2;
    double p = 1.0 + r * (1.0 + r * (0.5 + r * (1.0 / 6.0 + r * (1.0 / 24.0 + r * (1.0 / 120.0 + r * (1.0 / 720.0 + r * (1.0 / 5040.0 + r * (1.0 / 40320.0 + r * (1.0 / 362880.0 + r * (1.0 / 3628800.0 + r * (1.0 / 39916800.0 + r * (1.0 / 479001600.0))))))))))));
    return ldexp(p, (int)k);
}

__device__ __forceinline__ void ssm_disc(CArgs a, int j, int g, int p, double& abr, double& abi, double& cfr, double& cfi) {
    const size_t gp = ((size_t)j * 64 + g) * 64 + p;
    const double lre = fmin((double)a->in[11][gp], -1e-4), lim = (double)a->in[12][gp];
    const double dt = exp_d((double)a->in[13][j * 64 + g]);
    const double mag = exp_d(lre * dt); double sn, cs; sincos_d(lim * dt, sn, cs);
    abr = mag * cs; abi = mag * sn;
    const double den = lre * lre + lim * lim, nre = abr - 1.0, nim = abi;
    cfr = (nre * lre + nim * lim) / den; cfi = (nim * lre - nre * lim) / den;
}
__device__ void prep_phase(LAS unsigned char* lds) {
    LAS float* tile = (LAS float*)lds;
    CArgs ap = get_args();
    unsigned char* ws = ap->ws;
    const float* norm_g = ap->in[2];
    for (int l = 0; l < NLAYER; ++l) {
        const float* g = norm_g + (size_t)l * 5 * DM;
        transpose_job(tile, ap->in[4] + (size_t)l * DM * 2 * DFF, 2 * DFF, DM, (bf16_t*)(ws + WS_UP1 + l * SZ_UP), 2 * DFF, 1, g + 0 * DM);
        transpose_job(tile, ap->in[5] + (size_t)l * DFF * DM, DM, DFF, (bf16_t*)(ws + WS_DN1 + l * SZ_DN), DM, 0, nullptr);
        transpose_job(tile, ap->in[6] + (size_t)l * DM * 2 * DFF, 2 * DFF, DM, (bf16_t*)(ws + WS_UP2 + l * SZ_UP), 2 * DFF, 1, g + 4 * DM);
        transpose_job(tile, ap->in[7] + (size_t)l * DFF * DM, DM, DFF, (bf16_t*)(ws + WS_DN2 + l * SZ_DN), DM, 0, nullptr);
        transpose_job(tile, ap->in[20] + (size_t)l * DM * DM, DM, DM, (bf16_t*)(ws + WS_Q + l * SZ_SQ), DM, 0, g + 2 * DM);
        transpose_job(tile, ap->in[21] + (size_t)l * DM * 2 * DM, 2 * DM, DM, (bf16_t*)(ws + WS_K + l * SZ_SQ), DM, 0, g + 3 * DM);
        transpose_job(tile, ap->in[21] + (size_t)l * DM * 2 * DM + DM, 2 * DM, DM, (bf16_t*)(ws + WS_VT + l * SZ_SQ), DM, 0, g + 3 * DM);
        transpose_job(tile, ap->in[22] + (size_t)l * DM * DM, DM, DM, (bf16_t*)(ws + WS_O + l * SZ_SQ), DM, 0, nullptr);
        if ((l & 1) == 0) {
            const int j = l >> 1;
            transpose_job(tile, ap->in[8] + (size_t)j * DM * 3 * DM, 3 * DM, DM, (bf16_t*)(ws + WS_CIN + j * 3 * SZ_SQ), 3 * DM, 2, g + 1 * DM);
            transpose_job(tile, ap->in[10] + (size_t)j * DM * DM, DM, DM, (bf16_t*)(ws + WS_COUT + j * SZ_SQ), DM, 0, nullptr);
        } else {
            const int j = l >> 1;
            transpose_job(tile, ap->in[19] + (size_t)j * DM * 2 * DM, 2 * DM, DM, (bf16_t*)(ws + WS_GLU + j * 2 * SZ_SQ), 2 * DM, 3, nullptr);
        }
    }
    const int tid0 = opaque_tid(), lane = tid0 & 63, gw = blockIdx.x * 8 + (tid0 >> 6), nw = gridDim.x * 8;
    const float* x = ap->in[0]; bf16_t* xb = (bf16_t*)(ws + WS_XB); float* part = (float*)(ws + WS_PART);
    for (int row = gw; row < T_TOK; row += 2 * nw) {
        f32x4 v[2][4];
#pragma unroll
        for (int rr = 0; rr < 2; ++rr)
#pragma unroll
            for (int i = 0; i < 4; ++i) v[rr][i] = *(const f32x4*)(x + (size_t)(row + rr * nw) * DM + i * 256 + lane * 4);
#pragma unroll
        for (int rr = 0; rr < 2; ++rr) {
            float ss = 0.f;
#pragma unroll
            for (int i = 0; i < 4; ++i) {
                const f32x4 t = v[rr][i];
                u32x2 w; w.x = cvt_pk_bf16(t[0], t[1]); w.y = cvt_pk_bf16(t[2], t[3]);
                *(u32x2*)(xb + (size_t)(row + rr * nw) * DM + i * 256 + lane * 4) = w;
                ss += (t[0] * t[0] + t[1] * t[1]) + (t[2] * t[2] + t[3] * t[3]);
            }
#pragma unroll
            for (int o = 32; o >= 1; o >>= 1) ss += shx(ss, o);
            if (lane < 16) part[(size_t)(row + rr * nw) * 32 + lane] = lane == 0 ? ss : 0.f;
        }
    }
    const float* mem = ap->in[1]; bf16_t* memb = (bf16_t*)(ws + WS_MEMB);
    for (int row = gw; row < NB * MEML; row += nw) {
        f32x4 v[4]; float ss = 0.f;
#pragma unroll
        for (int i = 0; i < 4; ++i) { v[i] = *(const f32x4*)(mem + (size_t)row * DM + i * 256 + lane * 4); ss += (v[i][0] * v[i][0] + v[i][1] * v[i][1]) + (v[i][2] * v[i][2] + v[i][3] * v[i][3]); }
#pragma unroll
        for (int o = 32; o >= 1; o >>= 1) ss += shx(ss, o);
        const float rs = __builtin_amdgcn_rsqf(ss * (1.0f / 1024.0f) + NORM_EPS);
#pragma unroll
        for (int i = 0; i < 4; ++i) { u32x2 w; w.x = cvt_pk_bf16(v[i][0] * rs, v[i][1] * rs); w.y = cvt_pk_bf16(v[i][2] * rs, v[i][3] * rs);
            *(u32x2*)(memb + (size_t)row * DM + i * 256 + lane * 4) = w; }
    }
    float* disc = (float*)(ws + WS_DISC);
    for (int idx = blockIdx.x * NTHREADS + tid0; idx < 2 * 64 * 64; idx += gridDim.x * NTHREADS) {
        double abr, abi, cfr, cfi; ssm_disc(ap, idx >> 12, (idx >> 6) & 63, idx & 63, abr, abi, cfr, cfi);
        double pr = abr, pi = abi;
#pragma unroll
        for (int q = 0; q < 4; ++q) { const double nr = pr * pr - pi * pi, ni = 2.0 * pr * pi; pr = nr; pi = ni; }
        f32x4 v0, v1; v0[0] = (float)abr; v0[1] = (float)abi; v0[2] = (float)cfr; v0[3] = (float)cfi; v1[0] = (float)pr; v1[1] = (float)pi; v1[2] = 0.f; v1[3] = 0.f;
        *(f32x4*)(disc + (size_t)idx * 8) = v0; *(f32x4*)(disc + (size_t)idx * 8 + 4) = v1;
    }
}

__device__ void conv_phase(const bf16_t* U, bf16_t* Bg, const float* cw) {
    const size_t total = (size_t)T_TOK * 128;
    for (size_t idx = (size_t)blockIdx.x * NTHREADS + opaque_tid(); idx < total; idx += (size_t)gridDim.x * NTHREADS) {
        const int t = (int)(idx >> 7), c8 = (int)(idx & 127) * 8, pos = t & (SEQ - 1);
        const size_t off = (size_t)t * DM + c8;
        const u32x4 u0 = *(const u32x4*)(U + off);
        u32x4 u1 = (u32x4){0u, 0u, 0u, 0u}, u2 = (u32x4){0u, 0u, 0u, 0u};
        if (pos >= 1) u1 = *(const u32x4*)(U + off - DM);
        if (pos >= 2) u2 = *(const u32x4*)(U + off - 2 * DM);
        const u32x4 bb = *(const u32x4*)(Bg + off);
        float o[8];
#pragma unroll
        for (int i = 0; i < 4; ++i) {
            const int c = c8 + 2 * i;
            const float w0a = cw[c], w0b = cw[c + 1], w1a = cw[DM + c], w1b = cw[DM + c + 1], w2a = cw[2 * DM + c], w2b = cw[2 * DM + c + 1];
            o[2 * i] = bf_lo(bb[i]) * (w0a * bf_lo(u2[i]) + w1a * bf_lo(u1[i]) + w2a * bf_lo(u0[i]));
            o[2 * i + 1] = bf_hi(bb[i]) * (w0b * bf_hi(u2[i]) + w1b * bf_hi(u1[i]) + w2b * bf_hi(u0[i]));
        }
        u32x4 w; w.x = cvt_pk_bf16(o[0], o[1]); w.y = cvt_pk_bf16(o[2], o[3]); w.z = cvt_pk_bf16(o[4], o[5]); w.w = cvt_pk_bf16(o[6], o[7]);
        *(u32x4*)(Bg + off) = w;
    }
}

constexpr size_t SSM_PU_OFF = (size_t)64 * 2048 * 384 * 2;
constexpr size_t SSM_MQ_OFF = SSM_PU_OFF + (size_t)64 * 2048 * 128 * 4;
constexpr size_t SSM_P_OFF = SSM_MQ_OFF + (size_t)64 * 256 * 384 * 2;
static_assert(SSM_P_OFF + (size_t)64 * 128 * 256 * 2 <= (size_t)T_TOK * DFF * 2, "ssm scratch must fit the hidden buffer");

__device__ void ssm_uprep_phase(const bf16_t* xb, const float* part, const float* gain, bf16_t* U2) {
    const int tid = opaque_tid(), lane = tid & 63, gw = blockIdx.x * 8 + (tid >> 6), nw = gridDim.x * 8;
    const int s = lane & 15, gq = lane >> 4;
    for (int item0 = gw; item0 < 32768; item0 += 2 * nw) {
        f32x4 pp[2][4]; u32x4 xa[2][2];
#pragma unroll
        for (int rr = 0; rr < 2; ++rr) {
            const int item = item0 + rr * nw, g = (item & 15) * 4 + gq, c = (item >> 4) & 127, b = item >> 11, row = b * SEQ + c * 16 + s;
#pragma unroll
            for (int q = 0; q < 4; ++q) pp[rr][q] = *(const f32x4*)(part + (size_t)row * 32 + 4 * q);
            xa[rr][0] = *(const u32x4*)(xb + (size_t)row * DM + g * 16); xa[rr][1] = *(const u32x4*)(xb + (size_t)row * DM + g * 16 + 8);
        }
#pragma unroll
        for (int rr = 0; rr < 2; ++rr) {
            const int item = item0 + rr * nw, g = (item & 15) * 4 + gq, c = (item >> 4) & 127, b = item >> 11;
            float ssq = 0.f;
#pragma unroll
            for (int q = 0; q < 4; ++q) ssq += (pp[rr][q][0] + pp[rr][q][1]) + (pp[rr][q][2] + pp[rr][q][3]);
            const float rs = __builtin_amdgcn_rsqf(ssq * (1.0f / 1024.0f) + NORM_EPS);
            const unsigned xw[8] = {xa[rr][0].x, xa[rr][0].y, xa[rr][0].z, xa[rr][0].w, xa[rr][1].x, xa[rr][1].y, xa[rr][1].z, xa[rr][1].w};
            unsigned w[8];
#pragma unroll
            for (int q4 = 0; q4 < 4; ++q4) {
                const f32x4 gv = *(const f32x4*)(gain + g * 16 + q4 * 4);
                w[q4 * 2] = cvt_pk_bf16(bf_lo(xw[q4 * 2]) * rs * gv[0], bf_hi(xw[q4 * 2]) * rs * gv[1]); w[q4 * 2 + 1] = cvt_pk_bf16(bf_lo(xw[q4 * 2 + 1]) * rs * gv[2], bf_hi(xw[q4 * 2 + 1]) * rs * gv[3]);
            }
            bf16_t* dst = U2 + ((size_t)g * 2048 + b * 128 + c) * 384 + 16 * s;
            *(u32x4*)dst = (u32x4){w[0], w[1], w[2], w[3]}; *(u32x4*)(dst + 8) = (u32x4){w[4], w[5], w[6], w[7]};
        }
    }
}

__device__ void ssm_build_phase(int j, bf16_t* MQ, bf16_t* P, LAS unsigned char* lds) {
    CArgs a = get_args();
    LAS float* ApR = (LAS float*)lds; LAS float* ApI = ApR + 17 * 64;
    LAS float* BbR = ApI + 17 * 64; LAS float* BbI = BbR + 1024;
    LAS float* CR = BbI + 1024; LAS float* CI = CR + 1024; LAS float* Kt = CI + 1024;
    const int tid = opaque_tid();
    for (int item = blockIdx.x; item < 256; item += gridDim.x) {
        const int g = item >> 2, q4 = item & 3;
        if (tid < 64) {
            const int p = tid; const f32x4 dv = *(const f32x4*)((const float*)(a->ws + WS_DISC) + (((size_t)j * 64 + g) * 64 + p) * 8);
            const float abr = dv[0], abi = dv[1], cfr = dv[2], cfi = dv[3];
            float pr = 1.0f, pi = 0.0f;
            for (int n = 0; n <= 16; ++n) { ApR[n * 64 + p] = pr; ApI[n * 64 + p] = pi; const float nr = pr * abr - pi * abi, ni = pr * abi + pi * abr; pr = nr; pi = ni; }
            const size_t gp = ((size_t)j * 64 + g) * 64 + p;
            for (int h = 0; h < 16; ++h) { const float br = a->in[14][gp * 16 + h], bi = a->in[15][gp * 16 + h]; BbR[p * 16 + h] = cfr * br - cfi * bi; BbI[p * 16 + h] = cfr * bi + cfi * br; }
        }
        for (int i = tid; i < 1024; i += NTHREADS) { const size_t ci = ((size_t)j * 64 + g) * 1024 + i; CR[i] = a->in[16][ci]; CI[i] = a->in[17][ci]; }
        __syncthreads();
        for (int e = tid; e < 1024; e += NTHREADS) {
            const int tau = e >> 6, h = 4 * q4 + ((e >> 4) & 3), hp = e & 15; float acc = 0.f;
            for (int p = 0; p < 64; ++p) { const float cr = CR[h * 64 + p], ci = CI[h * 64 + p], ar = ApR[tau * 64 + p], ai = ApI[tau * 64 + p], br = BbR[p * 16 + hp], bi = BbI[p * 16 + hp];
                acc += (cr * ar - ci * ai) * br - (cr * ai + ci * ar) * bi; }
            Kt[e] = acc;
        }
        __syncthreads();
        bf16_t* mq = MQ + (size_t)g * 256 * 384;
        for (int e = tid; e < 64 * 192; e += NTHREADS) {
            const int rl = e / 192, k = (e - rl * 192) * 2, t = rl >> 2, hl = rl & 3, h = 4 * q4 + hl, n = t * 16 + h; float v[2];
#pragma unroll
            for (int q = 0; q < 2; ++q) { const int kk = k + q;
                if (kk < 256) { const int sidx = kk >> 4, hp = kk & 15; v[q] = (sidx <= t) ? Kt[(t - sidx) * 64 + hl * 16 + hp] : 0.f; }
                else if (kk < 320) { const int p = kk - 256; v[q] = CR[h * 64 + p] * ApR[(t + 1) * 64 + p] - CI[h * 64 + p] * ApI[(t + 1) * 64 + p]; }
                else { const int p = kk - 320; v[q] = -(CR[h * 64 + p] * ApI[(t + 1) * 64 + p] + CI[h * 64 + p] * ApR[(t + 1) * 64 + p]); } }
            *(unsigned*)(mq + (size_t)n * 384 + k) = cvt_pk_bf16(v[0], v[1]);
        }
        bf16_t* pp = P + (size_t)g * 128 * 256;
        for (int e = tid; e < 32 * 128; e += NTHREADS) {
            const int rl = e >> 7, k = (e & 127) * 2, im = rl >> 4, p = 16 * q4 + (rl & 15), r = im * 64 + p, sidx = k >> 4; float v[2];
            const float ar = ApR[(15 - sidx) * 64 + p], ai = ApI[(15 - sidx) * 64 + p];
#pragma unroll
            for (int q = 0; q < 2; ++q) { const int hp = (k + q) & 15; const float br = BbR[p * 16 + hp], bi = BbI[p * 16 + hp]; v[q] = im ? (ar * bi + ai * br) : (ar * br - ai * bi); }
            *(unsigned*)(pp + (size_t)r * 256 + k) = cvt_pk_bf16(v[0], v[1]);
        }
        __syncthreads();
    }
}

__device__ void ssm_cscan_phase(int j, const float* PU, bf16_t* U2) {
    CArgs a = get_args();
    const int tid = opaque_tid(), wave = tid >> 6, lane = tid & 63;
    if (wave >= 4) return;
    for (int item = blockIdx.x * 4 + wave; item < NB * 64; item += gridDim.x * 4) {
        const int b = item >> 6, g = item & 63, p = lane;
        const f32x4 dv = *(const f32x4*)((const float*)(a->ws + WS_DISC) + (((size_t)j * 64 + g) * 64 + p) * 8 + 4);
        const float a16r = dv[0], a16i = dv[1];
        float sr = 0.f, si = 0.f;
        const float* pu = PU + ((size_t)g * 2048 + b * 128) * 128 + p;
        bf16_t* uo = U2 + ((size_t)g * 2048 + b * 128) * 384 + 256 + p;
        for (int c0 = 0; c0 < 128; c0 += 32) {
            float lr[32], li[32];
#pragma unroll
            for (int q = 0; q < 32; ++q) { lr[q] = pu[(size_t)(c0 + q) * 128]; li[q] = pu[(size_t)(c0 + q) * 128 + 64]; }
#pragma unroll
            for (int q = 0; q < 32; ++q) {
                uo[(size_t)(c0 + q) * 384] = (bf16_t)(cvt_pk_bf16(sr, 0.f) & 0xffffu); uo[(size_t)(c0 + q) * 384 + 64] = (bf16_t)(cvt_pk_bf16(si, 0.f) & 0xffffu);
                const float nr = a16r * sr - a16i * si + lr[q], ni = a16r * si + a16i * sr + li[q]; sr = nr; si = ni;
            }
        }
    }
}

struct EpiPU {
    static constexpr bool PERM = false, LDSPART = false;
    __device__ __forceinline__ bool lds_part() const { return false; }
    float* PU;
    __device__ __forceinline__ void operator()(const f32x4 (&acc)[2][2][4][2], const Unit& u, int wr, int wc, int fr, int fq, const LAS unsigned char* lp) const {
        { const int ln_ = opaque_tid() & 63; fr = ln_ & 15; fq = ln_ >> 4; }
        const int row0 = u.pm * 256 + wr * 64 + fr, col0 = wc * 32 + 4 * fq;
#pragma unroll
        for (int ai = 0; ai < 2; ++ai)
#pragma unroll
            for (int m = 0; m < 4; ++m)
#pragma unroll
                for (int n = 0; n < 2; ++n) *(f32x4*)(PU + (size_t)(row0 + ai * 128 + m * 16) * 128 + col0 + n * 16) = acc[ai][0][m][n];
    }
};
struct EpiY {
    static constexpr bool PERM = true, LDSPART = false;
    __device__ __forceinline__ bool lds_part() const { return false; }
    const bf16_t* U2; bf16_t* Z; const float* dsk;
    __device__ __forceinline__ void operator()(const f32x4 (&acc)[2][2][4][2], const Unit& u, int wr, int wc, int fr, int fq, const LAS unsigned char* lp) const {
        { const int ln_ = opaque_tid() & 63; fr = ln_ & 15; fq = ln_ >> 4; }
        const int g = u.pm >> 3, rg0 = (u.pm & 7) * 256 + wr * 64 + fr, h0 = 8 * (fq & 1), tq = 2 * wc + (fq >> 1);
        const f32x4 d0 = *(const f32x4*)(dsk + g * 16 + h0), d1 = *(const f32x4*)(dsk + g * 16 + h0 + 4);
#pragma unroll
        for (int gp = 0; gp < 4; ++gp) {
            const int ai = gp >> 1;
            u32x4 uw[2][2];
#pragma unroll
            for (int mm = 0; mm < 2; ++mm)
#pragma unroll
                for (int bj = 0; bj < 2; ++bj) uw[mm][bj] = *(const u32x4*)(U2 + ((size_t)g * 2048 + rg0 + ai * 128 + ((gp & 1) * 2 + mm) * 16) * 384 + 16 * (8 * bj + tq) + h0);
#pragma unroll
            for (int mm = 0; mm < 2; ++mm) {
                const int m = (gp & 1) * 2 + mm;
                const int rg = rg0 + ai * 128 + m * 16, b = rg >> 7, cc = rg & 127;
                bf16_t* zrow = Z + (size_t)(b * SEQ + 16 * cc) * DM + g * 16 + h0;
#pragma unroll
                for (int bj = 0; bj < 2; ++bj) {
                    const u32x4 uv = uw[mm][bj];
                    const f32x4 y0 = acc[ai][bj][m][0], y1 = acc[ai][bj][m][1];
                    u32x4 w;
                    w.x = cvt_pk_bf16(gelu_tanh(y0[0] + d0[0] * bf_lo(uv.x)), gelu_tanh(y0[1] + d0[1] * bf_hi(uv.x)));
                    w.y = cvt_pk_bf16(gelu_tanh(y0[2] + d0[2] * bf_lo(uv.y)), gelu_tanh(y0[3] + d0[3] * bf_hi(uv.y)));
                    w.z = cvt_pk_bf16(gelu_tanh(y1[0] + d1[0] * bf_lo(uv.z)), gelu_tanh(y1[1] + d1[1] * bf_hi(uv.z)));
                    w.w = cvt_pk_bf16(gelu_tanh(y1[2] + d1[2] * bf_lo(uv.w)), gelu_tanh(y1[3] + d1[3] * bf_hi(uv.w)));
                    *(u32x4*)(zrow + (size_t)(8 * bj + tq) * DM) = w;
                }
            }
            asm volatile("" ::: "memory");
        }
    }
};

__device__ void attn_phase(const bf16_t* Q, const bf16_t* Kall, const bf16_t* VT, bf16_t* O, int layer, LAS unsigned char* lds) {
    const int tid0 = opaque_tid(), wave = __builtin_amdgcn_readfirstlane(tid0 >> 6);
    for (int unit = blockIdx.x; unit < NB * 4 * 8; unit += gridDim.x) {
        int lane = tid0 & 63; asm volatile("" : "+v"(lane));
        const int r = lane & 31, h = lane >> 5;
#define ATT_VOFF() int ln_ = tid0 & 63; asm volatile("" : "+v"(ln_)); const int rb = 2 * wave + (ln_ >> 5), cc0 = (ln_ & 31) ^ rb; \
        const unsigned voff_e = (unsigned)(rb * 4096 + cc0 * 8) * 2u, voff_o = (unsigned)(rb * 4096 + (cc0 ^ 16) * 8) * 2u
        const int b = unit >> 5, hd = (unit >> 3) & 3, qt = unit & 7;
        const int t0 = b * SEQ + qt * 256 + wave * 32;
        const bf16_t* qp = Q + (size_t)(t0 + r) * DM + hd * 256 + 8 * h;
        bf16x8 qf[16];
#pragma unroll
        for (int kk = 0; kk < 16; ++kk) qf[kk] = *(const bf16x8*)(qp + 16 * kk);
        __syncthreads();
        {
            ATT_VOFF();
            const char* kb = (const char*)(Kall + (size_t)(b * MEML) * 4096 + layer * 1024 + hd * 256);
#pragma unroll
            for (int it = 0; it < 16; ++it)
                __builtin_amdgcn_global_load_lds((const unsigned*)(kb + (size_t)it * 16 * 4096 * 2 + ((it & 1) ? voff_o : voff_e)), (LAS unsigned*)(lds + (it * 8 + wave) * 1024), 16, 0, 0);
        }
        asm volatile("s_waitcnt vmcnt(0)" ::: "memory");
        __syncthreads();
        bf16x8 pf[8][2]; float mh[4], mrun = -3.0e38f, drun = 0.f;
#pragma unroll
        for (int hf = 0; hf < 4; ++hf) {
            int r = lane & 31, h = lane >> 5; asm volatile("" : "+v"(r), "+v"(h));
            f32x16 s[2];
#pragma unroll
            for (int k4 = 0; k4 < 2; ++k4) {
                const int kt = hf * 2 + k4;
                f32x16 acc;
#pragma unroll
                for (int e = 0; e < 16; ++e) acc[e] = 0.f;
#pragma unroll
                for (int k8 = 0; k8 < 4; ++k8) {
                    bf16x8 af[4];
#pragma unroll
                    for (int i = 0; i < 4; ++i) af[i] = *(const LAS bf16x8*)(lds + (32 * kt + r) * 512 + (((2 * (4 * k8 + i) + h) ^ r) << 4));
                    __builtin_amdgcn_sched_group_barrier(0x100, 4, 0);
                    __builtin_amdgcn_sched_group_barrier(0x008, 4, 0);
#pragma unroll
                    for (int i = 0; i < 4; ++i) acc = __builtin_amdgcn_mfma_f32_32x32x16_bf16(af[i], qf[4 * k8 + i], acc, 0, 0, 0);
                }
                s[k4] = acc;
            }
            float mx = -3.0e38f;
#pragma unroll
            for (int k4 = 0; k4 < 2; ++k4)
#pragma unroll
                for (int e = 0; e < 16; ++e) mx = fmaxf(mx, s[k4][e]);
            mx = max_x32(mx);
            float sum = 0.f;
#pragma unroll
            for (int k4 = 0; k4 < 2; ++k4)
#pragma unroll
                for (int e = 0; e < 16; ++e) { const float pv = __builtin_amdgcn_exp2f(s[k4][e] - mx); s[k4][e] = pv; sum += pv; }
            sum = add_x32(sum);
            { const float mnew = fmaxf(mrun, mx); drun = drun * __builtin_amdgcn_exp2f(mrun - mnew) + sum * __builtin_amdgcn_exp2f(mx - mnew); mrun = mnew; mh[hf] = mx; }
#pragma unroll
            for (int k4 = 0; k4 < 2; ++k4)
#pragma unroll
                for (int s2 = 0; s2 < 2; ++s2) {
                    u32x4 w;
                    w.x = cvt_pk_bf16(s[k4][8 * s2 + 0], s[k4][8 * s2 + 1]); w.y = cvt_pk_bf16(s[k4][8 * s2 + 2], s[k4][8 * s2 + 3]);
                    w.z = cvt_pk_bf16(s[k4][8 * s2 + 4], s[k4][8 * s2 + 5]); w.w = cvt_pk_bf16(s[k4][8 * s2 + 6], s[k4][8 * s2 + 7]);
                    pf[hf * 2 + k4][s2] = __builtin_bit_cast(bf16x8, w);
                }
        }
        asm volatile("s_waitcnt lgkmcnt(0)" ::: "memory");
        __syncthreads();
        {
            ATT_VOFF();
            const char* vb = (const char*)(VT + (size_t)(layer * 1024 + hd * 256) * 4096 + b * MEML);
#pragma unroll
            for (int it = 0; it < 16; ++it)
                __builtin_amdgcn_global_load_lds((const unsigned*)(vb + (size_t)it * 16 * 4096 * 2 + ((it & 1) ? voff_o : voff_e)), (LAS unsigned*)(lds + (it * 8 + wave) * 1024), 16, 0, 0);
        }
        float fq[4];
        const float inv = 1.0f / drun;
#pragma unroll
        for (int q = 0; q < 4; ++q) fq[q] = __builtin_amdgcn_exp2f(mh[q] - mrun) * inv;
        asm volatile("s_waitcnt vmcnt(0)" ::: "memory");
        __syncthreads();
        bf16_t* op = O + (size_t)(t0 + r) * DM + hd * 256 + 4 * h;
        int rv = lane & 31, hv = lane >> 5; asm volatile("" : "+v"(rv), "+v"(hv));
#pragma unroll
        for (int dt = 0; dt < 8; ++dt) {
            f32x16 ac[4];
#pragma unroll
            for (int q = 0; q < 4; ++q)
#pragma unroll
                for (int e = 0; e < 16; ++e) ac[q][e] = 0.f;
            const LAS unsigned char* rowp = lds + (32 * dt + rv) * 512 + 8 * hv;
#pragma unroll
            for (int kt = 0; kt < 8; ++kt) {
                u32x4 vf[2];
#pragma unroll
                for (int s2 = 0; s2 < 2; ++s2) {
                    const u32x2 lo = *(const LAS u32x2*)(rowp + (((4 * kt + 2 * s2) ^ rv) << 4)), hi = *(const LAS u32x2*)(rowp + (((4 * kt + 2 * s2 + 1) ^ rv) << 4));
                    vf[s2].x = lo.x; vf[s2].y = lo.y; vf[s2].z = hi.x; vf[s2].w = hi.y;
                }
                __builtin_amdgcn_sched_group_barrier(0x100, 4, 0);
                __builtin_amdgcn_sched_group_barrier(0x008, 2, 0);
#pragma unroll
                for (int s2 = 0; s2 < 2; ++s2) ac[kt >> 1] = __builtin_amdgcn_mfma_f32_32x32x16_bf16(__builtin_bit_cast(bf16x8, vf[s2]), pf[kt][s2], ac[kt >> 1], 0, 0, 0);
            }
#pragma unroll
            for (int g4 = 0; g4 < 4; ++g4) {
                float o[4];
#pragma unroll
                for (int e = 0; e < 4; ++e) o[e] = (ac[0][4 * g4 + e] * fq[0] + ac[1][4 * g4 + e] * fq[1]) + (ac[2][4 * g4 + e] * fq[2] + ac[3][4 * g4 + e] * fq[3]);
                u32x2 w; w.x = cvt_pk_bf16(o[0], o[1]); w.y = cvt_pk_bf16(o[2], o[3]);
                *(u32x2*)(op + dt * 32 + 8 * g4) = w;
            }
        }
        asm volatile("s_waitcnt lgkmcnt(0)" ::: "memory");
    }
    __syncthreads();
}

__device__ void final_norm_phase(const bf16_t* xb, float* out, const float* g) {
    const int tid0 = opaque_tid(), lane = tid0 & 63, gw = blockIdx.x * 8 + (tid0 >> 6), nw = gridDim.x * 8;
    f32x4 gg[4];
#pragma unroll
    for (int i = 0; i < 4; ++i) gg[i] = *(const f32x4*)(g + i * 256 + lane * 4);
    for (int row = gw; row < T_TOK; row += 2 * nw) {
        u32x2 b2[2][4];
#pragma unroll
        for (int rr = 0; rr < 2; ++rr)
#pragma unroll
            for (int i = 0; i < 4; ++i) b2[rr][i] = *(const u32x2*)(xb + (size_t)(row + rr * nw) * DM + i * 256 + lane * 4);
#pragma unroll
        for (int rr = 0; rr < 2; ++rr) {
            f32x4 v[4]; float ss = 0.f;
#pragma unroll
            for (int i = 0; i < 4; ++i) {
                v[i][0] = bf_lo(b2[rr][i].x); v[i][1] = bf_hi(b2[rr][i].x); v[i][2] = bf_lo(b2[rr][i].y); v[i][3] = bf_hi(b2[rr][i].y);
                ss += (v[i][0] * v[i][0] + v[i][1] * v[i][1]) + (v[i][2] * v[i][2] + v[i][3] * v[i][3]);
            }
#pragma unroll
            for (int o = 32; o >= 1; o >>= 1) ss += shx(ss, o);
            const float rs = 1.0f / sqrtf(ss * (1.0f / 1024.0f) + NORM_EPS);
#pragma unroll
            for (int i = 0; i < 4; ++i) *(f32x4*)(out + (size_t)(row + rr * nw) * DM + i * 256 + lane * 4) = v[i] * rs * gg[i];
        }
    }
}

__global__ void __launch_bounds__(NTHREADS, 2) mega_fwd(Args a_unused) {
    extern __shared__ __attribute__((aligned(16))) unsigned char lds_raw[];
    LAS unsigned char* lds = (LAS unsigned char*)lds_raw;
    cg::grid_group grid = cg::this_grid();
    const int G = gridDim.x, c = blockIdx.x;
#define WSP(off) (get_args()->ws + (off))
#define XB_ ((bf16_t*)WSP(WS_XB))
#define HB_ ((bf16_t*)WSP(WS_HB))
#define HB2_ ((bf16_t*)WSP(WS_HB + (size_t)T_TOK * DM * 2))
#define PART_ ((float*)WSP(WS_PART))
#define OUT_ (get_args()->out)

    { unsigned* bar0 = (unsigned*)WSP(WS_BAR); if (blockIdx.x == 0 && threadIdx.x < 33) __hip_atomic_store(bar0 + 64 * threadIdx.x, 0u, __ATOMIC_RELAXED, __HIP_MEMORY_SCOPE_AGENT); }
    unsigned bar_k = 0;
#define GRID_BAR() do { bar_k += 1u; grid_barrier((unsigned*)WSP(WS_BAR), bar_k, 16u, (unsigned)G / 16u); } while (0)
    prep_phase(lds);
    grid.sync();
    {
        pg8::StaticOrder S; S.init(4096, 4096, G, c);
        { pg8::Gemm g = pg8::mk_gemm((const bf16_t*)WSP(WS_MEMB), (const bf16_t*)WSP(WS_K), DM); EpiBf16S E{(bf16_t*)WSP(WS_KALL), 4096, nullptr, 0, 1.0f}; pg8::gemm_phase(lds, g, S, E); }
        { pg8::Gemm g = pg8::mk_gemm((const bf16_t*)WSP(WS_VT), (const bf16_t*)WSP(WS_MEMB), DM); EpiBf16S E{(bf16_t*)WSP(WS_VTALL), 4096, nullptr, 0, 1.0f}; pg8::gemm_phase(lds, g, S, E); }
    }
#pragma unroll 1
    for (int l = 0; l < NLAYER; ++l) {
#pragma unroll 1
        for (int pass = 0; pass < 2; ++pass) {
            {
                pg8::StaticOrder S; S.init(T_TOK, 2 * DFF, G, c);
                pg8::Gemm g = pg8::mk_gemm(XB_, (const bf16_t*)WSP((pass ? WS_UP2 : WS_UP1) + l * SZ_UP), DM);
                EpiSwiglu E{HB_, PART_, 16}; pg8::gemm_phase(lds, g, S, E);
            }
            GRID_BAR();
            {
                pg8::StaticOrder S; S.init(T_TOK, DM, G, c);
                pg8::Gemm g = pg8::mk_gemm(HB_, (const bf16_t*)WSP((pass ? WS_DN2 : WS_DN1) + l * SZ_DN), DFF);
                EpiResid E{(l == 0 && pass == 0) ? get_args()->in[0] : (const float*)nullptr, XB_, PART_, 0.5f}; pg8::gemm_phase(lds, g, S, E);
            }
            GRID_BAR();
            if (pass == 0) {
                const int j = l >> 1; int np_q;
                if ((l & 1) == 0) {
                    {
                        pg8::StaticOrder S; S.init(T_TOK, 3 * DM, G, c);
                        pg8::Gemm g = pg8::mk_gemm(XB_, (const bf16_t*)WSP(WS_CIN + j * 3 * SZ_SQ), DM);
                        EpiConvIn E{HB_, HB2_, PART_, 16}; pg8::gemm_phase(lds, g, S, E);
                    }
                    GRID_BAR();
                    conv_phase(HB_, HB2_, get_args()->in[9] + (size_t)j * 3 * DM);
                    GRID_BAR();
                    {
                        pg8::StaticOrder S; S.init(T_TOK, DM, G, c);
                        pg8::Gemm g = pg8::mk_gemm(HB2_, (const bf16_t*)WSP(WS_COUT + j * SZ_SQ), DM);
                        EpiResid E{nullptr, XB_, PART_, 1.0f}; pg8::gemm_phase(lds, g, S, E);
                    }
                    GRID_BAR();
                    np_q = 16;
                } else {
#define U2_ HB_
#define PU_ ((float*)WSP(WS_HB + SSM_PU_OFF))
#define Z_ ((bf16_t*)WSP(WS_HB + SSM_PU_OFF))
#define MQ_ ((bf16_t*)WSP(WS_HB + SSM_MQ_OFF))
#define PM_ ((bf16_t*)WSP(WS_HB + SSM_P_OFF))
                    ssm_uprep_phase(XB_, PART_, get_args()->in[2] + (size_t)(l * 5 + 1) * DM, U2_);
                    ssm_build_phase(j, MQ_, PM_, lds);
                    GRID_BAR();
                    {
                        pg8::GroupOrder S{G, c};
                        pg8::Gemm g{U2_, PM_, 256, 384, (size_t)128 * 256 * 2};
                        EpiPU E{PU_}; pg8::gemm_phase(lds, g, S, E);
                    }
                    GRID_BAR();
                    ssm_cscan_phase(j, PU_, U2_);
                    GRID_BAR();
                    {
                        pg8::GroupOrder S{G, c};
                        pg8::Gemm g{U2_, MQ_, 384, 384, (size_t)256 * 384 * 2};
                        EpiY E{U2_, Z_, get_args()->in[18] + (size_t)j * DM}; pg8::gemm_phase(lds, g, S, E);
                    }
                    GRID_BAR();
                    {
                        pg8::StaticOrder S; S.init(T_TOK, 2 * DM, G, c);
                        pg8::Gemm g = pg8::mk_gemm(Z_, (const bf16_t*)WSP(WS_GLU + j * 2 * SZ_SQ), DM);
                        EpiGlu E{XB_, PART_}; pg8::gemm_phase(lds, g, S, E);
                    }
                    GRID_BAR();
                    np_q = 32;
                }
                {
                    pg8::StaticOrder S; S.init(T_TOK, DM, G, c);
                    pg8::Gemm g = pg8::mk_gemm(XB_, (const bf16_t*)WSP(WS_Q + l * SZ_SQ), DM);
                    EpiBf16S E{HB_, DM, PART_, np_q, 0.0625f * 1.44269504089f}; pg8::gemm_phase(lds, g, S, E);
                }
                GRID_BAR();
                attn_phase(HB_, (const bf16_t*)WSP(WS_KALL), (const bf16_t*)WSP(WS_VTALL), HB2_, l, lds);
                GRID_BAR();
                {
                    pg8::StaticOrder S; S.init(T_TOK, DM, G, c);
                    pg8::Gemm g = pg8::mk_gemm(HB2_, (const bf16_t*)WSP(WS_O + l * SZ_SQ), DM);
                    EpiResid E{nullptr, XB_, PART_, 1.0f}; pg8::gemm_phase(lds, g, S, E);
                }
                GRID_BAR();
            }
        }
    }
    final_norm_phase(XB_, OUT_, get_args()->in[3]);
}

extern "C" void kernel_launch(void* const* d_in, const int* in_sizes, int n_in, void* d_out, int out_size, void* d_ws, size_t ws_size, hipStream_t stream) {
    static int grid_blocks = 0;
    if (grid_blocks == 0) {
        if (n_in != 23 || out_size != T_TOK * DM || ws_size < WS_END) { fprintf(stderr, "kernel_launch: unexpected shapes (n_in %d out %d ws %zu need %zu)\n", n_in, out_size, ws_size, (size_t)WS_END); grid_blocks = -1; return; }
        int dev = 0, cus = 0, per_cu = 0;
        hipGetDevice(&dev);
        hipDeviceGetAttribute(&cus, hipDeviceAttributeMultiprocessorCount, dev);
        if (hipFuncSetAttribute((const void*)mega_fwd, hipFuncAttributeMaxDynamicSharedMemorySize, LDS_BYTES) != hipSuccess) { fprintf(stderr, "kernel_launch: hipFuncSetAttribute failed\n"); grid_blocks = -1; return; }
        if (hipOccupancyMaxActiveBlocksPerMultiprocessor(&per_cu, (const void*)mega_fwd, NTHREADS, LDS_BYTES) != hipSuccess || per_cu < 1) { fprintf(stderr, "kernel_launch: occupancy query gave %d\n", per_cu); per_cu = 1; }
        (void)hipGetLastError();
        grid_blocks = cus * 1;
    }
    if (grid_blocks < 0) return;
    Args a{};
    for (int i = 0; i < 23; ++i) a.in[i] = (const float*)d_in[i];
    a.out = (float*)d_out; a.ws = (unsigned char*)d_ws;
    void* args[] = {&a};
    hipError_t e = hipLaunchCooperativeKernel((const void*)mega_fwd, dim3(grid_blocks), dim3(NTHREADS), args, LDS_BYTES, stream);
    if (e != hipSuccess) fprintf(stderr, "cooperative launch failed: %s (grid %d)\n", hipGetErrorString(e), grid_blocks);
}
```
